# Optimizing an MI355X kernel written in HIP

```python
import jax, jax.numpy as jnp
from jax import lax
import numpy as np

D_MODEL = 2048
BATCH = 4
SEQ = 2048
DEPTH = 4

CHUNK = 64
N_MEM = 256
N_MEM_HEADS = 4
MEM_HEAD_DIM = D_MODEL // N_MEM_HEADS
D_FF = ((8 * D_MODEL // 3 + 255) // 256) * 256
A_WIDTH = D_MODEL // 2
B_WIDTH = D_MODEL // 2
A_HEADS = 8
A_HEAD_DIM = A_WIDTH // A_HEADS
GMLP_BLOCK = 128
CONV_WIDTH = 31
POOL_WINDOWS = (2, 4, 8, 16)
C_GROUPS = len(POOL_WINDOWS)
C_GROUP_DIM = D_MODEL // C_GROUPS
N_EVEN = (DEPTH + 1) // 2
N_ODD = DEPTH // 2
EPS = 1e-6

kernel_name = "hybrid_gmlp_conformer_pool_encoder"


def rms_norm(x, g):
    x32 = x.astype(jnp.float32)
    y = x32 * lax.rsqrt(jnp.mean(x32 * x32, axis=-1, keepdims=True) + EPS)
    return (y * g.astype(jnp.float32)).astype(x.dtype)


def layer_norm(x, g, b):
    x32 = x.astype(jnp.float32)
    mu = jnp.mean(x32, axis=-1, keepdims=True)
    xc = x32 - mu
    var = jnp.mean(xc * xc, axis=-1, keepdims=True)
    y = xc * lax.rsqrt(var + EPS)
    return (y * g.astype(jnp.float32) + b.astype(jnp.float32)).astype(x.dtype)


def swiglu_ffn(h, w_gate, w_up, w_down):
    return (jax.nn.silu(h @ w_gate) * (h @ w_up)) @ w_down


def gmlp_spatial_gate(u, v, w_s, b_s, ln_g, ln_b):
    b, s, _ = u.shape
    v = layer_norm(v, ln_g, ln_b)
    pos = jnp.arange(GMLP_BLOCK)
    mask = (pos[None, :] // CHUNK) <= (pos[:, None] // CHUNK)
    w = jnp.where(mask[None], w_s, jnp.zeros_like(w_s))
    vb = v.reshape(b, s // GMLP_BLOCK, GMLP_BLOCK, A_HEADS, A_HEAD_DIM)
    sp = jnp.einsum('hpq,bnqhc->bnphc', w, vb) + b_s.T[None, None, :, :, None]
    return u * sp.reshape(b, s, A_WIDTH)


def conformer_conv(a, g, conv_w, conv_b, ln_g, ln_b):
    h = a * jax.nn.sigmoid(g)
    h = lax.conv_general_dilated(
        h, conv_w, window_strides=(1,), padding=[(CONV_WIDTH - 1, 0)],
        dimension_numbers=('NWC', 'WIO', 'NWC'), feature_group_count=B_WIDTH) + conv_b
    h = layer_norm(h, ln_g, ln_b)
    return jax.nn.silu(h)


def even_mixer(h, w_in, b_in, w_s, b_s, gln_g, gln_b, conv_w, conv_b, cln_g, cln_b, w_out, b_out):
    z = h @ w_in + b_in
    u_a, v_a, a_b, g_b = jnp.split(z, [A_WIDTH, 2 * A_WIDTH, 2 * A_WIDTH + B_WIDTH], axis=-1)
    y_a = gmlp_spatial_gate(jax.nn.gelu(u_a), jax.nn.gelu(v_a), w_s, b_s, gln_g, gln_b)
    y_b = conformer_conv(a_b, g_b, conv_w, conv_b, cln_g, cln_b)
    return jnp.concatenate([y_a, y_b], axis=-1) @ w_out + b_out


def multiscale_pool_mixer(h, w_c, b_c, scale):
    b, s, _ = h.shape
    h32 = h.astype(jnp.float32)
    cs = jnp.cumsum(h32, axis=1)
    t = jnp.arange(1, s + 1, dtype=jnp.float32)[None, :, None]
    outs = []
    for gi, win in enumerate(POOL_WINDOWS):
        sl = slice(gi * C_GROUP_DIM, (gi + 1) * C_GROUP_DIM)
        c = cs[..., sl]
        prev = jnp.pad(c, ((0, 0), (win, 0), (0, 0)))[:, :s]
        mean = (c - prev) / jnp.minimum(t, win)
        d_g = (mean - h32[..., sl]).astype(h.dtype)
        outs.append(d_g @ w_c[gi] + b_c[gi])
    return jnp.concatenate(outs, axis=-1) * scale


def memory_cross_attention(h, mem_n, wq, wk, wv, wo):
    b, s, _ = h.shape
    m = mem_n.shape[1]
    q = (h @ wq).reshape(b, s, N_MEM_HEADS, MEM_HEAD_DIM)
    k = (mem_n @ wk).reshape(b, m, N_MEM_HEADS, MEM_HEAD_DIM)
    v = (mem_n @ wv).reshape(b, m, N_MEM_HEADS, MEM_HEAD_DIM)
    scores = jnp.einsum('bshd,bmhd->bhsm', q, k).astype(jnp.float32) * (MEM_HEAD_DIM ** -0.5)
    p = jax.nn.softmax(scores, axis=-1).astype(v.dtype)
    o = jnp.einsum('bhsm,bmhd->bshd', p, v).reshape(b, s, D_MODEL)
    return o @ wo


def setup_inputs(seed: int = 0) -> dict:
    key = jax.random.key(seed)
    ks = iter(jax.random.split(key, 48))

    def nrm(shape, scale):
        return jax.random.normal(next(ks), shape, jnp.float32) * scale

    def gain(shape):
        return 1.0 + nrm(shape, 0.1)

    D, F = D_MODEL, D_FF
    return {
        "x": nrm((BATCH, SEQ, D), 1.0),
        "mem": nrm((BATCH, N_MEM, D), 1.0),
        "norm_ffn1": gain((DEPTH, D)),
        "ffn1_gate": nrm((DEPTH, D, F), D ** -0.5),
        "ffn1_up": nrm((DEPTH, D, F), D ** -0.5),
        "ffn1_down": nrm((DEPTH, F, D), F ** -0.5),
        "norm_mix": gain((DEPTH, D)),
        "ab_w_in": nrm((N_EVEN, D, 2 * A_WIDTH + 2 * B_WIDTH), D ** -0.5),
        "ab_b_in": nrm((N_EVEN, 2 * A_WIDTH + 2 * B_WIDTH), 0.02),
        "gmlp_w_s": nrm((N_EVEN, A_HEADS, GMLP_BLOCK, GMLP_BLOCK), GMLP_BLOCK ** -0.5),
        "gmlp_b_s": gain((N_EVEN, A_HEADS, GMLP_BLOCK)),
        "gmlp_ln_g": gain((N_EVEN, A_WIDTH)),
        "gmlp_ln_b": nrm((N_EVEN, A_WIDTH), 0.02),
        "conv_w": nrm((N_EVEN, CONV_WIDTH, 1, B_WIDTH), CONV_WIDTH ** -0.5),
        "conv_b": nrm((N_EVEN, B_WIDTH), 0.02),
        "conv_ln_g": gain((N_EVEN, B_WIDTH)),
        "conv_ln_b": nrm((N_EVEN, B_WIDTH), 0.02),
        "ab_w_out": nrm((N_EVEN, A_WIDTH + B_WIDTH, D), (A_WIDTH + B_WIDTH) ** -0.5),
        "ab_b_out": nrm((N_EVEN, D), 0.02),
        "pool_w": nrm((N_ODD, C_GROUPS, C_GROUP_DIM, C_GROUP_DIM), C_GROUP_DIM ** -0.5),
        "pool_b": nrm((N_ODD, C_GROUPS, C_GROUP_DIM), 0.02),
        "pool_scale": 0.5 + nrm((N_ODD, D), 0.05),
        "norm_xq": gain((DEPTH, D)),
        "norm_xkv": gain((DEPTH, D)),
        "xattn_wq": nrm((DEPTH, D, D), D ** -0.5),
        "xattn_wk": nrm((DEPTH, D, D), D ** -0.5),
        "xattn_wv": nrm((DEPTH, D, D), D ** -0.5),
        "xattn_wo": nrm((DEPTH, D, D), D ** -0.5),
        "norm_ffn2": gain((DEPTH, D)),
        "ffn2_gate": nrm((DEPTH, D, F), D ** -0.5),
        "ffn2_up": nrm((DEPTH, D, F), D ** -0.5),
        "ffn2_down": nrm((DEPTH, F, D), F ** -0.5),
        "norm_final": gain((D,)),
    }


def reference(x, mem, norm_ffn1, ffn1_gate, ffn1_up, ffn1_down, norm_mix,
              ab_w_in, ab_b_in, gmlp_w_s, gmlp_b_s, gmlp_ln_g, gmlp_ln_b,
              conv_w, conv_b, conv_ln_g, conv_ln_b, ab_w_out, ab_b_out,
              pool_w, pool_b, pool_scale, norm_xq, norm_xkv,
              xattn_wq, xattn_wk, xattn_wv, xattn_wo,
              norm_ffn2, ffn2_gate, ffn2_up, ffn2_down, norm_final):
    for l in range(DEPTH):
        h = rms_norm(x, norm_ffn1[l])
        x = x + 0.5 * swiglu_ffn(h, ffn1_gate[l], ffn1_up[l], ffn1_down[l])
        h = rms_norm(x, norm_mix[l])
        if l % 2 == 0:
            e = l // 2
            x = x + even_mixer(h, ab_w_in[e], ab_b_in[e], gmlp_w_s[e], gmlp_b_s[e],
                               gmlp_ln_g[e], gmlp_ln_b[e], conv_w[e], conv_b[e],
                               conv_ln_g[e], conv_ln_b[e], ab_w_out[e], ab_b_out[e])
        else:
            o = l // 2
            x = x + multiscale_pool_mixer(h, pool_w[o], pool_b[o], pool_scale[o])
        h = rms_norm(x, norm_xq[l])
        m = rms_norm(mem, norm_xkv[l])
        x = x + memory_cross_attention(h, m, xattn_wq[l], xattn_wk[l], xattn_wv[l], xattn_wo[l])
        h = rms_norm(x, norm_ffn2[l])
        x = x + 0.5 * swiglu_ffn(h, ffn2_gate[l], ffn2_up[l], ffn2_down[l])
    return rms_norm(x, norm_final)
```

```cpp
#include <hip/hip_runtime.h>
#include <cstdio>
#include <cstdint>
namespace pg8 {
#define PG8_LAS __attribute__((address_space(3)))
typedef unsigned short bf16_t;
typedef short bf16x8 __attribute__((ext_vector_type(8)));
typedef float f32x4 __attribute__((ext_vector_type(4)));
typedef float f32x2 __attribute__((ext_vector_type(2)));
typedef unsigned u32x4 __attribute__((ext_vector_type(4)));
typedef unsigned u32x2 __attribute__((ext_vector_type(2)));
#ifndef MK_WGM
#define MK_WGM 4
#endif
constexpr int BM = 256, BK = 64, HALF = 128, HTB = HALF * BK * 2  , STAGE_BYTES = 8 * HTB, NXCD = 8, WGM = MK_WGM;

__host__ __device__ __forceinline__ int lds_byte(int r, int c) { const int st = (r >> 4) * 2 + (c >> 5), rr = r & 15, cc = c & 31, ob = rr * 64 + cc * 2; return st * 1024 + (ob ^ (((ob >> 9) & 1) << 5)); }
__host__ __device__ __forceinline__ void stage_rc(int b, int& R, int& C) { const int st = b / 1024, sb = b % 1024, swz = sb ^ (((sb >> 9) & 1) << 5); R = (st >> 1) * 16 + swz / 64; C = (st & 1) * 32 + (swz % 64) / 2; }
__host__ __device__ __forceinline__ int perm32(int rho) { const int n = rho >> 4, i = rho & 15; return 8 * (i >> 2) + 4 * n + (i & 3); }

struct Unit { int pm, pn, xa, xb, id; };
struct Gemm { const bf16_t* A; const bf16_t* Bt; int lda, ldb, K, agrp; };

struct StaticOrder {
    int nM, nN, nwg, G, c;
    __host__ __device__ void init(int M, int N, int G_, int c_) { nM = M / BM; nN = N / BM; nwg = nM * nN; G = G_; c = c_; }
    __host__ __device__ bool next(int i, Unit& u) const {
        const long L = (long)i * G + c; if (L >= nwg) return false;
        int wgid = (int)L; { const int q = nwg / NXCD, r = nwg % NXCD, xcd = wgid % NXCD, off = wgid / NXCD; wgid = (xcd < r ? xcd * (q + 1) : r * (q + 1) + (xcd - r) * q) + off; }
        const int nig = WGM * nN, gid = wgid / nig, fm = gid * WGM, gsz = (nM - fm) < WGM ? (nM - fm) : WGM;
        u.pm = fm + ((wgid % nig) % gsz); u.pn = (wgid % nig) / gsz; u.xa = 0; u.xb = 0; u.id = 0; return true;
    }
};
struct ListOrder {
    int lo, hi, G, c, nN, rowmajor;
    __host__ __device__ bool next(int i, Unit& u) const {
        const int i0 = (lo > c) ? (lo - c + G - 1) / G : 0; const int L = (i0 + i) * G + c; if (L >= hi) return false; const int k = L - lo;
        if (rowmajor) { u.pm = k / nN; u.pn = k % nN; } else { u.pm = k % nN; u.pn = k / nN; } u.xa = 0; u.xb = 0; u.id = 0; return true;
    }
};

struct BatchBOrder : StaticOrder {
    int bstride;
    __host__ __device__ bool next(int i, Unit& u) const { const bool ok = StaticOrder::next(i, u); if (ok) u.xb = (u.pm >> 3) * bstride; return ok; }
};
struct PreOrder {
    int G, c, l0, nl, oWO, oV, oK, oWQ;
    __host__ __device__ bool next(int i, Unit& u) const {
        const int e = i * G + c; if (e >= nl * 256) return false;
        const int t = e & 7, b = (e >> 3) & 3, h = (e >> 5) & 3, kind = (e >> 7) & 1, l = l0 + (e >> 8), big = l * 2048 * 2048 + h * 512, small = (l * 1024 + b * 256) * 2048 + h * 512;
        if (kind == 0) { u.pm = t; u.pn = 0; u.xa = oWO + big; u.xb = oV + small; } else { u.pm = 0; u.pn = t; u.xa = oK + small; u.xb = oWQ + big; }
        u.id = (kind << 9) | (l << 7) | (h << 5) | (b << 3) | t; return true;
    }
};

typedef __bf16 bf16x2_t __attribute__((ext_vector_type(2)));
__device__ __forceinline__ unsigned cvt_pk_bf16(float lo, float hi) { const f32x2 v = {lo, hi}; const bf16x2_t b = __builtin_convertvector(v, bf16x2_t); return __builtin_bit_cast(unsigned, b); }

typedef _Float16 h16x2_t __attribute__((ext_vector_type(2)));
__device__ __forceinline__ unsigned cvt_pk_h16(float lo, float hi) { const f32x2 v = {lo, hi}; const h16x2_t b = __builtin_convertvector(v, h16x2_t); return __builtin_bit_cast(unsigned, b); }
__device__ __forceinline__ float h_lo(unsigned w) { return (float)__builtin_bit_cast(h16x2_t, w)[0]; }
__device__ __forceinline__ float h_hi(unsigned w) { return (float)__builtin_bit_cast(h16x2_t, w)[1]; }

#ifndef MK_SP2
#define MK_SP2 true
#endif
template <class Epi, class Sched, bool SP2 = MK_SP2>
__device__ __forceinline__ void gemm_phase(PG8_LAS unsigned char* lds, const Gemm g, const Sched& S, const Epi& E) {
    int tid = threadIdx.x; asm volatile("" : "+v"(tid));
    const int wid = __builtin_amdgcn_readfirstlane(tid >> 6), lane = tid & 63, wr = wid >> 2, wc = wid & 3, fr = lane & 15, fq = lane >> 4;
    const int K = g.K, nt = K / BK;
    unsigned voffA[2], voffB[2];
#pragma unroll
    for (int i = 0; i < 2; ++i) { int R, C; stage_rc(tid * 16 + i * 8192, R, C); const int Rb = Epi::PERM ? ((R & ~31) + perm32(R & 31)) : R;
        voffA[i] = (unsigned)(R * g.lda + C) * 2u; voffB[i] = (unsigned)(Rb * g.ldb + C) * 2u; }
    const size_t kstep = (size_t)(BK * 2);
    const size_t hstepA = (size_t)HALF * g.lda * 2, hstepB = (size_t)HALF * g.ldb * 2;
    const size_t tstepA = 2 * hstepA, tstepB = 2 * hstepB;
    const unsigned ldsw = (unsigned)wid * 1024u;
    const int aoff = lds_byte(wr * 64 + fr, fq * 8), boff = lds_byte(wc * 32 + fr, fq * 8);
#define PG8_SA(b, h) (((b) * 2 + (h)) * HTB)
#define PG8_SB(b, h) ((4 + (b) * 2 + (h)) * HTB)
#ifndef MK_STAGE_AUX
#define MK_STAGE_AUX 1
#endif
#define PG8_STAGE(bufoff, gbase, voff) do { _Pragma("unroll") for (int _i = 0; _i < 2; ++_i) \
        __builtin_amdgcn_global_load_lds((const unsigned*)((const char*)(gbase) + (voff)[_i]), (PG8_LAS unsigned*)(lds + (bufoff) + ldsw + _i * 8192), 16, 0, MK_STAGE_AUX); } while (0)
#define PG8_LDA(dst, b, h) do { _Pragma("unroll") for (int m = 0; m < 4; ++m) _Pragma("unroll") for (int k = 0; k < 2; ++k) dst[m][k] = *(const PG8_LAS bf16x8*)(lds + PG8_SA(b, h) + aoff + m * 2048 + k * 1024); } while (0)
#define PG8_LDB(dst, b, h) do { _Pragma("unroll") for (int n = 0; n < 2; ++n) _Pragma("unroll") for (int k = 0; k < 2; ++k) dst[n][k] = *(const PG8_LAS bf16x8*)(lds + PG8_SB(b, h) + boff + n * 2048 + k * 1024); } while (0)
#ifndef MK_NOPRIO
#define PG8_PRIO(x) __builtin_amdgcn_s_setprio(x)
#else
#define PG8_PRIO(x) do { } while (0)
#endif
#if !defined(MK_MMA_PLAIN)
#define PG8_MM1(ai, bj, At, Bt, m, n, k) acc[ai][bj][m][n] = __builtin_amdgcn_mfma_f32_16x16x32_bf16(Bt[n][k], At[m][k], acc[ai][bj][m][n], 0, 0, 0); __builtin_amdgcn_sched_barrier(0)
#define PG8_MMA(ai, bj, At, Bt) do { PG8_PRIO(1); _Pragma("unroll") for (int k = 0; k < 2; ++k) { PG8_MM1(ai, bj, At, Bt, 0, 0, k); PG8_MM1(ai, bj, At, Bt, 0, 1, k); PG8_MM1(ai, bj, At, Bt, 1, 1, k); PG8_MM1(ai, bj, At, Bt, 1, 0, k); \
        PG8_MM1(ai, bj, At, Bt, 2, 0, k); PG8_MM1(ai, bj, At, Bt, 2, 1, k); PG8_MM1(ai, bj, At, Bt, 3, 1, k); PG8_MM1(ai, bj, At, Bt, 3, 0, k); } PG8_PRIO(0); } while (0)
#else
#define PG8_MMA(ai, bj, At, Bt) do { PG8_PRIO(1); _Pragma("unroll") for (int m = 0; m < 4; ++m) _Pragma("unroll") for (int n = 0; n < 2; ++n) _Pragma("unroll") for (int k = 0; k < 2; ++k) \
        acc[ai][bj][m][n] = __builtin_amdgcn_mfma_f32_16x16x32_bf16(Bt[n][k], At[m][k], acc[ai][bj][m][n], 0, 0, 0); PG8_PRIO(0); } while (0)
#endif
#if !defined(MK_MMA_PLAIN)
#define PG8_MMAR(ai, bj, At, Bt) do { PG8_PRIO(1); _Pragma("unroll") for (int k = 1; k >= 0; --k) { PG8_MM1(ai, bj, At, Bt, 3, 0, k); PG8_MM1(ai, bj, At, Bt, 3, 1, k); PG8_MM1(ai, bj, At, Bt, 2, 1, k); PG8_MM1(ai, bj, At, Bt, 2, 0, k); \
        PG8_MM1(ai, bj, At, Bt, 1, 0, k); PG8_MM1(ai, bj, At, Bt, 1, 1, k); PG8_MM1(ai, bj, At, Bt, 0, 1, k); PG8_MM1(ai, bj, At, Bt, 0, 0, k); } PG8_PRIO(0); } while (0)
#define PG8_MMAX(ai) do { PG8_MMA(ai, 0, At, B0); PG8_MMAR(ai, 1, At, B1); } while (0)
#else
#define PG8_MMAX(ai) do { PG8_MMA(ai, 0, At, B0); PG8_MMA(ai, 1, At, B1); } while (0)
#endif
#define PG8_WAIT_V(n) asm volatile("s_waitcnt vmcnt(" #n ")" ::: "memory")
#define PG8_WAIT_L(n) asm volatile("s_waitcnt lgkmcnt(" #n ")" ::: "memory")
#define PG8_BAR __builtin_amdgcn_s_barrier()
#define PG8_SCHED __builtin_amdgcn_sched_barrier(0)
    Unit cur, nxt; int ui = 0;
    if (!S.next(0, cur)) return;
    f32x4 acc[2][2][4][2];
#pragma unroll
    for (int a = 0; a < 2; ++a)
#pragma unroll
        for (int b = 0; b < 2; ++b)
#pragma unroll
            for (int m = 0; m < 4; ++m)
#pragma unroll
                for (int n = 0; n < 2; ++n) acc[a][b][m][n] = (f32x4){0.f, 0.f, 0.f, 0.f};
    bf16x8 At[4][2], B0[2][2], B1[2][2];
    const char* cA = (const char*)g.A + (size_t)cur.pm * tstepA + (size_t)(cur.pn >> 1) * (size_t)g.agrp * 2 + (size_t)cur.xa * 2; const char* cB = (const char*)g.Bt + (size_t)cur.pn * tstepB + (size_t)cur.xb * 2;
    if constexpr (Epi::RSTD_LDS) E.begin(cur, tid);
    if constexpr (SP2) {
    PG8_STAGE(PG8_SB(0, 0), cB, voffB); PG8_STAGE(PG8_SB(0, 1), cB + hstepB, voffB); PG8_STAGE(PG8_SA(0, 0), cA, voffA); PG8_STAGE(PG8_SA(0, 1), cA + hstepA, voffA);
    if (wr == 1) PG8_BAR;
    PG8_WAIT_V(2); PG8_BAR;
    PG8_STAGE(PG8_SB(1, 0), cB + kstep, voffB); PG8_STAGE(PG8_SA(1, 0), cA + kstep, voffA); PG8_STAGE(PG8_SB(1, 1), cB + hstepB + kstep, voffB);
    PG8_WAIT_V(6); PG8_BAR;
    } else {
    PG8_STAGE(PG8_SB(0, 0), cB, voffB); PG8_STAGE(PG8_SA(0, 0), cA, voffA); PG8_STAGE(PG8_SB(0, 1), cB + hstepB, voffB); PG8_STAGE(PG8_SA(0, 1), cA + hstepA, voffA);
    if (wr == 1) PG8_BAR;
    PG8_WAIT_V(4); PG8_BAR;
    PG8_STAGE(PG8_SB(1, 0), cB + kstep, voffB); PG8_STAGE(PG8_SA(1, 0), cA + kstep, voffA); PG8_STAGE(PG8_SB(1, 1), cB + hstepB + kstep, voffB);
    PG8_WAIT_V(6); PG8_BAR;
    }
    for (;;) {
        const bool has_next = S.next(ui + 1, nxt);
        const char* nA = has_next ? (const char*)g.A + (size_t)nxt.pm * tstepA + (size_t)(nxt.pn >> 1) * (size_t)g.agrp * 2 + (size_t)nxt.xa * 2 : cA; const char* nB = has_next ? (const char*)g.Bt + (size_t)nxt.pn * tstepB + (size_t)nxt.xb * 2 : cB;
        for (int t = 0; t < nt; t += 2) {
            const bool last = (t == nt - 2);
            if constexpr (Epi::RSTD_LDS) { if (last) E.late(tid); }
            const char* a1 = cA + (size_t)(t + 1) * kstep;
            const char* a2 = last ? nA : cA + (size_t)(t + 2) * kstep; const char* b2 = last ? nB : cB + (size_t)(t + 2) * kstep;
            const char* a3 = a2 + kstep; const char* b3 = b2 + kstep;
            if constexpr (SP2) {
            PG8_LDB(B0, 0, 0); PG8_LDB(B1, 0, 1); PG8_SCHED; PG8_LDA(At, 0, 0); PG8_STAGE(PG8_SA(1, 1), a1 + hstepA, voffA);
            PG8_WAIT_V(8); PG8_WAIT_L(0); PG8_BAR; PG8_MMAX(0); PG8_BAR; PG8_SCHED;
            PG8_LDA(At, 0, 1); PG8_STAGE(PG8_SB(0, 0), b2, voffB); PG8_STAGE(PG8_SB(0, 1), b2 + hstepB, voffB); PG8_STAGE(PG8_SA(0, 0), a2, voffA);
            PG8_WAIT_V(8); PG8_WAIT_L(0); PG8_BAR; PG8_MMAX(1); PG8_BAR; PG8_SCHED;
            PG8_LDB(B0, 1, 0); PG8_LDB(B1, 1, 1); PG8_SCHED; PG8_LDA(At, 1, 0); PG8_STAGE(PG8_SA(0, 1), a2 + hstepA, voffA);
            PG8_WAIT_V(8); PG8_WAIT_L(0); PG8_BAR; PG8_MMAX(0); PG8_BAR; PG8_SCHED;
            PG8_LDA(At, 1, 1); PG8_STAGE(PG8_SB(1, 0), b3, voffB); PG8_STAGE(PG8_SB(1, 1), b3 + hstepB, voffB); PG8_STAGE(PG8_SA(1, 0), a3, voffA);
            PG8_WAIT_V(8); PG8_WAIT_L(0); PG8_BAR; PG8_MMAX(1); PG8_BAR; PG8_SCHED;
            } else {
            PG8_LDB(B0, 0, 0); PG8_SCHED; PG8_LDA(At, 0, 0); PG8_STAGE(PG8_SA(1, 1), a1 + hstepA, voffA);
            PG8_WAIT_L(8); PG8_BAR; PG8_WAIT_L(0); PG8_MMA(0, 0, At, B0); PG8_BAR; PG8_SCHED;
            PG8_LDB(B1, 0, 1); PG8_STAGE(PG8_SB(0, 0), b2, voffB);
            PG8_BAR; PG8_WAIT_L(0); PG8_MMA(0, 1, At, B1); PG8_BAR;
            PG8_LDA(At, 0, 1); PG8_STAGE(PG8_SA(0, 0), a2, voffA);
            PG8_BAR; PG8_WAIT_L(0); PG8_MMA(1, 0, At, B0); PG8_BAR; PG8_SCHED;
            PG8_STAGE(PG8_SB(0, 1), b2 + hstepB, voffB);
            PG8_WAIT_V(6); PG8_BAR; PG8_MMA(1, 1, At, B1); PG8_BAR;
            PG8_LDB(B0, 1, 0); PG8_SCHED; PG8_LDA(At, 1, 0); PG8_STAGE(PG8_SA(0, 1), a2 + hstepA, voffA);
            PG8_WAIT_L(8); PG8_BAR; PG8_WAIT_L(0); PG8_MMA(0, 0, At, B0); PG8_BAR; PG8_SCHED;
            PG8_LDB(B1, 1, 1); PG8_STAGE(PG8_SB(1, 0), b3, voffB);
            PG8_BAR; PG8_WAIT_L(0); PG8_MMA(0, 1, At, B1); PG8_BAR;
            PG8_LDA(At, 1, 1); PG8_STAGE(PG8_SA(1, 0), a3, voffA);
            PG8_BAR; PG8_WAIT_L(0); PG8_MMA(1, 0, At, B0); PG8_BAR; PG8_SCHED;
            PG8_STAGE(PG8_SB(1, 1), b3 + hstepB, voffB);
            PG8_WAIT_V(6); PG8_BAR; PG8_MMA(1, 1, At, B1); PG8_BAR;
            }
        }
        if (wr == 0) PG8_BAR;
        E(acc, cur, wr, wc, fr, fq);
#if defined(MK_EPI_TWICE)
        if (Epi::TWICE_OK) { asm volatile("" ::: "memory"); E(acc, cur, wr, wc, fr, fq); }
#endif
        if (!has_next) break;
#pragma unroll
        for (int a = 0; a < 2; ++a)
#pragma unroll
            for (int b = 0; b < 2; ++b)
#pragma unroll
                for (int m = 0; m < 4; ++m)
#pragma unroll
                    for (int n = 0; n < 2; ++n) acc[a][b][m][n] = (f32x4){0.f, 0.f, 0.f, 0.f};
        cur = nxt; cA = nA; cB = nB; ++ui;
        if constexpr (Epi::RSTD_LDS) E.begin(cur, tid);
        if (wr == 1) PG8_BAR;
    }
    PG8_WAIT_V(0);
    PG8_BAR;
#undef PG8_SA
#undef PG8_SB
#undef PG8_STAGE
#undef PG8_LDA
#undef PG8_LDB
#undef PG8_MMA
#undef PG8_MM1
#undef PG8_MMAR
#undef PG8_MMAX
#undef PG8_WAIT_V
#undef PG8_WAIT_L
#undef PG8_BAR
#undef PG8_SCHED
}
}
#ifndef MK_RESID_BF16
#define MK_RESID_BF16 1
#endif
namespace pg8 {
constexpr float RMS_EPS = 1e-6f;
constexpr int DM = 2048;
constexpr int LDS_RED_OFF = 131072 + 1024, LDS_RSL_OFF = 131072 + 5120, LDS_RAW_OFF = 131072 + 6144;
struct RstdLds {
    const float* ssq; PG8_LAS unsigned char* lds;
    __device__ __forceinline__ void begin(const Unit& u, int tid) const {
        const int w = __builtin_amdgcn_readfirstlane(tid >> 6), lane = tid & 63;
        __builtin_amdgcn_global_load_lds((const unsigned*)(ssq + ((size_t)(u.pm * BM + 32 * w)) * 8 + 4 * lane), (PG8_LAS unsigned*)(lds + LDS_RAW_OFF + w * 1024), 16, 0, 0);
    }
    __device__ __forceinline__ void late(int tid) const {
        const f32x4 v = *(const PG8_LAS f32x4*)(lds + LDS_RAW_OFF + tid * 16);
        float s = (v[0] + v[1]) + (v[2] + v[3]); s += __shfl_xor(s, 1);
        if ((tid & 1) == 0) ((PG8_LAS float*)(lds + LDS_RSL_OFF))[tid >> 1] = __builtin_amdgcn_rsqf(s * (1.0f / DM) + RMS_EPS);
    }
    __device__ __forceinline__ void rows8(int wr, int fr, float (&r)[2][4]) const {
        const PG8_LAS float* rsl = (const PG8_LAS float*)(lds + LDS_RSL_OFF);
#pragma unroll
        for (int ai = 0; ai < 2; ++ai)
#pragma unroll
            for (int m = 0; m < 4; ++m) r[ai][m] = rsl[ai * HALF + wr * 64 + m * 16 + fr];
    }
};
__device__ __forceinline__ float fast_sigmoid(float x) { return __builtin_amdgcn_rcpf(1.0f + __builtin_amdgcn_exp2f(-1.4426950408889634f * x)); }
__device__ __forceinline__ float fast_silu(float x) { return x * fast_sigmoid(x); }
__device__ __forceinline__ float fast_gelu_tanh(float x) { return x * fast_sigmoid(1.5957691216057308f * (x + 0.044715f * x * x * x)); }

struct EpiSwiglu {
    static constexpr bool PERM = true, TWICE_OK = true, RSTD_LDS = true;
    bf16_t* H; int ldh; RstdLds R;
    __device__ __forceinline__ void begin(const Unit& u, int tid) const { R.begin(u, tid); }
    __device__ __forceinline__ void late(int tid) const { R.late(tid); }
    __device__ __forceinline__ void operator()(const f32x4 (&acc)[2][2][4][2], const Unit& u, int wr, int wc, int fr, int fq) const {
        float rs[2][4]; R.rows8(wr, fr, rs);
        const int row0 = u.pm * BM + wr * 64 + fr, col0 = u.pn * HALF + wc * 32 + 8 * fq;
#pragma unroll
        for (int ai = 0; ai < 2; ++ai)
#pragma unroll
            for (int m = 0; m < 4; ++m) { const float r = rs[ai][m]; float v[8];
#pragma unroll
                for (int n = 0; n < 2; ++n)
#pragma unroll
                    for (int i = 0; i < 4; ++i) v[4 * n + i] = fast_silu(acc[ai][0][m][n][i] * r) * (acc[ai][1][m][n][i] * r);
                u32x4 w; w.x = cvt_pk_bf16(v[0], v[1]); w.y = cvt_pk_bf16(v[2], v[3]); w.z = cvt_pk_bf16(v[4], v[5]); w.w = cvt_pk_bf16(v[6], v[7]);
#if defined(MK_HID_NT)
                __builtin_nontemporal_store(w, (u32x4*)(H + (size_t)(row0 + ai * HALF + m * 16) * ldh + col0)); }
#else
                *(u32x4*)(H + (size_t)(row0 + ai * HALF + m * 16) * ldh + col0) = w; }
#endif
    }
};
template <bool BIAS, bool SCALE> struct EpiResid {
    static constexpr bool PERM = true, TWICE_OK = false, RSTD_LDS = false;
    bf16_t* XH; bf16_t* XB; float* ssq; const float* bias; const float* cscale; float alpha; PG8_LAS float* red;
    __device__ __forceinline__ void operator()(const f32x4 (&acc)[2][2][4][2], const Unit& u, int wr, int wc, int fr, int fq) const {
        const int row0 = u.pm * BM + wr * 64 + fr, col0 = u.pn * BM + wc * 32 + 8 * fq;
        f32x4 bv[2][2], mv[2][2];
#pragma unroll
        for (int bj = 0; bj < 2; ++bj)
#pragma unroll
            for (int n = 0; n < 2; ++n) { bv[bj][n] = BIAS ? *(const f32x4*)(bias + col0 + bj * HALF + 4 * n) : (f32x4){0.f, 0.f, 0.f, 0.f};
                                          mv[bj][n] = SCALE ? *(const f32x4*)(cscale + col0 + bj * HALF + 4 * n) * alpha : (f32x4){alpha, alpha, alpha, alpha}; }
#if !defined(MK_RESID_NOPRE)
        constexpr bool L16 = !BIAS && !SCALE;
#else
        constexpr bool L16 = false;
#endif
#ifndef MK_RESID_NPRE
#define MK_RESID_NPRE 2
#endif
        constexpr int NPRE = L16 ? MK_RESID_NPRE : 0;
        u32x4 xo2[2][4][2];
        if constexpr (L16) {
#pragma unroll
            for (int ai = 0; ai < 2; ++ai)
#pragma unroll
                for (int m = 0; m < (ai ? NPRE : 4); ++m)
#pragma unroll
                    for (int bj = 0; bj < 2; ++bj) xo2[ai][m][bj] = *(const u32x4*)((MK_RESID_BF16 ? XB : XH) + (size_t)(row0 + ai * HALF + m * 16) * DM + col0 + bj * HALF);
        }
#pragma unroll
        for (int ai = 0; ai < 2; ++ai) { u32x4 xo[4][2];
#pragma unroll
            for (int m = 0; m < 4; ++m)
#pragma unroll
                for (int bj = 0; bj < 2; ++bj) { if (L16 && (ai == 0 || m < NPRE)) xo[m][bj] = xo2[ai][m][bj]; else xo[m][bj] = *(const u32x4*)((MK_RESID_BF16 ? XB : XH) + (size_t)(row0 + ai * HALF + m * 16) * DM + col0 + bj * HALF); }
#pragma unroll
            for (int m = 0; m < 4; ++m) { const int row = row0 + ai * HALF + m * 16; const size_t off = (size_t)row * DM + col0; float ss = 0.f;
#pragma unroll
                for (int bj = 0; bj < 2; ++bj) { const u32x4 q = xo[m][bj];
                    const f32x4 x0 = MK_RESID_BF16 ? (f32x4){__uint_as_float(q.x << 16), __uint_as_float(q.x & 0xffff0000u), __uint_as_float(q.y << 16), __uint_as_float(q.y & 0xffff0000u)} : (f32x4){h_lo(q.x), h_hi(q.x), h_lo(q.y), h_hi(q.y)};
                    const f32x4 x1 = MK_RESID_BF16 ? (f32x4){__uint_as_float(q.z << 16), __uint_as_float(q.z & 0xffff0000u), __uint_as_float(q.w << 16), __uint_as_float(q.w & 0xffff0000u)} : (f32x4){h_lo(q.z), h_hi(q.z), h_lo(q.w), h_hi(q.w)};
                    f32x4 a0 = acc[ai][bj][m][0], a1 = acc[ai][bj][m][1]; if (BIAS) { a0 = a0 + bv[bj][0]; a1 = a1 + bv[bj][1]; }
                    const f32x4 v0 = x0 + a0 * mv[bj][0], v1 = x1 + a1 * mv[bj][1];
                    u32x4 w; w.x = cvt_pk_bf16(v0[0], v0[1]); w.y = cvt_pk_bf16(v0[2], v0[3]); w.z = cvt_pk_bf16(v1[0], v1[1]); w.w = cvt_pk_bf16(v1[2], v1[3]);
                    *(u32x4*)(XB + off + bj * HALF) = w;
                    if (MK_RESID_BF16) {
                        const float r0 = __uint_as_float(w.x << 16), r1 = __uint_as_float(w.x & 0xffff0000u), r2 = __uint_as_float(w.y << 16), r3 = __uint_as_float(w.y & 0xffff0000u);
                        const float r4 = __uint_as_float(w.z << 16), r5 = __uint_as_float(w.z & 0xffff0000u), r6 = __uint_as_float(w.w << 16), r7 = __uint_as_float(w.w & 0xffff0000u);
                        ss += ((r0 * r0 + r1 * r1) + (r2 * r2 + r3 * r3)) + ((r4 * r4 + r5 * r5) + (r6 * r6 + r7 * r7));
                    } else {
                        u32x4 wh; wh.x = cvt_pk_h16(v0[0], v0[1]); wh.y = cvt_pk_h16(v0[2], v0[3]); wh.z = cvt_pk_h16(v1[0], v1[1]); wh.w = cvt_pk_h16(v1[2], v1[3]);
                        *(u32x4*)(XH + off + bj * HALF) = wh;
                        ss += ((v0[0] * v0[0] + v0[1] * v0[1]) + (v0[2] * v0[2] + v0[3] * v0[3])) + ((v1[0] * v1[0] + v1[1] * v1[1]) + (v1[2] * v1[2] + v1[3] * v1[3])); } }
                ss += __shfl_xor(ss, 16); ss += __shfl_xor(ss, 32);
                if (fq == 0) red[(ai * HALF + wr * 64 + m * 16 + fr) * 4 + wc] = ss; }
            asm volatile("" ::: "memory"); }
        asm volatile("s_waitcnt lgkmcnt(0)" ::: "memory"); __builtin_amdgcn_s_barrier(); asm volatile("" ::: "memory");
        { const int t = threadIdx.x; if (t < BM) { const f32x4 r4 = *(const PG8_LAS f32x4*)(red + 4 * t); ssq[((size_t)(u.pm * BM + t)) * 8 + u.pn] = (r4[0] + r4[1]) + (r4[2] + r4[3]); } }
        asm volatile("s_waitcnt lgkmcnt(0)" ::: "memory"); __builtin_amdgcn_s_barrier(); asm volatile("" ::: "memory");
    }
};
struct EpiResidFinal {
    static constexpr bool PERM = true, TWICE_OK = false, RSTD_LDS = false;
    const bf16_t* XB; float* ssq; float alpha; PG8_LAS float* red; PG8_LAS float* rsl; float* out; const float* gfin; unsigned* cnt; unsigned* tmo;
    __device__ __forceinline__ void operator()(const f32x4 (&acc_)[2][2][4][2], const Unit& u, int wr, int wc, int fr_, int fq) const {
        f32x4 (&acc)[2][2][4][2] = const_cast<f32x4 (&)[2][2][4][2]>(acc_);
        int fr = fr_; asm volatile("" : "+v"(fr));
        const int rb = wr * 64 + fr, row0 = u.pm * BM + rb, col0 = u.pn * BM + wc * 32 + 8 * fq;
#pragma unroll
        for (int ai = 0; ai < 2; ++ai) { u32x4 xo[4][2];
#pragma unroll
            for (int m = 0; m < 4; ++m)
#pragma unroll
                for (int bj = 0; bj < 2; ++bj) xo[m][bj] = *(const u32x4*)(XB + (size_t)(row0 + ai * HALF + m * 16) * DM + col0 + bj * HALF);
#pragma unroll
            for (int m = 0; m < 4; ++m) { float ss = 0.f;
#pragma unroll
                for (int bj = 0; bj < 2; ++bj) { const u32x4 q = xo[m][bj];
                    const f32x4 x0 = (f32x4){__uint_as_float(q.x << 16), __uint_as_float(q.x & 0xffff0000u), __uint_as_float(q.y << 16), __uint_as_float(q.y & 0xffff0000u)};
                    const f32x4 x1 = (f32x4){__uint_as_float(q.z << 16), __uint_as_float(q.z & 0xffff0000u), __uint_as_float(q.w << 16), __uint_as_float(q.w & 0xffff0000u)};
                    const f32x4 v0 = x0 + acc[ai][bj][m][0] * alpha, v1 = x1 + acc[ai][bj][m][1] * alpha; acc[ai][bj][m][0] = v0; acc[ai][bj][m][1] = v1;
                    ss += ((v0[0] * v0[0] + v0[1] * v0[1]) + (v0[2] * v0[2] + v0[3] * v0[3])) + ((v1[0] * v1[0] + v1[1] * v1[1]) + (v1[2] * v1[2] + v1[3] * v1[3])); }
                ss += __shfl_xor(ss, 16); ss += __shfl_xor(ss, 32);
                if (fq == 0) red[(ai * HALF + m * 16 + rb) * 4 + wc] = ss; }
            asm volatile("" ::: "memory"); }
        asm volatile("s_waitcnt lgkmcnt(0)" ::: "memory"); __builtin_amdgcn_s_barrier(); asm volatile("" ::: "memory");
        const int t = threadIdx.x;
        if (t < BM) { const f32x4 r4 = *(const PG8_LAS f32x4*)(red + 4 * t); ssq[((size_t)(u.pm * BM + t)) * 8 + u.pn] = (r4[0] + r4[1]) + (r4[2] + r4[3]); }
        asm volatile("s_waitcnt vmcnt(0) lgkmcnt(0)" ::: "memory"); __builtin_amdgcn_s_barrier(); asm volatile("" ::: "memory");
        if (t == 0) { unsigned* cw = cnt + 64 * u.pm;
            __builtin_amdgcn_fence(__ATOMIC_RELEASE, "agent"); asm volatile("s_waitcnt vmcnt(0)" ::: "memory");
            (void)__hip_atomic_fetch_add(cw, 1u, __ATOMIC_RELAXED, __HIP_MEMORY_SCOPE_AGENT);
            unsigned sp = 0;
            while (__hip_atomic_load(cw, __ATOMIC_RELAXED, __HIP_MEMORY_SCOPE_AGENT) < 8u) { __builtin_amdgcn_s_sleep(1);
                if ((++sp & 255u) == 0u) { if (__hip_atomic_load(tmo, __ATOMIC_RELAXED, __HIP_MEMORY_SCOPE_AGENT)) break; if (sp > (1u << 18)) { atomicAdd(tmo, 1u); break; } } }
            __builtin_amdgcn_fence(__ATOMIC_ACQUIRE, "agent"); asm volatile("s_waitcnt vmcnt(0)" ::: "memory"); }
        asm volatile("" ::: "memory"); __builtin_amdgcn_s_barrier(); asm volatile("" ::: "memory");
        if (t < BM) { const f32x4* sp4 = (const f32x4*)(ssq + ((size_t)(u.pm * BM + t)) * 8); const f32x4 a = sp4[0], b = sp4[1];
            rsl[t] = __builtin_amdgcn_rsqf((((a[0] + a[1]) + (a[2] + a[3])) + ((b[0] + b[1]) + (b[2] + b[3]))) * (1.0f / DM) + RMS_EPS); }
        asm volatile("s_waitcnt vmcnt(0) lgkmcnt(0)" ::: "memory"); __builtin_amdgcn_s_barrier(); asm volatile("" ::: "memory");
        f32x4 gv[2][2];
#pragma unroll
        for (int bj = 0; bj < 2; ++bj)
#pragma unroll
            for (int n = 0; n < 2; ++n) gv[bj][n] = *(const f32x4*)(gfin + col0 + bj * HALF + 4 * n);
#pragma unroll
        for (int ai = 0; ai < 2; ++ai)
#pragma unroll
            for (int m = 0; m < 4; ++m) { const float r = rsl[ai * HALF + m * 16 + rb]; float* op = out + (size_t)(row0 + ai * HALF + m * 16) * DM + col0;
#pragma unroll
                for (int bj = 0; bj < 2; ++bj)
#pragma unroll
                    for (int n = 0; n < 2; ++n) *(f32x4*)(op + bj * HALF + 4 * n) = acc[ai][bj][m][n] * r * gv[bj][n]; }
    }
};
struct EpiWin {
    static constexpr bool PERM = true, TWICE_OK = false, RSTD_LDS = true;
    bf16_t *U, *V, *HB; float* lnp; RstdLds R; const float* bias;
    __device__ __forceinline__ void begin(const Unit& u, int tid) const { R.begin(u, tid); }
    __device__ __forceinline__ void late(int tid) const { R.late(tid); }
    __device__ __forceinline__ void operator()(const f32x4 (&acc)[2][2][4][2], const Unit& u, int wr, int wc, int fr, int fq) const {
        float rs[2][4]; R.rows8(wr, fr, rs);
        const int row0 = u.pm * BM + wr * 64 + fr;
        if (u.pn < 8) {
            const bool isv = u.pn >= 4; bf16_t* dst = isv ? V : U;
            const int colt = (u.pn & 3) * BM + wc * 32 + 8 * fq, bcol = u.pn * BM + wc * 32 + 8 * fq;
            f32x4 bv[2][2];
#pragma unroll
            for (int bj = 0; bj < 2; ++bj)
#pragma unroll
                for (int n = 0; n < 2; ++n) bv[bj][n] = *(const f32x4*)(bias + bcol + bj * HALF + 4 * n);
#pragma unroll
            for (int ai = 0; ai < 2; ++ai)
#pragma unroll
                for (int m = 0; m < 4; ++m) { const int row = row0 + ai * HALF + m * 16; const float r = rs[ai][m]; float s1 = 0.f, s2 = 0.f;
#pragma unroll
                    for (int bj = 0; bj < 2; ++bj) { float v[8];
#pragma unroll
                        for (int n = 0; n < 2; ++n)
#pragma unroll
                            for (int i = 0; i < 4; ++i) { const float g = fast_gelu_tanh(acc[ai][bj][m][n][i] * r + bv[bj][n][i]); v[4 * n + i] = g; s1 += g; s2 += g * g; }
                        u32x4 w; w.x = cvt_pk_bf16(v[0], v[1]); w.y = cvt_pk_bf16(v[2], v[3]); w.z = cvt_pk_bf16(v[4], v[5]); w.w = cvt_pk_bf16(v[6], v[7]);
                        *(u32x4*)(dst + (size_t)row * 1024 + colt + bj * HALF) = w; }
                    if (isv) { s1 += __shfl_xor(s1, 16); s1 += __shfl_xor(s1, 32); s2 += __shfl_xor(s2, 16); s2 += __shfl_xor(s2, 32);
                        if (fq == 0) *(f32x2*)(lnp + ((size_t)row * 16 + (u.pn - 4) * 4 + wc) * 2) = (f32x2){s1, s2}; } }
        } else {
            const int j0 = (u.pn - 8) * HALF + wc * 32 + 8 * fq;
            f32x4 ba[2], bg[2];
#pragma unroll
            for (int n = 0; n < 2; ++n) { ba[n] = *(const f32x4*)(bias + 2048 + j0 + 4 * n); bg[n] = *(const f32x4*)(bias + 3072 + j0 + 4 * n); }
#pragma unroll
            for (int ai = 0; ai < 2; ++ai)
#pragma unroll
                for (int m = 0; m < 4; ++m) { const int row = row0 + ai * HALF + m * 16; const float r = rs[ai][m]; float v[8];
#pragma unroll
                    for (int n = 0; n < 2; ++n)
#pragma unroll
                        for (int i = 0; i < 4; ++i) v[4 * n + i] = (acc[ai][0][m][n][i] * r + ba[n][i]) * fast_sigmoid(acc[ai][1][m][n][i] * r + bg[n][i]);
                    u32x4 w; w.x = cvt_pk_bf16(v[0], v[1]); w.y = cvt_pk_bf16(v[2], v[3]); w.z = cvt_pk_bf16(v[4], v[5]); w.w = cvt_pk_bf16(v[6], v[7]);
                    *(u32x4*)(HB + (size_t)row * 1024 + j0) = w; }
        }
    }
};
struct EpiNone {
    static constexpr bool PERM = true, TWICE_OK = false, RSTD_LDS = false;
    __device__ __forceinline__ void operator()(const f32x4 (&acc)[2][2][4][2], const Unit&, int, int, int, int) const {
#pragma unroll
        for (int ai = 0; ai < 2; ++ai)
#pragma unroll
            for (int bj = 0; bj < 2; ++bj)
#pragma unroll
                for (int m = 0; m < 4; ++m) asm volatile("" :: "v"(acc[ai][bj][m][0]), "v"(acc[ai][bj][m][1]));
    }
};
struct EpiQ {
    static constexpr bool PERM = true, TWICE_OK = false, RSTD_LDS = true;
    bf16_t* Q; RstdLds R; float qscale;
    __device__ __forceinline__ void begin(const Unit& u, int tid) const { R.begin(u, tid); }
    __device__ __forceinline__ void late(int tid) const { R.late(tid); }
    __device__ __forceinline__ void operator()(const f32x4 (&acc)[2][2][4][2], const Unit& u, int wr, int wc, int fr, int fq) const {
        float rs[2][4]; R.rows8(wr, fr, rs);
        const int row0 = u.pm * BM + wr * 64 + fr, col0 = u.pn * BM + wc * 32 + 8 * fq;
#pragma unroll
        for (int ai = 0; ai < 2; ++ai)
#pragma unroll
            for (int m = 0; m < 4; ++m) { const float r = rs[ai][m] * qscale; bf16_t* rowp = Q + (size_t)(row0 + ai * HALF + m * 16) * DM + col0;
#pragma unroll
                for (int bj = 0; bj < 2; ++bj) { const f32x4 v0 = acc[ai][bj][m][0] * r, v1 = acc[ai][bj][m][1] * r;
                    u32x4 w; w.x = cvt_pk_bf16(v0[0], v0[1]); w.y = cvt_pk_bf16(v0[2], v0[3]); w.z = cvt_pk_bf16(v1[0], v1[1]); w.w = cvt_pk_bf16(v1[2], v1[3]);
                    *(u32x4*)(rowp + bj * HALF) = w; } }
    }
};
struct EpiKV {
    static constexpr bool PERM = true, TWICE_OK = false, RSTD_LDS = false;
    bf16_t* KB; bf16_t* VB; const float* rstd_mem;
    __device__ __forceinline__ void operator()(const f32x4 (&acc)[2][2][4][2], const Unit& u, int wr, int wc, int fr, int fq) const {
        const int row0 = u.pm * BM + wr * 64 + fr, l = (u.pn >> 3) & 3, col0 = (u.pn & 7) * BM + wc * 32 + 8 * fq; bf16_t* dst = (u.pn < 32) ? KB : VB;
#pragma unroll
        for (int ai = 0; ai < 2; ++ai)
#pragma unroll
            for (int m = 0; m < 4; ++m) { const int row = row0 + ai * HALF + m * 16; const float r = rstd_mem[row]; bf16_t* rowp = dst + ((size_t)l * 1024 + row) * DM + col0;
#pragma unroll
                for (int bj = 0; bj < 2; ++bj) { const f32x4 v0 = acc[ai][bj][m][0] * r, v1 = acc[ai][bj][m][1] * r;
                    u32x4 w; w.x = cvt_pk_bf16(v0[0], v0[1]); w.y = cvt_pk_bf16(v0[2], v0[3]); w.z = cvt_pk_bf16(v1[0], v1[1]); w.w = cvt_pk_bf16(v1[2], v1[3]);
                    *(u32x4*)(rowp + bj * HALF) = w; } }
    }
};
struct EpiPre {
    static constexpr bool PERM = true, TWICE_OK = false, RSTD_LDS = false;
    bf16_t* VWt; bf16_t* KWg;
    __device__ __forceinline__ void operator()(const f32x4 (&acc)[2][2][4][2], const Unit& u, int wr, int wc, int fr, int fq) const {
        const int e = u.id, t = e & 7, b = (e >> 3) & 3, h = (e >> 5) & 3, l = (e >> 7) & 3; const bool kw = e >= 512; const int ldc = kw ? 2048 : 1024;
        bf16_t* base = kw ? KWg + ((size_t)(l * 4 + b) * 1024 + h * 256 + wr * 64 + fr) * 2048 + t * BM + wc * 32 + 8 * fq
                          : VWt + ((size_t)(l * 4 + b) * 2048 + t * BM + wr * 64 + fr) * 1024 + h * 256 + wc * 32 + 8 * fq;
#pragma unroll
        for (int ai = 0; ai < 2; ++ai)
#pragma unroll
            for (int m = 0; m < 4; ++m) { bf16_t* rowp = base + (size_t)(ai * HALF + m * 16) * ldc;
#pragma unroll
                for (int bj = 0; bj < 2; ++bj) { const f32x4 v0 = acc[ai][bj][m][0], v1 = acc[ai][bj][m][1];
                    u32x4 w; w.x = cvt_pk_bf16(v0[0], v0[1]); w.y = cvt_pk_bf16(v0[2], v0[3]); w.z = cvt_pk_bf16(v1[0], v1[1]); w.w = cvt_pk_bf16(v1[2], v1[3]);
                    *(u32x4*)(rowp + bj * HALF) = w; } }
    }
};
struct EpiSoftmax {
    static constexpr bool PERM = true, TWICE_OK = false, RSTD_LDS = true;
    bf16_t* P; RstdLds R; float qscale; PG8_LAS float* red; PG8_LAS float* red2;
    __device__ __forceinline__ void begin(const Unit& u, int tid) const { R.begin(u, tid); }
    __device__ __forceinline__ void late(int tid) const { R.late(tid); }
    __device__ __forceinline__ void operator()(const f32x4 (&acc_)[2][2][4][2], const Unit& u, int wr, int wc, int fr_, int fq) const {
        f32x4 (&acc)[2][2][4][2] = const_cast<f32x4 (&)[2][2][4][2]>(acc_);
        int fr = fr_; asm volatile("" : "+v"(fr));
        const int rb = wr * 64 + fr;
        const PG8_LAS float* rsl = (const PG8_LAS float*)(R.lds + LDS_RSL_OFF) + rb;
        PG8_LAS float* r1 = red + 4 * rb; PG8_LAS float* r2 = red2 + 4 * rb;
#pragma unroll
        for (int ai = 0; ai < 2; ++ai)
#pragma unroll
            for (int m = 0; m < 4; ++m) { float mx = acc[ai][0][m][0][0];
#pragma unroll
                for (int bj = 0; bj < 2; ++bj)
#pragma unroll
                    for (int n = 0; n < 2; ++n)
#pragma unroll
                        for (int i = 0; i < 4; ++i) mx = fmaxf(mx, acc[ai][bj][m][n][i]);
                mx = fmaxf(mx, __shfl_xor(mx, 16)); mx = fmaxf(mx, __shfl_xor(mx, 32));
                if (fq == 0) r1[(ai * HALF + m * 16) * 4 + wc] = mx * (rsl[ai * HALF + m * 16] * qscale); }
        asm volatile("s_waitcnt lgkmcnt(0)" ::: "memory"); __builtin_amdgcn_s_barrier(); asm volatile("" ::: "memory");
#pragma unroll
        for (int ai = 0; ai < 2; ++ai)
#pragma unroll
            for (int m = 0; m < 4; ++m) { const f32x4 m4 = *(const PG8_LAS f32x4*)(r1 + (ai * HALF + m * 16) * 4);
                const float mx = fmaxf(fmaxf(m4[0], m4[1]), fmaxf(m4[2], m4[3])), r = rsl[ai * HALF + m * 16] * qscale; float sum = 0.f;
#pragma unroll
                for (int bj = 0; bj < 2; ++bj)
#pragma unroll
                    for (int n = 0; n < 2; ++n)
#pragma unroll
                        for (int i = 0; i < 4; ++i) { const float pz = __builtin_amdgcn_exp2f(acc[ai][bj][m][n][i] * r - mx); acc[ai][bj][m][n][i] = pz; sum += pz; }
                sum += __shfl_xor(sum, 16); sum += __shfl_xor(sum, 32);
                if (fq == 0) r2[(ai * HALF + m * 16) * 4 + wc] = sum; }
        asm volatile("s_waitcnt lgkmcnt(0)" ::: "memory"); __builtin_amdgcn_s_barrier(); asm volatile("" ::: "memory");
        bf16_t* base = P + (size_t)(u.pm * BM + rb) * 1024 + u.pn * BM + wc * 32 + 8 * fq;
#pragma unroll
        for (int ai = 0; ai < 2; ++ai)
#pragma unroll
            for (int m = 0; m < 4; ++m) { const f32x4 s4 = *(const PG8_LAS f32x4*)(r2 + (ai * HALF + m * 16) * 4);
                const float inv = __builtin_amdgcn_rcpf((s4[0] + s4[1]) + (s4[2] + s4[3])); bf16_t* rowp = base + (size_t)(ai * HALF + m * 16) * 1024;
#pragma unroll
                for (int bj = 0; bj < 2; ++bj) { const f32x4 v0 = acc[ai][bj][m][0] * inv, v1 = acc[ai][bj][m][1] * inv;
                    u32x4 w; w.x = cvt_pk_bf16(v0[0], v0[1]); w.y = cvt_pk_bf16(v0[2], v0[3]); w.z = cvt_pk_bf16(v1[0], v1[1]); w.w = cvt_pk_bf16(v1[2], v1[3]);
                    *(u32x4*)(rowp + bj * HALF) = w; } }
    }
};
}
namespace mk {
using pg8::bf16_t; using pg8::bf16x8; using pg8::f32x4; using pg8::f32x2; using pg8::u32x4; using pg8::u32x2;
#define LAS __attribute__((address_space(3)))
typedef unsigned short bf16;
constexpr int D = 2048, NB = 4, S = 2048, M = NB * S, F = 5632, NM = 256, MM = NB * NM, NL = 4, NWAVES = 8, NTHREADS = 512;
constexpr float EPS = 1e-6f;
constexpr float QSCALE = 0.044194173824159216f * 1.4426950408889634f;

constexpr size_t MiB = 1u << 20;
constexpr size_t WS_CTL = 0, CTL_BYTES = 1 * MiB;
constexpr size_t SZ_WGU = (size_t)2 * F * D * 2, SZ_WDN = (size_t)D * F * 2, SZ_SQ = (size_t)D * D * 2;
constexpr size_t WS_WGU = 1 * MiB;
constexpr size_t WS_WDN = WS_WGU + 8 * SZ_WGU;
constexpr size_t WS_WQ = WS_WDN + 8 * SZ_WDN;
constexpr size_t WS_WO = WS_WQ + 4 * SZ_SQ;
constexpr size_t WS_WK = WS_WO + 4 * SZ_SQ;
constexpr size_t WS_WV = WS_WK + 4 * SZ_SQ;
constexpr size_t WS_WIN = WS_WV + 4 * SZ_SQ;
constexpr size_t WS_WOUT = WS_WIN + 2 * 2 * SZ_SQ;
constexpr size_t WS_WPOOL = WS_WOUT + 2 * SZ_SQ;
constexpr size_t WS_WSG = WS_WPOOL + 2 * (size_t)2048 * 512 * 2;
constexpr size_t WS_X = WS_WSG + 2 * (size_t)8 * 128 * 128 * 2;
constexpr size_t WS_XB = WS_X + (size_t)M * D * 4;
constexpr size_t WS_SSQ = WS_XB + (size_t)M * D * 2;
constexpr size_t WS_LNP = WS_SSQ + (size_t)M * 32 * 4;
constexpr size_t WS_MEMB = WS_LNP + (size_t)M * 32 * 4;
constexpr size_t WS_RMEM = WS_MEMB + (size_t)MM * D * 2;
constexpr size_t WS_KB = WS_RMEM + 4096;
constexpr size_t WS_VT = WS_KB + (size_t)NL * MM * D * 2;
constexpr size_t WS_HID = WS_VT + (size_t)NL * MM * D * 2;
constexpr size_t WS_U = WS_HID, WS_V = WS_U + (size_t)M * 1024 * 2, WS_HB = WS_V + (size_t)M * 1024 * 2, WS_YC = WS_HB + (size_t)M * 1024 * 2;
constexpr size_t WS_DD = WS_HID;
constexpr size_t WS_Q = WS_HID, WS_O = WS_Q + (size_t)M * D * 2;
constexpr size_t WS_P = WS_O;
constexpr size_t WS_VW = (WS_HID + (size_t)M * F * 2 + 4095) & ~(size_t)4095;
constexpr size_t WS_KW = WS_VW + (size_t)NL * NB * D * 1024 * 2;
constexpr size_t WS_END = WS_KW + (size_t)NL * NB * 1024 * D * 2;
static_assert(WS_YC + (size_t)M * D * 2 <= WS_HID + (size_t)M * F * 2 && WS_O + (size_t)M * D * 2 <= WS_HID + (size_t)M * F * 2, "overlays fit in HID");

constexpr int RING_BYTES = 131072, LDSCTL_OFF = RING_BYTES, MISC_OFF = LDSCTL_OFF + 320, LDS_RED2_OFF = 147456, LDS_BYTES = 151552;

typedef unsigned v4u __attribute__((ext_vector_type(4)));
#define LDS_WAIT() asm volatile("s_waitcnt lgkmcnt(0)" ::: "memory")
#define VM_WAIT() asm volatile("s_waitcnt vmcnt(0)" ::: "memory")
__device__ __forceinline__ unsigned f2bf(float f) { unsigned u = __builtin_bit_cast(unsigned, f); return (u + 0x7fffu + ((u >> 16) & 1u)) >> 16; }
__device__ __forceinline__ unsigned pk2(float lo, float hi) { return f2bf(lo) | (f2bf(hi) << 16); }
__device__ __forceinline__ float bflo(unsigned w) { return __builtin_bit_cast(float, w << 16); }
__device__ __forceinline__ float bfhi(unsigned w) { return __builtin_bit_cast(float, w & 0xffff0000u); }
__device__ __forceinline__ float wave_sum(float v) {
#pragma unroll
    for (int o = 1; o < 64; o <<= 1) v += __shfl_xor(v, o);
    return v;
}
typedef __attribute__((address_space(1))) unsigned gu32;
#define RLX_AGENT __ATOMIC_RELAXED, __HIP_MEMORY_SCOPE_AGENT
#define XB_TMO      128
#define XB_XCNT(j)  (256  + 64 * (j))
#define XB_XSUB(j)  (1280 + 64 * (j))
#define XB_XGEN(j)  (2304 + 64 * (j))
#define XB_TOP      3328
#define XB_TOPGEN   3392
#define XCD_BAR_WORDS 3456
#define XB_SPIN_CAP (1u << 18)

__device__ __forceinline__ unsigned xb_ld(unsigned* p)              { return __hip_atomic_load(p, __ATOMIC_RELAXED, __HIP_MEMORY_SCOPE_AGENT); }
__device__ __forceinline__ unsigned xb_add(unsigned* p, unsigned v) { return __hip_atomic_fetch_add(p, v, __ATOMIC_RELAXED, __HIP_MEMORY_SCOPE_AGENT); }
__device__ __forceinline__ unsigned xb_xcc_id() { return (unsigned)__builtin_amdgcn_s_getreg((3 << 11) | 20) & 0xFu; }
#define XB_SPIN(cond, bar) do { unsigned _sp = 0; while (cond) { __builtin_amdgcn_s_sleep(1); \
    if ((++_sp & 255u) == 0u) { if (xb_ld(&(bar)[XB_TMO])) break; if (_sp > XB_SPIN_CAP) { atomicAdd(&(bar)[XB_TMO], 1u); break; } } } } while (0)

struct XcdBarrier {
    unsigned* bar; unsigned x;
    volatile LAS unsigned* st;
};

__device__ __forceinline__ XcdBarrier xcd_barrier_post(unsigned* bar, volatile LAS unsigned* st) {
    XcdBarrier b; b.bar = bar; b.x = xb_xcc_id(); b.st = st;
    if (threadIdx.x == 0) (void)xb_add(&bar[XB_XCNT(b.x)], 1u);
    return b;
}
__device__ __forceinline__ void xcd_barrier_complete(unsigned* bar, unsigned x, unsigned& nloc, unsigned& nx) {
    const unsigned G = gridDim.x * gridDim.y * gridDim.z;
    unsigned sum, cnt, mine, sp = 0u;
    for (;;) {
        sum = 0u; cnt = 0u; mine = 0u;
#pragma unroll
        for (unsigned j = 0; j < 16; ++j) { const unsigned c = xb_ld(&bar[XB_XCNT(j)]); sum += c; cnt += (c > 0u) ? 1u : 0u; }
        if (sum == G) break;
        __builtin_amdgcn_s_sleep(1);
        if ((++sp & 255u) == 0u) { if (xb_ld(&bar[XB_TMO])) break; if (sp > XB_SPIN_CAP) { atomicAdd(&bar[XB_TMO], 1u); break; } }
    }
    mine = xb_ld(&bar[XB_XCNT(x)]);
    nloc = mine > 0u ? mine : 1u; nx = cnt > 0u ? cnt : 1u;
}

__device__ __forceinline__ void xcd_barrier(const XcdBarrier& b) {
    asm volatile("s_waitcnt vmcnt(0)" ::: "memory");
    __syncthreads();
    if (threadIdx.x == 0) {
        unsigned* bar = b.bar;
        __builtin_amdgcn_s_waitcnt(0);
        unsigned nloc = b.st[0], nx = b.st[1];
        if (nloc == 0u) { xcd_barrier_complete(bar, b.x, nloc, nx); b.st[0] = nloc; b.st[1] = nx; }
        const unsigned old = xb_add(&bar[XB_XSUB(b.x)], 1u);
        const unsigned gen = old / nloc;
        if (old + 1u == (gen + 1u) * nloc) {
            __builtin_amdgcn_fence(__ATOMIC_RELEASE, "agent");
            asm volatile("s_waitcnt vmcnt(0)" ::: "memory");
            const unsigned og = xb_add(&bar[XB_TOP], 1u);
            const unsigned tg = og / nx;
            if (og + 1u == (tg + 1u) * nx) xb_add(&bar[XB_TOPGEN], 1u);
            else XB_SPIN(xb_ld(&bar[XB_TOPGEN]) == tg, bar);
            __builtin_amdgcn_fence(__ATOMIC_ACQUIRE, "agent");
            xb_add(&bar[XB_XGEN(b.x)], 1u);
            asm volatile("s_waitcnt vmcnt(0)" ::: "memory");
        } else {
            XB_SPIN(xb_ld(&bar[XB_XGEN(b.x)]) == gen, bar);
            __builtin_amdgcn_fence(__ATOMIC_ACQUIRE, "agent");
            asm volatile("s_waitcnt vmcnt(0)" ::: "memory");
        }
    }
    __syncthreads();
}

struct Ctx { LAS unsigned char* lds; int tid, lane, wave, vcu, G; unsigned char* ws; const float* const* in; };
#define WSP(T, off) ((T*)(c.ws + (off)))
__device__ __forceinline__ int deal_item(int vcu, int G, int N, int k) {
    if (G == 256 && (N & 255) == 0) return (k < (N >> 8)) ? (vcu >> 5) * (N >> 3) + (vcu & 31) + 32 * k : -1;
    const int it = vcu + k * G; return it < N ? it : -1;
}
#define SBAR() do { asm volatile("" ::: "memory"); __builtin_amdgcn_s_barrier(); asm volatile("" ::: "memory"); } while (0)

struct Job { const float* W; const float* gain; bf16* WT; int ldw, c0, K, rmul, radd, kb, nb; };
__device__ __forceinline__ void job_load(const Job& j, float (&v)[32], int lane) {
    const float* src = j.W + (size_t)(64 * j.kb + (lane >> 5)) * j.ldw + j.c0 + 32 * j.nb + (lane & 31);
#pragma unroll
    for (int i = 0; i < 32; ++i) v[i] = __builtin_nontemporal_load(src + (size_t)(2 * i) * j.ldw);
}
__device__ __forceinline__ void job_finish(const Job& j, float (&v)[32], LAS float* scr, int lane) {
    const int k0 = 64 * j.kb, n0 = 32 * j.nb;
    if (j.gain) { const float* gp = j.gain + k0 + (lane >> 5);
#pragma unroll
        for (int i = 0; i < 32; ++i) v[i] *= gp[2 * i]; }
#pragma unroll
    for (int i = 0; i < 32; ++i) scr[(2 * i + (lane >> 5)) * 33 + (lane & 31)] = v[i];
    LDS_WAIT(); asm volatile("" ::: "memory");
    const int cc = lane & 7;
#pragma unroll
    for (int q = 0; q < 4; ++q) { const int n = (lane >> 3) + 8 * q; const LAS float* sp = scr + (8 * cc) * 33 + n;
        v4u o; o.x = pk2(sp[0 * 33], sp[1 * 33]); o.y = pk2(sp[2 * 33], sp[3 * 33]); o.z = pk2(sp[4 * 33], sp[5 * 33]); o.w = pk2(sp[6 * 33], sp[7 * 33]);
        const int nn = n0 + n, drow = (nn >> 7) * j.rmul + (nn & 127) + j.radd;
        __builtin_nontemporal_store(o, (v4u*)(j.WT + (size_t)drow * j.K + k0 + 8 * cc)); }
    LDS_WAIT(); asm volatile("" ::: "memory");
}
constexpr int IT_GU = (D / 64) * (F / 32), IT_SQ = (D / 64) * (D / 32), IT_POOL = (512 / 64) * (512 / 32);
static_assert((F / 64) * (D / 32) == IT_GU, "down-projection item count equals gate/up item count");
constexpr int L_COMMON = 6 * IT_GU, L_EVEN = L_COMMON + 3 * IT_SQ, L_ODD = L_COMMON + 4 * IT_POOL, KV_ITEMS = NL * 3 * IT_SQ;
__host__ __device__ constexpr int layer_items(int l) { return (l & 1) ? L_ODD : L_EVEN; }
__host__ __device__ constexpr int mixer_items(int l) { return (l & 1) ? 4 * IT_POOL : 3 * IT_SQ; }
__device__ __forceinline__ Job decode_job(const Ctx& c, int l, int r) {
    Job j; j.c0 = 0; j.rmul = 128; j.radd = 0; j.gain = nullptr; int nblk;
    if (l < 0) { const int ll = r / (3 * IT_SQ); r -= ll * 3 * IT_SQ; const int t = r / IT_SQ; r -= t * IT_SQ;
        j.W = c.in[25 + t] + (size_t)ll * D * D; j.ldw = D; j.K = D; nblk = D / 32;
        if (t < 2) { j.gain = c.in[23] + ll * D; j.WT = WSP(bf16, t ? WS_WV : WS_WK); j.radd = ll * D; } else j.WT = WSP(bf16, WS_WO + (size_t)ll * SZ_SQ); }
    else { int f = -1;
        if (r < 3 * IT_GU) f = 0; else { r -= 3 * IT_GU; const int mi = mixer_items(l);
            if (r < mi) {
                if ((l & 1) == 0) { const int e = l >> 1;
                    if (r < 2 * IT_SQ) { j.W = c.in[7] + (size_t)e * D * 4096; j.ldw = 4096; j.K = D; j.gain = c.in[6] + l * D; j.WT = WSP(bf16, WS_WIN + (size_t)e * 2 * SZ_SQ);
                        if (r < IT_SQ) { nblk = 64; }
                        else if (r < IT_SQ + IT_SQ / 2) { r -= IT_SQ; j.c0 = 2048; nblk = 32; j.rmul = 256; j.radd = 2048; }
                        else { r -= IT_SQ + IT_SQ / 2; j.c0 = 3072; nblk = 32; j.rmul = 256; j.radd = 2048 + 128; }
                    } else { r -= 2 * IT_SQ; j.W = c.in[17] + (size_t)e * 2048 * D; j.ldw = D; j.K = 2048; j.WT = WSP(bf16, WS_WOUT + (size_t)e * SZ_SQ); nblk = D / 32; }
                } else { const int o = l >> 1, g = r / IT_POOL; r -= g * IT_POOL; j.W = c.in[19] + (size_t)(o * 4 + g) * 512 * 512; j.ldw = 512; j.K = 512; j.WT = WSP(bf16, WS_WPOOL + (size_t)o * 2048 * 512 * 2); j.radd = g * 512; nblk = 16; }
            } else { r -= mi; f = 1; } }
        if (f >= 0) { const int t = r / IT_GU, base = f ? 28 : 2; r -= t * IT_GU;
            if (t < 2) { j.W = c.in[base + 1 + t] + (size_t)l * D * F; j.ldw = F; j.K = D; j.gain = c.in[base] + l * D; j.WT = WSP(bf16, WS_WGU + (size_t)(l * 2 + f) * SZ_WGU); j.rmul = 256; j.radd = t * 128; nblk = F / 32; }
            else { j.W = c.in[base + 3] + (size_t)l * F * D; j.ldw = D; j.K = F; j.WT = WSP(bf16, WS_WDN + (size_t)(l * 2 + f) * SZ_WDN); nblk = D / 32; } }
    }
    j.kb = r / nblk; j.nb = r - j.kb * nblk; return j;
}
template <int NI> __device__ __forceinline__ void convert_range(const Ctx& c, int l, int lo, int hi, int rank, int nranks) {
    LAS float* scr = (LAS float*)(c.lds + c.wave * 16384);
    const int step = nranks * NWAVES, lane = c.lane;
    for (int it = lo + rank * NWAVES + c.wave; it < hi; it += NI * step) {
        Job j[NI]; float v[NI][32];
#pragma unroll
        for (int q = 0; q < NI; ++q) if (it + q * step < hi) { j[q] = decode_job(c, l, it + q * step); job_load(j[q], v[q], lane); }
#pragma unroll
        for (int q = 0; q < NI; ++q) if (it + q * step < hi) job_finish(j[q], v[q], scr, lane);
    }
}
#ifndef MK_CONV_Q1
#define MK_CONV_Q1 26
#define MK_CONV_Q2 52
#endif
constexpr int NSCORE = 128;
constexpr int NGEMM_UP = 235;
__host__ __device__ constexpr int conv_cut(int l, int pct) { return (int)((long)layer_items(l) * pct / 100); }

__device__ __forceinline__ void p0_prologue(const Ctx& c) {
    const int gw = c.vcu * NWAVES + c.wave, NGW = c.G * NWAVES, lane = c.lane;
    convert_range<2>(c, -1, 0, KV_ITEMS, c.vcu, c.G);
    convert_range<2>(c, 0, 0, layer_items(0), c.vcu, c.G);
    for (int l = 1; l < NL; ++l) convert_range<2>(c, l, conv_cut(l, MK_CONV_Q2), layer_items(l), c.vcu, c.G);
    { const float* x = c.in[0]; bf16* XH = WSP(bf16, WS_X); bf16* XB = WSP(bf16, WS_XB); float* ssq = WSP(float, WS_SSQ);
      for (int m = gw; m < M; m += NGW) { const f32x4* xr = (const f32x4*)(x + (size_t)m * D) + lane; u32x2* xh = (u32x2*)(XH + (size_t)m * D) + lane; u32x2* xb = (u32x2*)(XB + (size_t)m * D) + lane; float s = 0.f;
#pragma unroll
          for (int j = 0; j < 8; ++j) { const f32x4 v = xr[64 * j]; u32x2 w; w.x = pk2(v[0], v[1]); w.y = pk2(v[2], v[3]); xb[64 * j] = w;
              if (MK_RESID_BF16) { const float r0 = bflo(w.x), r1 = bfhi(w.x), r2 = bflo(w.y), r3 = bfhi(w.y); s += (r0 * r0 + r1 * r1) + (r2 * r2 + r3 * r3); }
              else { u32x2 wh; wh.x = pg8::cvt_pk_h16(v[0], v[1]); wh.y = pg8::cvt_pk_h16(v[2], v[3]); xh[64 * j] = wh; s += (v[0] * v[0] + v[1] * v[1]) + (v[2] * v[2] + v[3] * v[3]); } }
          s = wave_sum(s);
          if (lane < 8) ssq[(size_t)m * 8 + lane] = lane == 0 ? s : 0.f; } }
    { const float* x = c.in[1]; bf16* XB = WSP(bf16, WS_MEMB); float* rm = WSP(float, WS_RMEM);
      for (int m = gw; m < MM; m += NGW) { const f32x4* xr = (const f32x4*)(x + (size_t)m * D) + lane; f32x4 v[8]; float s = 0.f;
#pragma unroll
          for (int j = 0; j < 8; ++j) { v[j] = xr[64 * j]; s += (v[j][0] * v[j][0] + v[j][1] * v[j][1]) + (v[j][2] * v[j][2] + v[j][3] * v[j][3]); }
          s = wave_sum(s);
          u32x2* xb = (u32x2*)(XB + (size_t)m * D) + lane;
#pragma unroll
          for (int j = 0; j < 8; ++j) { u32x2 w; w.x = pk2(v[j][0], v[j][1]); w.y = pk2(v[j][2], v[j][3]); xb[64 * j] = w; }
          if (lane == 0) rm[m] = __builtin_amdgcn_rsqf(s * (1.0f / D) + EPS); } }
    { const float* wq = c.in[24]; const float* gq = c.in[22]; bf16* o = WSP(bf16, WS_WQ);
      for (int m = gw; m < NL * D; m += NGW) { const f32x4* xr = (const f32x4*)(wq + (size_t)m * D) + lane; u32x2* xb = (u32x2*)(o + (size_t)m * D) + lane; const float g = gq[m];
#pragma unroll
          for (int j = 0; j < 8; ++j) { const f32x4 v = __builtin_nontemporal_load(xr + 64 * j) * g; u32x2 w; w.x = pk2(v[0], v[1]); w.y = pk2(v[2], v[3]); xb[64 * j] = w; } } }
    { const float* ws = c.in[9]; bf16* o = WSP(bf16, WS_WSG);
      for (int i = gw * 64 + lane; i < 2 * 8 * 128 * 128; i += NGW * 64) { const int q = i & 127, p = (i >> 7) & 127; o[i] = (bf16)f2bf(((q >> 6) <= (p >> 6)) ? ws[i] : 0.f); } }
}

template <int WIN> __device__ __forceinline__ void pool_rows(const bf16* X, int row0, int t0, int ch, f32x4 gv, const LAS float* rsl, bf16* DD) {
    f32x4 hv[31];
#pragma unroll
    for (int r = 16 - WIN; r < 31; ++r) { const float rr = rsl[r]; f32x4 xv = (f32x4){0.f, 0.f, 0.f, 0.f}; if (t0 - 15 + r >= 0) { const u32x2 q = *(const u32x2*)(X + (size_t)(row0 - 15 + r) * D + ch); xv = MK_RESID_BF16 ? (f32x4){bflo(q.x), bfhi(q.x), bflo(q.y), bfhi(q.y)} : (f32x4){pg8::h_lo(q.x), pg8::h_hi(q.x), pg8::h_lo(q.y), pg8::h_hi(q.y)}; } hv[r] = xv * rr * gv; }
#pragma unroll
    for (int t = 0; t < 16; ++t) { f32x4 s = hv[15 + t];
#pragma unroll
        for (int i = 1; i < WIN; ++i) s += hv[15 + t - i];
        const int n = (t0 + t + 1 < WIN) ? t0 + t + 1 : WIN; const float inv = 1.0f / (float)n;
        const f32x4 d = s * inv - hv[15 + t];
        u32x2 w; w.x = pk2(d[0], d[1]); w.y = pk2(d[2], d[3]); *(u32x2*)(DD + (size_t)(row0 + t) * D + ch) = w; }
}
__device__ __forceinline__ void pool_phase(const Ctx& c, const float* gain  ) {
    const bf16* X = WSP(bf16, MK_RESID_BF16 ? WS_XB : WS_X); const float* ssq = WSP(float, WS_SSQ); bf16* DD = WSP(bf16, WS_DD);
    LAS float* rsl = (LAS float*)c.lds;
    const int ch = 4 * c.tid; const f32x4 gv = *(const f32x4*)(gain + ch);
    for (int k0 = 0; deal_item(c.vcu, c.G, M / 16, k0) >= 0; k0 += 4) {
        { const int q = c.tid >> 6, t = c.tid & 63, it = deal_item(c.vcu, c.G, M / 16, k0 + (q & 3));
          if (q < 4 && it >= 0) { const int row0 = it * 16, t0 = row0 & (S - 1), r = t >> 1, part = t & 1; const bool valid = (r < 31) && (t0 - 15 + r >= 0); float s = 0.f;
              if (valid) { const f32x4 a = *(const f32x4*)(ssq + (size_t)(row0 - 15 + r) * 8 + part * 4); s = (a[0] + a[1]) + (a[2] + a[3]); }
              s += __shfl_xor(s, 1);
              if (part == 0 && r < 31) rsl[q * 32 + r] = valid ? __builtin_amdgcn_rsqf(s * (1.0f / D) + EPS) : 0.f; } }
        LDS_WAIT(); __syncthreads();
        for (int kk = 0, it; kk < 4 && (it = deal_item(c.vcu, c.G, M / 16, k0 + kk)) >= 0; ++kk) { const int row0 = it * 16, t0 = row0 & (S - 1); const LAS float* rs = rsl + kk * 32;
            switch (c.wave >> 1) { case 0: pool_rows<2>(X, row0, t0, ch, gv, rs, DD); break; case 1: pool_rows<4>(X, row0, t0, ch, gv, rs, DD); break;
                                   case 2: pool_rows<8>(X, row0, t0, ch, gv, rs, DD); break; default: pool_rows<16>(X, row0, t0, ch, gv, rs, DD); break; } }
        __syncthreads(); }
}

__device__ __forceinline__ void gate_item(const Ctx& c, int idx, int e, const bf16* U, const bf16* V, const float* lnp, const bf16* WSG, const float* bs, const float* lng, const float* lnb, bf16* YC) {
    LAS unsigned char* vnT = c.lds;
    LAS f32x2* st = (LAS f32x2*)(c.lds + 36864);
    const int h = idx & 7, row0 = (idx >> 3) * 128, lane = c.lane, fr = lane & 15, fq = lane >> 4, w = c.wave;
    if (c.tid < 128) { const f32x4* p = (const f32x4*)(lnp + (size_t)(row0 + c.tid) * 32); float s1 = 0.f, s2 = 0.f;
#pragma unroll
        for (int j = 0; j < 8; ++j) { const f32x4 a = p[j]; s1 += a[0] + a[2]; s2 += a[1] + a[3]; }
        const float mu = s1 * (1.0f / 1024.f), var = fmaxf(s2 * (1.0f / 1024.f) - mu * mu, 0.f);
        st[c.tid] = (f32x2){mu, __builtin_amdgcn_rsqf(var + EPS)}; }
    LDS_WAIT(); __syncthreads();
#pragma unroll
    for (int i = 0; i < 4; ++i) { const int j = c.tid + 512 * i, q = j >> 4, cc = (j & 15) * 8;
        const v4u raw = *(const v4u*)(V + (size_t)(row0 + q) * 1024 + h * 128 + cc); const f32x2 ms = st[q];
        const f32x4 g0 = *(const f32x4*)(lng + h * 128 + cc), g1 = *(const f32x4*)(lng + h * 128 + cc + 4), b0 = *(const f32x4*)(lnb + h * 128 + cc), b1 = *(const f32x4*)(lnb + h * 128 + cc + 4);
        const float v[8] = {bflo(raw.x), bfhi(raw.x), bflo(raw.y), bfhi(raw.y), bflo(raw.z), bfhi(raw.z), bflo(raw.w), bfhi(raw.w)};
        const float g[8] = {g0[0], g0[1], g0[2], g0[3], g1[0], g1[1], g1[2], g1[3]}, bb[8] = {b0[0], b0[1], b0[2], b0[3], b1[0], b1[1], b1[2], b1[3]};
#pragma unroll
        for (int k = 0; k < 8; ++k) *(LAS unsigned short*)(vnT + ((cc + k) * 136 + q) * 2) = (unsigned short)f2bf((v[k] - ms.x) * ms.y * g[k] + bb[k]); }
    LDS_WAIT(); __syncthreads();
    bf16x8 Af[4]; const bf16* wrow = WSG + ((size_t)(e * 8 + h) * 128 + 16 * w + fr) * 128 + 8 * fq;
#pragma unroll
    for (int ks = 0; ks < 4; ++ks) Af[ks] = *(const bf16x8*)(wrow + 32 * ks);
    const float bsv = bs[(e * 8 + h) * 128 + 16 * w + fr]; const size_t orow = (size_t)(row0 + 16 * w + fr);
#pragma unroll
    for (int cb = 0; cb < 8; ++cb) { f32x4 acc = (f32x4){0.f, 0.f, 0.f, 0.f};
#pragma unroll
        for (int ks = 0; ks < 4; ++ks) { const bf16x8 Bf = *(const LAS bf16x8*)(vnT + ((16 * cb + fr) * 136 + 32 * ks + 8 * fq) * 2); acc = __builtin_amdgcn_mfma_f32_16x16x32_bf16(Bf, Af[ks], acc, 0, 0, 0); }
        const u32x2 uu = *(const u32x2*)(U + orow * 1024 + h * 128 + 16 * cb + 4 * fq);
        u32x2 o; o.x = pk2(bflo(uu.x) * (acc[0] + bsv), bfhi(uu.x) * (acc[1] + bsv)); o.y = pk2(bflo(uu.y) * (acc[2] + bsv), bfhi(uu.y) * (acc[3] + bsv));
        *(u32x2*)(YC + orow * 2048 + h * 128 + 16 * cb + 4 * fq) = o; }
    __syncthreads();
}
__device__ __forceinline__ void mix_phase(const Ctx& c, int e) {
    const bf16* U = WSP(bf16, WS_U); const bf16* V = WSP(bf16, WS_V); const bf16* HB = WSP(bf16, WS_HB); bf16* YC = WSP(bf16, WS_YC); const float* lnp = WSP(float, WS_LNP);
#ifndef MK_MIXREP_G
#define MK_MIXREP_G 1
#define MK_MIXREP_C 1
#endif
    for (int rep = 0; rep < MK_MIXREP_G; ++rep)
    for (int k = 0, it; (it = deal_item(c.vcu, c.G, 512, k)) >= 0; ++k) gate_item(c, it, e, U, V, lnp, WSP(bf16, WS_WSG), c.in[10], c.in[11] + e * 1024, c.in[12] + e * 1024, YC);
    { const int ch = 2 * c.tid; const float* cw = c.in[13] + (size_t)e * 31 * 1024 + ch; LAS f32x2* red = (LAS f32x2*)(c.lds + 40960);
      f32x2 wv[31];
#pragma unroll
      for (int j = 0; j < 31; ++j) wv[j] = *(const f32x2*)(cw + j * 1024);
      const f32x2 cbv = *(const f32x2*)(c.in[14] + e * 1024 + ch), gv = *(const f32x2*)(c.in[15] + e * 1024 + ch), bv = *(const f32x2*)(c.in[16] + e * 1024 + ch);
      for (int rep = 0; rep < MK_MIXREP_C; ++rep)
      for (int k = 0, it; (it = deal_item(c.vcu, c.G, M / 16, k)) >= 0; ++k) { const int r0 = it * 16, t0 = r0 & (S - 1);
          unsigned hw[46];
#pragma unroll
          for (int i = 0; i < 46; ++i) { unsigned raw = 0u; if (t0 - 30 + i >= 0) raw = *(const unsigned*)(HB + (size_t)(r0 - 30 + i) * 1024 + ch); hw[i] = raw; }
          f32x2 o[16];
#pragma unroll
          for (int r = 0; r < 16; ++r) { o[r] = cbv;
#pragma unroll
              for (int j = 0; j < 31; ++j) o[r] += (f32x2){bflo(hw[r + j]), bfhi(hw[r + j])} * wv[j]; }
#pragma unroll
          for (int r = 0; r < 16; ++r) { const float s1 = wave_sum(o[r][0] + o[r][1]), s2 = wave_sum(o[r][0] * o[r][0] + o[r][1] * o[r][1]); if (c.lane == 0) red[c.wave * 16 + r] = (f32x2){s1, s2}; }
          LDS_WAIT(); __syncthreads();
#pragma unroll
          for (int r = 0; r < 16; ++r) { float s1 = 0.f, s2 = 0.f;
#pragma unroll
              for (int w = 0; w < 8; ++w) { const f32x2 p = red[w * 16 + r]; s1 += p[0]; s2 += p[1]; }
              const float mu = s1 * (1.0f / 1024.f), var = fmaxf(s2 * (1.0f / 1024.f) - mu * mu, 0.f), rs = __builtin_amdgcn_rsqf(var + EPS);
              const float y0 = (o[r][0] - mu) * rs * gv[0] + bv[0], y1 = (o[r][1] - mu) * rs * gv[1] + bv[1];
              *(unsigned*)(YC + (size_t)(r0 + r) * 2048 + 1024 + ch) = pk2(pg8::fast_silu(y0), pg8::fast_silu(y1)); }
          __syncthreads(); } }
}


__device__ __forceinline__ void final_phase(const Ctx& c, float* out) {
    const bf16* X = WSP(bf16, MK_RESID_BF16 ? WS_XB : WS_X); const float* ssq = WSP(float, WS_SSQ); const float* g = c.in[32];
    const int gw = c.vcu * NWAVES + c.wave, NGW = c.G * NWAVES, lane = c.lane;
    f32x4 gv[8];
#pragma unroll
    for (int j = 0; j < 8; ++j) gv[j] = ((const f32x4*)g)[lane + 64 * j];
    for (int k = 0, m; (m = deal_item(gw, NGW, M, k)) >= 0; ++k) { float s = 0.f; if (lane < 2) { const f32x4 a = ((const f32x4*)(ssq + (size_t)m * 8))[lane]; s = (a[0] + a[1]) + (a[2] + a[3]); }
        const float rs = __builtin_amdgcn_rsqf(wave_sum(s) * (1.0f / D) + EPS);
        const u32x2* xr = (const u32x2*)(X + (size_t)m * D) + lane; f32x4* o = (f32x4*)(out + (size_t)m * D) + lane;
#pragma unroll
        for (int j = 0; j < 8; ++j) { const u32x2 q = xr[64 * j]; o[64 * j] = (MK_RESID_BF16 ? (f32x4){bflo(q.x), bfhi(q.x), bflo(q.y), bfhi(q.y)} : (f32x4){pg8::h_lo(q.x), pg8::h_hi(q.x), pg8::h_lo(q.y), pg8::h_hi(q.y)}) * rs * gv[j]; } }
}

struct Args { const float* in[33]; float* out; unsigned char* ws; int s_lo, s_hi, flags, bar_region; };
__global__ void __launch_bounds__(NTHREADS, 2) mega(Args a) {
    extern __shared__ __attribute__((aligned(16))) unsigned char lds_raw[];
    Ctx c; c.lds = (LAS unsigned char*)lds_raw; c.tid = threadIdx.x; c.lane = c.tid & 63; c.wave = __builtin_amdgcn_readfirstlane(c.tid >> 6);
    c.G = gridDim.x; { const int bx = blockIdx.x; c.vcu = (c.G % 8 == 0) ? (bx % 8) * (c.G / 8) + bx / 8 : bx; }
    c.ws = a.ws; c.in = a.in; const int vcu0 = c.vcu;
    volatile LAS unsigned* MISC = (volatile LAS unsigned*)(c.lds + MISC_OFF);
    for (int u = c.tid; u < (LDS_BYTES - LDSCTL_OFF) / 4; u += NTHREADS) ((LAS unsigned*)(c.lds + LDSCTL_OFF))[u] = 0u;
    __syncthreads();
    XcdBarrier bar = xcd_barrier_post((unsigned*)(c.ws + WS_CTL) + a.bar_region * XCD_BAR_WORDS, MISC + 8);
#if defined(MK_BAR_TWICE)
#define GRID_BAR() do { xcd_barrier(bar); xcd_barrier(bar); } while (0)
#else
#define GRID_BAR() xcd_barrier(bar)
#endif
#ifndef MK_REPEAT
#define MK_REPEAT -1
#endif
#define REPS(type) ((MK_REPEAT == (type)) ? 2 : 1)
    const int bx = blockIdx.x;
    PG8_LAS float* lds_red = (PG8_LAS float*)(c.lds + pg8::LDS_RED_OFF);
    bf16* XB = WSP(bf16, WS_XB); float* ssq = WSP(float, WS_SSQ);

#define RLOOP(type) for (int rp = 0; rp < REPS(type); ++rp)
#ifndef MK_FUSE_FINAL
#define MK_FUSE_FINAL 1
#endif
    bool fused_final = false;
    if (a.flags & 1) {
        RLOOP(0) { p0_prologue(c); GRID_BAR(); }
        RLOOP(1) { pg8::Gemm g{WSP(bf16, WS_MEMB), WSP(bf16, WS_WK), D, D, D, 0}; pg8::ListOrder so{0, 256, c.G, bx, 4, 0}; pg8::EpiKV E{WSP(bf16, WS_KB), WSP(bf16, WS_VT), WSP(float, WS_RMEM)};
          pg8::gemm_phase(c.lds, g, so, E); GRID_BAR(); }
        { pg8::Gemm g{(const bf16*)c.ws, (const bf16*)c.ws, D, D, 512, 0}; pg8::PreOrder so{c.G, bx, 0, (c.G > NSCORE) ? 1 : NL, (int)(WS_WO / 2), (int)(WS_VT / 2), (int)(WS_KB / 2), (int)(WS_WQ / 2)}; pg8::EpiPre E{WSP(bf16, WS_VW), WSP(bf16, WS_KW)};
          pg8::gemm_phase(c.lds, g, so, E);
        }
    }
    for (int it = 0; it <= NL; ++it) {
        const int l = it - 1;
        { int t = threadIdx.x, vc = vcu0, gg = gridDim.x; size_t z = 0; asm volatile("" : "+v"(t), "+s"(z), "+s"(vc), "+s"(gg));
          c.tid = t; c.lane = t & 63; c.wave = __builtin_amdgcn_readfirstlane(t >> 6); c.ws = a.ws + z; c.vcu = vc; c.G = gg;
          XB = WSP(bf16, WS_XB); ssq = WSP(float, WS_SSQ); }
        if (it > 0 && 4 * l + 1 >= a.s_lo && 4 * l + 1 < a.s_hi) {
            if ((l & 1) == 0) { const int e = l >> 1;
                RLOOP(4) { pg8::Gemm g{XB, WSP(bf16, WS_WIN + (size_t)e * 2 * SZ_SQ), D, D, D, 0}; pg8::StaticOrder so; so.init(M, 4096, c.G, bx);
                  pg8::EpiWin E{WSP(bf16, WS_U), WSP(bf16, WS_V), WSP(bf16, WS_HB), WSP(float, WS_LNP), pg8::RstdLds{ssq, c.lds}, c.in[8] + e * 4096};
                  pg8::gemm_phase(c.lds, g, so, E); GRID_BAR(); }
                RLOOP(5) { mix_phase(c, e); GRID_BAR(); }
                RLOOP(6) { pg8::Gemm g{WSP(bf16, WS_YC), WSP(bf16, WS_WOUT + (size_t)e * SZ_SQ), D, D, D, 0}; pg8::StaticOrder so; so.init(M, D, c.G, bx);
                  pg8::EpiResid<true, false> E{WSP(bf16, WS_X), XB, ssq, c.in[18] + e * D, nullptr, rp ? 0.0f : 1.0f, lds_red};
                  pg8::gemm_phase(c.lds, g, so, E); GRID_BAR(); }
            } else { const int o = l >> 1;
                RLOOP(7) { pool_phase(c, c.in[6] + l * D); GRID_BAR(); }
                RLOOP(8) { pg8::Gemm g{WSP(bf16, WS_DD), WSP(bf16, WS_WPOOL + (size_t)o * 2048 * 512 * 2), D, 512, 512, 512}; pg8::StaticOrder so; so.init(M, D, c.G, bx);
                  pg8::EpiResid<true, true> E{WSP(bf16, WS_X), XB, ssq, c.in[20] + o * D, c.in[21] + o * D, rp ? 0.0f : 1.0f, lds_red};
                  pg8::gemm_phase(c.lds, g, so, E); GRID_BAR(); }
            }
        }
        if (it > 0 && 4 * l + 2 >= a.s_lo && 4 * l + 2 < a.s_hi) {
            RLOOP(9) { pg8::Gemm g{XB, WSP(bf16, WS_KW + (size_t)l * NB * 1024 * D * 2), D, D, D, 0}; pg8::BatchBOrder so; so.init(M, 1024, c.G, bx); so.bstride = 1024 * D;
              pg8::EpiSoftmax E{WSP(bf16, WS_P), pg8::RstdLds{ssq, c.lds}, QSCALE, lds_red, (PG8_LAS float*)(c.lds + LDS_RED2_OFF)};
              pg8::gemm_phase(c.lds, g, so, E);
              if (c.G > NSCORE && bx >= NSCORE && l + 1 < NL && rp == 0) {
                  pg8::Gemm g2{(const bf16*)c.ws, (const bf16*)c.ws, D, D, 512, 0}; pg8::PreOrder so2{c.G - NSCORE, bx - NSCORE, l + 1, 1, (int)(WS_WO / 2), (int)(WS_VT / 2), (int)(WS_KB / 2), (int)(WS_WQ / 2)}; pg8::EpiPre E2{WSP(bf16, WS_VW), WSP(bf16, WS_KW)};
                  pg8::gemm_phase(c.lds, g2, so2, E2); }
              GRID_BAR(); }
            RLOOP(11) { pg8::Gemm g{WSP(bf16, WS_P), WSP(bf16, WS_VW + (size_t)l * NB * D * 1024 * 2), 1024, 1024, 1024, 0}; pg8::BatchBOrder so; so.init(M, D, c.G, bx); so.bstride = D * 1024;
              pg8::EpiResid<false, false> E{WSP(bf16, WS_X), XB, ssq, nullptr, nullptr, rp ? 0.0f : 1.0f, lds_red};
              pg8::gemm_phase(c.lds, g, so, E); GRID_BAR(); }
        }
        for (int j = 0; j < 2; ++j) {
            const int s = (j == 0) ? 4 * l + 3 : 4 * it, ll = (j == 0) ? l : it;
            if ((j == 0 && it == 0) || (j == 1 && it == NL) || s < a.s_lo || s >= a.s_hi) continue;
            RLOOP(2) { const int ngemm = (c.G > NGEMM_UP) ? NGEMM_UP : c.G;
              if (bx < ngemm) { pg8::Gemm g{XB, WSP(bf16, WS_WGU + (size_t)(ll * 2 + (1 - j)) * SZ_WGU), D, D, D, 0}; pg8::StaticOrder so; so.init(M, 2 * F, ngemm, bx);
                pg8::EpiSwiglu E{WSP(bf16, WS_HID), F, pg8::RstdLds{ssq, c.lds}};
                pg8::gemm_phase(c.lds, g, so, E); }
              if (ll + 1 < NL && rp == 0) { const int nl = ll + 1, nsp = c.G - ngemm, lo = (j == 1) ? 0 : conv_cut(nl, MK_CONV_Q1), hi = (j == 1) ? conv_cut(nl, MK_CONV_Q1) : conv_cut(nl, MK_CONV_Q2);
                  if (nsp > 0) { if (bx >= ngemm) convert_range<2>(c, nl, lo, hi, bx - ngemm, nsp); }
                  else convert_range<2>(c, nl, lo, hi, c.vcu, c.G); }
              GRID_BAR(); }
#if defined(MK_PROBE_CHEAP)
            { pg8::Gemm g{XB, WSP(bf16, WS_WGU + (size_t)(ll * 2 + (1 - j)) * SZ_WGU), D, D, D, 0}; pg8::StaticOrder so; so.init(M, 2 * F, c.G, bx);
              pg8::EpiQ E{WSP(bf16, WS_END + 4096), pg8::RstdLds{ssq, c.lds}, 1.0f};
              pg8::gemm_phase(c.lds, g, so, E); GRID_BAR(); }
#endif
#if defined(MK_PROBE_SHORT)
            { pg8::Gemm g{XB, WSP(bf16, WS_WGU + (size_t)(ll * 2 + (1 - j)) * SZ_WGU), D, D, 256, 0}; pg8::StaticOrder so; so.init(M, D, c.G, bx);
              pg8::EpiNone E{};
              pg8::gemm_phase(c.lds, g, so, E); GRID_BAR(); }
#endif
#if defined(MK_PROBE_HOTB)
            { struct HotB : pg8::StaticOrder { __device__ bool next(int i, pg8::Unit& u) const { const bool ok = pg8::StaticOrder::next(i, u); u.pn = 0; return ok; } };
              pg8::Gemm g{XB, WSP(bf16, WS_WGU + (size_t)(ll * 2 + (1 - j)) * SZ_WGU), D, D, D, 0}; HotB so; so.init(M, 2 * F, c.G, bx);
              pg8::EpiNone E{};
              pg8::gemm_phase(c.lds, g, so, E); GRID_BAR(); }
#endif
#if defined(MK_PROBE_HOTAB)
            { struct HotAB : pg8::StaticOrder { __device__ bool next(int i, pg8::Unit& u) const { const bool ok = pg8::StaticOrder::next(i, u); u.pn = 0; u.pm = 0; return ok; } };
              pg8::Gemm g{XB, WSP(bf16, WS_WGU + (size_t)(ll * 2 + (1 - j)) * SZ_WGU), D, D, D, 0}; HotAB so; so.init(M, 2 * F, c.G, bx);
              pg8::EpiNone E{};
              pg8::gemm_phase(c.lds, g, so, E); GRID_BAR(); }
#endif
#if defined(MK_PROBE_COLDB)
            { pg8::Gemm g{XB, (const bf16*)c.in[j ? 3 : 29] + (size_t)ll * D * F * 2, D, D, D, 0}; pg8::StaticOrder so; so.init(M, 2 * F, c.G, bx);
              pg8::EpiNone E{};
              pg8::gemm_phase(c.lds, g, so, E); GRID_BAR(); }
#endif
#if defined(MK_PROBE_ZERO)
            { const bf16* zz = WSP(bf16, WS_CTL + 512 * 1024);
              pg8::Gemm g{zz, zz, 0, 0, D, 0}; pg8::StaticOrder so; so.init(M, 2 * F, c.G, bx);
              pg8::EpiNone E{};
              pg8::gemm_phase(c.lds, g, so, E); GRID_BAR(); }
#endif
#if defined(MK_PROBE_NONE)
            { pg8::Gemm g{XB, WSP(bf16, WS_WGU + (size_t)(ll * 2 + (1 - j)) * SZ_WGU), D, D, D, 0}; pg8::StaticOrder so; so.init(M, 2 * F, c.G, bx);
              pg8::EpiNone E{};
              pg8::gemm_phase(c.lds, g, so, E); GRID_BAR(); }
#endif
            RLOOP(3) { pg8::Gemm g{WSP(bf16, WS_HID), WSP(bf16, WS_WDN + (size_t)(ll * 2 + (1 - j)) * SZ_WDN), F, F, F, 0}; pg8::StaticOrder so; so.init(M, D, c.G, bx);
              if (MK_FUSE_FINAL && s == 4 * NL - 1 && (a.flags & 2) && c.G >= (M / 256) * (D / 256) && rp == REPS(3) - 1) {
                  pg8::EpiResidFinal E{XB, ssq, 0.5f, lds_red, (PG8_LAS float*)(c.lds + pg8::LDS_RSL_OFF), a.out, c.in[32], (unsigned*)(c.ws + WS_CTL + 768 * 1024), (unsigned*)(c.ws + WS_CTL) + a.bar_region * XCD_BAR_WORDS + XB_TMO};
                  pg8::gemm_phase(c.lds, g, so, E); fused_final = true; }
              else { pg8::EpiResid<false, false> E{WSP(bf16, WS_X), XB, ssq, nullptr, nullptr, rp ? 0.0f : 0.5f, lds_red};
                  pg8::gemm_phase(c.lds, g, so, E); GRID_BAR(); } }
        }
    }
    if ((a.flags & 2) && !fused_final) final_phase(c, a.out);
}
}
#ifndef MK_DEBUG
#define MK_DEBUG 0
#endif
#if MK_DEBUG
__global__ void k_bf16_to_f32(const unsigned short* a, float* o, size_t n) {
    for (size_t i = (size_t)blockIdx.x * blockDim.x + threadIdx.x; i < n; i += (size_t)gridDim.x * blockDim.x) o[i] = __uint_as_float(((unsigned)a[i]) << 16);
}
__global__ void k_cmp(const unsigned short* a, const float* ref, size_t n, double* acc) {
    double d = 0.0, r = 0.0;
    for (size_t i = (size_t)blockIdx.x * blockDim.x + threadIdx.x; i < n; i += (size_t)gridDim.x * blockDim.x) { const double x = __uint_as_float(((unsigned)a[i]) << 16), y = ref[i]; d += (x - y) * (x - y); r += y * y; }
    for (int o = 32; o >= 1; o >>= 1) { d += __shfl_xor(d, o); r += __shfl_xor(r, o); }
    if ((threadIdx.x & 63) == 0) { atomicAdd(acc, d); atomicAdd(acc + 1, r); }
}
__global__ void k_cmp_attn(const unsigned short* mine, const float* ref, int which, double* acc) {
    double d = 0.0, r = 0.0; const size_t n = (which == 1 || which == 2) ? (size_t)mk::MM * mk::D : (size_t)mk::M * mk::D;
    for (size_t i = (size_t)blockIdx.x * blockDim.x + threadIdx.x; i < n; i += (size_t)gridDim.x * blockDim.x) {
        const size_t row = i / mk::D, col = i % mk::D; size_t mi = i; double sc = 1.0;
        if (which == 0) sc = 1.0 / (double)mk::QSCALE;
        double y = ref[i];
        if (which == 4) { const size_t b = row / mk::S; y = 0.0; for (int k = 0; k < 256; ++k) y += ref[(b * 256 + k) * mk::D + col]; y *= (1.0 / 256.0); }
        const double x = (double)__uint_as_float(((unsigned)mine[mi]) << 16) * sc; d += (x - y) * (x - y); r += y * y; }
    for (int o = 32; o >= 1; o >>= 1) { d += __shfl_xor(d, o); r += __shfl_xor(r, o); }
    if ((threadIdx.x & 63) == 0) { atomicAdd(acc, d); atomicAdd(acc + 1, r); }
}
__global__ void k_frac(const unsigned short* mine, const float* ref, int mode, int wsel, double* acc) {
    double m = 0.0, t = 0.0; const size_t n = (size_t)mk::M * mk::D;
    for (size_t i = (size_t)blockIdx.x * blockDim.x + threadIdx.x; i < n; i += (size_t)gridDim.x * blockDim.x) { const size_t row = i / mk::D, col = i % mk::D;
        if (wsel >= 0 && (int)((row % 128) / 16) != wsel) continue;
        double y = (mode == 3) ? ref[((row / mk::S) * 256) * mk::D + col] : ref[(mode == 1) ? 0 : i]; if (mode == 1) { const size_t b = row / mk::S; y = 0.0; for (int k = 0; k < 256; ++k) y += ref[(b * 256 + k) * mk::D + col]; y *= (1.0 / 256.0); }
        double x = (double)__uint_as_float(((unsigned)mine[i]) << 16); if (mode == 2) x *= 1.0 / (double)mk::QSCALE; t += 1.0; if (fabs(x - y) <= 0.02 * fabs(y) + 1e-3) m += 1.0; }
    for (int o = 32; o >= 1; o >>= 1) { m += __shfl_xor(m, o); t += __shfl_xor(t, o); }
    if ((threadIdx.x & 63) == 0) { atomicAdd(acc, m); atomicAdd(acc + 1, t); }
}
__global__ void k_verdict3(const double* acc, float* out, size_t n) {
    const float c1 = 2.0f + floorf((float)(10.0 * acc[0] / acc[1])), c2 = 2.0f + floorf((float)(10.0 * acc[2] / acc[3]));
    for (size_t i = (size_t)blockIdx.x * blockDim.x + threadIdx.x; i < n; i += (size_t)gridDim.x * blockDim.x) out[i] = (i < n / 2) ? c1 : c2;
}
__global__ void k_verdict2(const double* acc, int lo, int hi, int code0, float* out, size_t n, double thr) {
    int code = 0; for (int s = lo; s < hi; ++s) if (!(acc[2 * s] <= thr * acc[2 * s + 1])) { code = code0 + (s - lo); break; }
    if (code) for (size_t i = (size_t)blockIdx.x * blockDim.x + threadIdx.x; i < n; i += (size_t)gridDim.x * blockDim.x) out[i] = (float)code;
}
__global__ void k_verdict(const double* acc, int ns, float* out, size_t n, double thr) {
    int code = 0; for (int s = 0; s < ns; ++s) if (!(acc[2 * s] <= thr * acc[2 * s + 1])) { code = s + 1; break; }
    if (code) for (size_t i = (size_t)blockIdx.x * blockDim.x + threadIdx.x; i < n; i += (size_t)gridDim.x * blockDim.x) out[i] = (float)code;
}
#endif
extern "C" void kernel_launch(void* const* d_in, const int* in_sizes, int n_in, void* d_out, int out_size, void* d_ws, size_t ws_size, hipStream_t stream) {
    using namespace mk;
    static int grid = 0;
    if (grid == 0) {
        if (n_in != 33 || out_size != M * D || ws_size < WS_END) { fprintf(stderr, "kernel_launch: unexpected problem (n_in %d, out %d, ws %zu < %zu); nothing launched\n", n_in, out_size, ws_size, (size_t)WS_END); grid = -1; return; }
        int dev = 0, cus = 0, per_cu = 0;
        if (hipGetDevice(&dev) != hipSuccess || hipDeviceGetAttribute(&cus, hipDeviceAttributeMultiprocessorCount, dev) != hipSuccess) { grid = -1; return; }
        if (hipFuncSetAttribute((const void*)mega, hipFuncAttributeMaxDynamicSharedMemorySize, LDS_BYTES) != hipSuccess) { fprintf(stderr, "kernel_launch: hipFuncSetAttribute failed\n"); grid = -1; return; }
        if (hipOccupancyMaxActiveBlocksPerMultiprocessor(&per_cu, (const void*)mega, NTHREADS, LDS_BYTES) != hipSuccess || per_cu < 1) fprintf(stderr, "kernel_launch: occupancy query reports %d workgroups per CU\n", per_cu);
        (void)hipGetLastError();
        grid = cus;
    }
    if (grid < 0) return;
    (void)hipMemsetAsync((char*)d_ws + WS_CTL, 0, CTL_BYTES, stream);
    Args a{};
    for (int i = 0; i < 33; ++i) a.in[i] = (const float*)d_in[i];
    a.out = (float*)d_out; a.ws = (unsigned char*)d_ws;
#if !MK_DEBUG
    a.s_lo = 0; a.s_hi = 16; a.flags = 3; a.bar_region = 0;
    hipLaunchKernelGGL(mega, dim3(grid), dim3(NTHREADS), LDS_BYTES, stream, a);
#else
    const size_t NV_OFF = (WS_END + 4095) & ~(size_t)4095;
    if (ws_size < NV_OFF + nv::bufs_bytes()) { fprintf(stderr, "debug build: workspace too small\n"); return; }
    const nv::Bufs nb = nv::carve((unsigned char*)d_ws + NV_OFF);
    double* acc = (double*)((char*)d_ws + WS_CTL + 512 * 1024);
    a.s_lo = 0; a.s_hi = 0; a.flags = 1; a.bar_region = 0;
    hipLaunchKernelGGL(mega, dim3(grid), dim3(NTHREADS), LDS_BYTES, stream, a);
    for (int s = MK_DEBUG_LO; s < MK_DEBUG_HI; ++s) {
        hipLaunchKernelGGL(k_bf16_to_f32, dim3(2048), dim3(256), 0, stream, (const unsigned short*)((char*)d_ws + WS_XB), nb.X, (size_t)M * D);
        a.s_lo = s; a.s_hi = s + 1; a.flags = 0; a.bar_region = 1 + s;
        hipLaunchKernelGGL(mega, dim3(grid), dim3(NTHREADS), LDS_BYTES, stream, a);
        nv::sublayer(nb, d_in, s, stream);
        hipLaunchKernelGGL(k_cmp, dim3(2048), dim3(256), 0, stream, (const unsigned short*)((char*)d_ws + WS_XB), (const float*)nb.X, (size_t)M * D, acc + 2 * s);
        if (s == 2) {
            hipLaunchKernelGGL(k_cmp_attn, dim3(2048), dim3(256), 0, stream, (const unsigned short*)((char*)d_ws + WS_Q), (const float*)nb.T2, 0, acc + 2 * 20);
            hipLaunchKernelGGL(k_cmp_attn, dim3(2048), dim3(256), 0, stream, (const unsigned short*)((char*)d_ws + WS_KB), (const float*)nb.K, 1, acc + 2 * 21);
            hipLaunchKernelGGL(k_cmp_attn, dim3(2048), dim3(256), 0, stream, (const unsigned short*)((char*)d_ws + WS_VT), (const float*)nb.V, 2, acc + 2 * 22);
        }
    }
    a.s_lo = 0; a.s_hi = 0; a.flags = 2; a.bar_region = 17;
    hipLaunchKernelGGL(mega, dim3(grid), dim3(NTHREADS), LDS_BYTES, stream, a);
    hipLaunchKernelGGL(k_verdict, dim3(2048), dim3(256), 0, stream, (const double*)acc, 16, (float*)d_out, (size_t)M * D, 1e-4);
    hipLaunchKernelGGL(k_verdict2, dim3(2048), dim3(256), 0, stream, (const double*)acc, 20, 24, 5, (float*)d_out, (size_t)M * D, 1e-3);
#endif
}
```

```cpp
#include <hip/hip_runtime.h>
#include <cstdio>
#include <cstdint>
#define MK_EARLY_INV 1
namespace pg8 {
#define PG8_LAS __attribute__((address_space(3)))
typedef unsigned short bf16_t;
typedef short bf16x8 __attribute__((ext_vector_type(8)));
typedef float f32x4 __attribute__((ext_vector_type(4)));
typedef float f32x2 __attribute__((ext_vector_type(2)));
typedef unsigned u32x4 __attribute__((ext_vector_type(4)));
typedef unsigned u32x2 __attribute__((ext_vector_type(2)));
#ifndef MK_WGM
#define MK_WGM 4
#endif
constexpr int BM = 256, BK = 64, HALF = 128, HTB = HALF * BK * 2  , STAGE_BYTES = 8 * HTB, NXCD = 8, WGM = MK_WGM;

__host__ __device__ __forceinline__ int lds_byte(int r, int c) { const int st = (r >> 4) * 2 + (c >> 5), rr = r & 15, cc = c & 31, ob = rr * 64 + cc * 2; return st * 1024 + (ob ^ (((ob >> 9) & 1) << 5)); }
__host__ __device__ __forceinline__ void stage_rc(int b, int& R, int& C) { const int st = b / 1024, sb = b % 1024, swz = sb ^ (((sb >> 9) & 1) << 5); R = (st >> 1) * 16 + swz / 64; C = (st & 1) * 32 + (swz % 64) / 2; }
__host__ __device__ __forceinline__ int perm32(int rho) { const int n = rho >> 4, i = rho & 15; return 8 * (i >> 2) + 4 * n + (i & 3); }

struct Unit { int pm, pn, xa, xb, id; };
struct Gemm { const bf16_t* A; const bf16_t* Bt; int lda, ldb, K, agrp; };

struct StaticOrder {
    int nM, nN, nwg, G, c;
    __host__ __device__ void init(int M, int N, int G_, int c_) { nM = M / BM; nN = N / BM; nwg = nM * nN; G = G_; c = c_; }
    __host__ __device__ bool next(int i, Unit& u) const {
        const long L = (long)i * G + c; if (L >= nwg) return false;
        int wgid = (int)L; { const int q = nwg / NXCD, r = nwg % NXCD, xcd = wgid % NXCD, off = wgid / NXCD; wgid = (xcd < r ? xcd * (q + 1) : r * (q + 1) + (xcd - r) * q) + off; }
        const int nig = WGM * nN, gid = wgid / nig, fm = gid * WGM, gsz = (nM - fm) < WGM ? (nM - fm) : WGM;
        u.pm = fm + ((wgid % nig) % gsz); u.pn = (wgid % nig) / gsz; u.xa = 0; u.xb = 0; u.id = 0; return true;
    }
};
struct ListOrder {
    int lo, hi, G, c, nN, rowmajor;
    __host__ __device__ bool next(int i, Unit& u) const {
        const int i0 = (lo > c) ? (lo - c + G - 1) / G : 0; const int L = (i0 + i) * G + c; if (L >= hi) return false; const int k = L - lo;
        if (rowmajor) { u.pm = k / nN; u.pn = k % nN; } else { u.pm = k % nN; u.pn = k / nN; } u.xa = 0; u.xb = 0; u.id = 0; return true;
    }
};

struct BatchBOrder : StaticOrder {
    int bstride;
    __host__ __device__ bool next(int i, Unit& u) const { const bool ok = StaticOrder::next(i, u); if (ok) u.xb = (u.pm >> 3) * bstride; return ok; }
};
struct PreOrder {
    int G, c, l0, nl, oWO, oV, oK, oWQ;
    __host__ __device__ bool next(int i, Unit& u) const {
        const int e = i * G + c; if (e >= nl * 256) return false;
        const int t = e & 7, b = (e >> 3) & 3, h = (e >> 5) & 3, kind = (e >> 7) & 1, l = l0 + (e >> 8), big = l * 2048 * 2048 + h * 512, small = (l * 1024 + b * 256) * 2048 + h * 512;
        if (kind == 0) { u.pm = t; u.pn = 0; u.xa = oWO + big; u.xb = oV + small; } else { u.pm = 0; u.pn = t; u.xa = oK + small; u.xb = oWQ + big; }
        u.id = (kind << 9) | (l << 7) | (h << 5) | (b << 3) | t; return true;
    }
};

typedef __bf16 bf16x2_t __attribute__((ext_vector_type(2)));
__device__ __forceinline__ unsigned cvt_pk_bf16(float lo, float hi) { const f32x2 v = {lo, hi}; const bf16x2_t b = __builtin_convertvector(v, bf16x2_t); return __builtin_bit_cast(unsigned, b); }

typedef _Float16 h16x2_t __attribute__((ext_vector_type(2)));
__device__ __forceinline__ unsigned cvt_pk_h16(float lo, float hi) { const f32x2 v = {lo, hi}; const h16x2_t b = __builtin_convertvector(v, h16x2_t); return __builtin_bit_cast(unsigned, b); }
__device__ __forceinline__ float h_lo(unsigned w) { return (float)__builtin_bit_cast(h16x2_t, w)[0]; }
__device__ __forceinline__ float h_hi(unsigned w) { return (float)__builtin_bit_cast(h16x2_t, w)[1]; }

#ifndef MK_SP2
#define MK_SP2 true
#endif
template <class Epi, class Sched, bool SP2 = MK_SP2>
__device__ __forceinline__ void gemm_phase(PG8_LAS unsigned char* lds, const Gemm g, const Sched& S, const Epi& E) {
    int tid = threadIdx.x; asm volatile("" : "+v"(tid));
    const int wid = __builtin_amdgcn_readfirstlane(tid >> 6), lane = tid & 63, wr = wid >> 2, wc = wid & 3, fr = lane & 15, fq = lane >> 4;
    const int K = g.K, nt = K / BK;
    unsigned voffA[2], voffB[2];
#pragma unroll
    for (int i = 0; i < 2; ++i) { int R, C; stage_rc(tid * 16 + i * 8192, R, C); const int Rb = Epi::PERM ? ((R & ~31) + perm32(R & 31)) : R;
        voffA[i] = (unsigned)(R * g.lda + C) * 2u; voffB[i] = (unsigned)(Rb * g.ldb + C) * 2u; }
    const size_t kstep = (size_t)(BK * 2);
    const size_t hstepA = (size_t)HALF * g.lda * 2, hstepB = (size_t)HALF * g.ldb * 2;
    const size_t tstepA = 2 * hstepA, tstepB = 2 * hstepB;
    const unsigned ldsw = (unsigned)wid * 1024u;
    const int aoff = lds_byte(wr * 64 + fr, fq * 8), boff = lds_byte(wc * 32 + fr, fq * 8);
#define PG8_SA(b, h) (((b) * 2 + (h)) * HTB)
#define PG8_SB(b, h) ((4 + (b) * 2 + (h)) * HTB)
#ifndef MK_STAGE_AUX
#define MK_STAGE_AUX 1
#endif
#define PG8_STAGE(bufoff, gbase, voff) do { _Pragma("unroll") for (int _i = 0; _i < 2; ++_i) \
        __builtin_amdgcn_global_load_lds((const unsigned*)((const char*)(gbase) + (voff)[_i]), (PG8_LAS unsigned*)(lds + (bufoff) + ldsw + _i * 8192), 16, 0, MK_STAGE_AUX); } while (0)
#define PG8_LDA(dst, b, h) do { _Pragma("unroll") for (int m = 0; m < 4; ++m) _Pragma("unroll") for (int k = 0; k < 2; ++k) dst[m][k] = *(const PG8_LAS bf16x8*)(lds + PG8_SA(b, h) + aoff + m * 2048 + k * 1024); } while (0)
#define PG8_LDB(dst, b, h) do { _Pragma("unroll") for (int n = 0; n < 2; ++n) _Pragma("unroll") for (int k = 0; k < 2; ++k) dst[n][k] = *(const PG8_LAS bf16x8*)(lds + PG8_SB(b, h) + boff + n * 2048 + k * 1024); } while (0)
#ifndef MK_NOPRIO
#define PG8_PRIO(x) __builtin_amdgcn_s_setprio(x)
#else
#define PG8_PRIO(x) do { } while (0)
#endif
#if !defined(MK_MMA_PLAIN)
#define PG8_MM1(ai, bj, At, Bt, m, n, k) acc[ai][bj][m][n] = __builtin_amdgcn_mfma_f32_16x16x32_bf16(Bt[n][k], At[m][k], acc[ai][bj][m][n], 0, 0, 0); __builtin_amdgcn_sched_barrier(0)
#define PG8_MMA(ai, bj, At, Bt) do { PG8_PRIO(1); _Pragma("unroll") for (int k = 0; k < 2; ++k) { PG8_MM1(ai, bj, At, Bt, 0, 0, k); PG8_MM1(ai, bj, At, Bt, 0, 1, k); PG8_MM1(ai, bj, At, Bt, 1, 1, k); PG8_MM1(ai, bj, At, Bt, 1, 0, k); \
        PG8_MM1(ai, bj, At, Bt, 2, 0, k); PG8_MM1(ai, bj, At, Bt, 2, 1, k); PG8_MM1(ai, bj, At, Bt, 3, 1, k); PG8_MM1(ai, bj, At, Bt, 3, 0, k); } PG8_PRIO(0); } while (0)
#else
#define PG8_MMA(ai, bj, At, Bt) do { PG8_PRIO(1); _Pragma("unroll") for (int m = 0; m < 4; ++m) _Pragma("unroll") for (int n = 0; n < 2; ++n) _Pragma("unroll") for (int k = 0; k < 2; ++k) \
        acc[ai][bj][m][n] = __builtin_amdgcn_mfma_f32_16x16x32_bf16(Bt[n][k], At[m][k], acc[ai][bj][m][n], 0, 0, 0); PG8_PRIO(0); } while (0)
#endif
#if !defined(MK_MMA_PLAIN)
#define PG8_MMAR(ai, bj, At, Bt) do { PG8_PRIO(1); _Pragma("unroll") for (int k = 1; k >= 0; --k) { PG8_MM1(ai, bj, At, Bt, 3, 0, k); PG8_MM1(ai, bj, At, Bt, 3, 1, k); PG8_MM1(ai, bj, At, Bt, 2, 1, k); PG8_MM1(ai, bj, At, Bt, 2, 0, k); \
        PG8_MM1(ai, bj, At, Bt, 1, 0, k); PG8_MM1(ai, bj, At, Bt, 1, 1, k); PG8_MM1(ai, bj, At, Bt, 0, 1, k); PG8_MM1(ai, bj, At, Bt, 0, 0, k); } PG8_PRIO(0); } while (0)
#define PG8_MMAX(ai) do { PG8_MMA(ai, 0, At, B0); PG8_MMAR(ai, 1, At, B1); } while (0)
#else
#define PG8_MMAX(ai) do { PG8_MMA(ai, 0, At, B0); PG8_MMA(ai, 1, At, B1); } while (0)
#endif
#define PG8_WAIT_V(n) asm volatile("s_waitcnt vmcnt(" #n ")" ::: "memory")
#define PG8_WAIT_L(n) asm volatile("s_waitcnt lgkmcnt(" #n ")" ::: "memory")
#define PG8_BAR __builtin_amdgcn_s_barrier()
#define PG8_SCHED __builtin_amdgcn_sched_barrier(0)
    Unit cur, nxt; int ui = 0;
    if (!S.next(0, cur)) return;
    f32x4 acc[2][2][4][2];
#pragma unroll
    for (int a = 0; a < 2; ++a)
#pragma unroll
        for (int b = 0; b < 2; ++b)
#pragma unroll
            for (int m = 0; m < 4; ++m)
#pragma unroll
                for (int n = 0; n < 2; ++n) acc[a][b][m][n] = (f32x4){0.f, 0.f, 0.f, 0.f};
    bf16x8 At[4][2], B0[2][2], B1[2][2];
    const char* cA = (const char*)g.A + (size_t)cur.pm * tstepA + (size_t)(cur.pn >> 1) * (size_t)g.agrp * 2 + (size_t)cur.xa * 2; const char* cB = (const char*)g.Bt + (size_t)cur.pn * tstepB + (size_t)cur.xb * 2;
    if constexpr (Epi::RSTD_LDS) E.begin(cur, tid);
    if constexpr (SP2) {
    PG8_STAGE(PG8_SB(0, 0), cB, voffB); PG8_STAGE(PG8_SB(0, 1), cB + hstepB, voffB); PG8_STAGE(PG8_SA(0, 0), cA, voffA); PG8_STAGE(PG8_SA(0, 1), cA + hstepA, voffA);
    if (wr == 1) PG8_BAR;
    PG8_WAIT_V(2); PG8_BAR;
    PG8_STAGE(PG8_SB(1, 0), cB + kstep, voffB); PG8_STAGE(PG8_SA(1, 0), cA + kstep, voffA); PG8_STAGE(PG8_SB(1, 1), cB + hstepB + kstep, voffB);
    PG8_WAIT_V(6); PG8_BAR;
    } else {
    PG8_STAGE(PG8_SB(0, 0), cB, voffB); PG8_STAGE(PG8_SA(0, 0), cA, voffA); PG8_STAGE(PG8_SB(0, 1), cB + hstepB, voffB); PG8_STAGE(PG8_SA(0, 1), cA + hstepA, voffA);
    if (wr == 1) PG8_BAR;
    PG8_WAIT_V(4); PG8_BAR;
    PG8_STAGE(PG8_SB(1, 0), cB + kstep, voffB); PG8_STAGE(PG8_SA(1, 0), cA + kstep, voffA); PG8_STAGE(PG8_SB(1, 1), cB + hstepB + kstep, voffB);
    PG8_WAIT_V(6); PG8_BAR;
    }
    for (;;) {
        const bool has_next = S.next(ui + 1, nxt);
        const char* nA = has_next ? (const char*)g.A + (size_t)nxt.pm * tstepA + (size_t)(nxt.pn >> 1) * (size_t)g.agrp * 2 + (size_t)nxt.xa * 2 : cA; const char* nB = has_next ? (const char*)g.Bt + (size_t)nxt.pn * tstepB + (size_t)nxt.xb * 2 : cB;
        for (int t = 0; t < nt; t += 2) {
            const bool last = (t == nt - 2);
            if constexpr (Epi::RSTD_LDS) { if (last) E.late(tid); }
            const char* a1 = cA + (size_t)(t + 1) * kstep;
            const char* a2 = last ? nA : cA + (size_t)(t + 2) * kstep; const char* b2 = last ? nB : cB + (size_t)(t + 2) * kstep;
            const char* a3 = a2 + kstep; const char* b3 = b2 + kstep;
            if constexpr (SP2) {
            PG8_LDB(B0, 0, 0); PG8_LDB(B1, 0, 1); PG8_SCHED; PG8_LDA(At, 0, 0); PG8_STAGE(PG8_SA(1, 1), a1 + hstepA, voffA);
            PG8_WAIT_V(8); PG8_WAIT_L(0); PG8_BAR; PG8_MMAX(0); PG8_BAR; PG8_SCHED;
            PG8_LDA(At, 0, 1); PG8_STAGE(PG8_SB(0, 0), b2, voffB); PG8_STAGE(PG8_SB(0, 1), b2 + hstepB, voffB); PG8_STAGE(PG8_SA(0, 0), a2, voffA);
            PG8_WAIT_V(8); PG8_WAIT_L(0); PG8_BAR; PG8_MMAX(1); PG8_BAR; PG8_SCHED;
            PG8_LDB(B0, 1, 0); PG8_LDB(B1, 1, 1); PG8_SCHED; PG8_LDA(At, 1, 0); PG8_STAGE(PG8_SA(0, 1), a2 + hstepA, voffA);
            PG8_WAIT_V(8); PG8_WAIT_L(0); PG8_BAR; PG8_MMAX(0); PG8_BAR; PG8_SCHED;
            PG8_LDA(At, 1, 1); PG8_STAGE(PG8_SB(1, 0), b3, voffB); PG8_STAGE(PG8_SB(1, 1), b3 + hstepB, voffB); PG8_STAGE(PG8_SA(1, 0), a3, voffA);
            PG8_WAIT_V(8); PG8_WAIT_L(0); PG8_BAR; PG8_MMAX(1); PG8_BAR; PG8_SCHED;
            } else {
            PG8_LDB(B0, 0, 0); PG8_SCHED; PG8_LDA(At, 0, 0); PG8_STAGE(PG8_SA(1, 1), a1 + hstepA, voffA);
            PG8_WAIT_L(8); PG8_BAR; PG8_WAIT_L(0); PG8_MMA(0, 0, At, B0); PG8_BAR; PG8_SCHED;
            PG8_LDB(B1, 0, 1); PG8_STAGE(PG8_SB(0, 0), b2, voffB);
            PG8_BAR; PG8_WAIT_L(0); PG8_MMA(0, 1, At, B1); PG8_BAR;
            PG8_LDA(At, 0, 1); PG8_STAGE(PG8_SA(0, 0), a2, voffA);
            PG8_BAR; PG8_WAIT_L(0); PG8_MMA(1, 0, At, B0); PG8_BAR; PG8_SCHED;
            PG8_STAGE(PG8_SB(0, 1), b2 + hstepB, voffB);
            PG8_WAIT_V(6); PG8_BAR; PG8_MMA(1, 1, At, B1); PG8_BAR;
            PG8_LDB(B0, 1, 0); PG8_SCHED; PG8_LDA(At, 1, 0); PG8_STAGE(PG8_SA(0, 1), a2 + hstepA, voffA);
            PG8_WAIT_L(8); PG8_BAR; PG8_WAIT_L(0); PG8_MMA(0, 0, At, B0); PG8_BAR; PG8_SCHED;
            PG8_LDB(B1, 1, 1); PG8_STAGE(PG8_SB(1, 0), b3, voffB);
            PG8_BAR; PG8_WAIT_L(0); PG8_MMA(0, 1, At, B1); PG8_BAR;
            PG8_LDA(At, 1, 1); PG8_STAGE(PG8_SA(1, 0), a3, voffA);
            PG8_BAR; PG8_WAIT_L(0); PG8_MMA(1, 0, At, B0); PG8_BAR; PG8_SCHED;
            PG8_STAGE(PG8_SB(1, 1), b3 + hstepB, voffB);
            PG8_WAIT_V(6); PG8_BAR; PG8_MMA(1, 1, At, B1); PG8_BAR;
            }
        }
        if (wr == 0) PG8_BAR;
        E(acc, cur, wr, wc, fr, fq);
#if defined(MK_EPI_TWICE)
        if (Epi::TWICE_OK) { asm volatile("" ::: "memory"); E(acc, cur, wr, wc, fr, fq); }
#endif
        if (!has_next) break;
#pragma unroll
        for (int a = 0; a < 2; ++a)
#pragma unroll
            for (int b = 0; b < 2; ++b)
#pragma unroll
                for (int m = 0; m < 4; ++m)
#pragma unroll
                    for (int n = 0; n < 2; ++n) acc[a][b][m][n] = (f32x4){0.f, 0.f, 0.f, 0.f};
        cur = nxt; cA = nA; cB = nB; ++ui;
        if constexpr (Epi::RSTD_LDS) E.begin(cur, tid);
        if (wr == 1) PG8_BAR;
    }
    PG8_WAIT_V(0);
    PG8_BAR;
#undef PG8_SA
#undef PG8_SB
#undef PG8_STAGE
#undef PG8_LDA
#undef PG8_LDB
#undef PG8_MMA
#undef PG8_MM1
#undef PG8_MMAR
#undef PG8_MMAX
#undef PG8_WAIT_V
#undef PG8_WAIT_L
#undef PG8_BAR
#undef PG8_SCHED
}
}
#ifndef MK_RESID_BF16
#define MK_RESID_BF16 1
#endif
namespace pg8 {
constexpr float RMS_EPS = 1e-6f;
constexpr int DM = 2048;
constexpr int LDS_RED_OFF = 131072 + 1024, LDS_RSL_OFF = 131072 + 5120, LDS_RAW_OFF = 131072 + 6144;
struct RstdLds {
    const float* ssq; PG8_LAS unsigned char* lds;
    __device__ __forceinline__ void begin(const Unit& u, int tid) const {
        const int w = __builtin_amdgcn_readfirstlane(tid >> 6), lane = tid & 63;
        __builtin_amdgcn_global_load_lds((const unsigned*)(ssq + ((size_t)(u.pm * BM + 32 * w)) * 8 + 4 * lane), (PG8_LAS unsigned*)(lds + LDS_RAW_OFF + w * 1024), 16, 0, 0);
    }
    __device__ __forceinline__ void late(int tid) const {
        const f32x4 v = *(const PG8_LAS f32x4*)(lds + LDS_RAW_OFF + tid * 16);
        float s = (v[0] + v[1]) + (v[2] + v[3]); s += __shfl_xor(s, 1);
        if ((tid & 1) == 0) ((PG8_LAS float*)(lds + LDS_RSL_OFF))[tid >> 1] = __builtin_amdgcn_rsqf(s * (1.0f / DM) + RMS_EPS);
    }
    __device__ __forceinline__ void rows8(int wr, int fr, float (&r)[2][4]) const {
        const PG8_LAS float* rsl = (const PG8_LAS float*)(lds + LDS_RSL_OFF);
#pragma unroll
        for (int ai = 0; ai < 2; ++ai)
#pragma unroll
            for (int m = 0; m < 4; ++m) r[ai][m] = rsl[ai * HALF + wr * 64 + m * 16 + fr];
    }
};
__device__ __forceinline__ float fast_sigmoid(float x) { return __builtin_amdgcn_rcpf(1.0f + __builtin_amdgcn_exp2f(-1.4426950408889634f * x)); }
__device__ __forceinline__ float fast_silu(float x) { return x * fast_sigmoid(x); }
__device__ __forceinline__ float fast_gelu_tanh(float x) { return x * fast_sigmoid(1.5957691216057308f * (x + 0.044715f * x * x * x)); }

struct EpiSwiglu {
    static constexpr bool PERM = true, TWICE_OK = true, RSTD_LDS = true;
    bf16_t* H; int ldh; RstdLds R;
    __device__ __forceinline__ void begin(const Unit& u, int tid) const { R.begin(u, tid); }
    __device__ __forceinline__ void late(int tid) const { R.late(tid); }
    __device__ __forceinline__ void operator()(const f32x4 (&acc)[2][2][4][2], const Unit& u, int wr, int wc, int fr, int fq) const {
        float rs[2][4]; R.rows8(wr, fr, rs);
        const int row0 = u.pm * BM + wr * 64 + fr, col0 = u.pn * HALF + wc * 32 + 8 * fq;
#pragma unroll
        for (int ai = 0; ai < 2; ++ai)
#pragma unroll
            for (int m = 0; m < 4; ++m) { const float r = rs[ai][m]; float v[8];
#pragma unroll
                for (int n = 0; n < 2; ++n)
#pragma unroll
                    for (int i = 0; i < 4; ++i) v[4 * n + i] = fast_silu(acc[ai][0][m][n][i] * r) * (acc[ai][1][m][n][i] * r);
                u32x4 w; w.x = cvt_pk_bf16(v[0], v[1]); w.y = cvt_pk_bf16(v[2], v[3]); w.z = cvt_pk_bf16(v[4], v[5]); w.w = cvt_pk_bf16(v[6], v[7]);
#if defined(MK_HID_NT)
                __builtin_nontemporal_store(w, (u32x4*)(H + (size_t)(row0 + ai * HALF + m * 16) * ldh + col0)); }
#else
                *(u32x4*)(H + (size_t)(row0 + ai * HALF + m * 16) * ldh + col0) = w; }
#endif
    }
};
template <bool BIAS, bool SCALE> struct EpiResid {
    static constexpr bool PERM = true, TWICE_OK = false, RSTD_LDS = false;
    bf16_t* XH; bf16_t* XB; float* ssq; const float* bias; const float* cscale; float alpha; PG8_LAS float* red;
    __device__ __forceinline__ void operator()(const f32x4 (&acc)[2][2][4][2], const Unit& u, int wr, int wc, int fr, int fq) const {
        const int row0 = u.pm * BM + wr * 64 + fr, col0 = u.pn * BM + wc * 32 + 8 * fq;
        f32x4 bv[2][2], mv[2][2];
#pragma unroll
        for (int bj = 0; bj < 2; ++bj)
#pragma unroll
            for (int n = 0; n < 2; ++n) { bv[bj][n] = BIAS ? *(const f32x4*)(bias + col0 + bj * HALF + 4 * n) : (f32x4){0.f, 0.f, 0.f, 0.f};
                                          mv[bj][n] = SCALE ? *(const f32x4*)(cscale + col0 + bj * HALF + 4 * n) * alpha : (f32x4){alpha, alpha, alpha, alpha}; }
#if !defined(MK_RESID_NOPRE)
        constexpr bool L16 = !BIAS && !SCALE;
#else
        constexpr bool L16 = false;
#endif
#ifndef MK_RESID_NPRE
#define MK_RESID_NPRE 2
#endif
        constexpr int NPRE = L16 ? MK_RESID_NPRE : 0;
        u32x4 xo2[2][4][2];
        if constexpr (L16) {
#pragma unroll
            for (int ai = 0; ai < 2; ++ai)
#pragma unroll
                for (int m = 0; m < (ai ? NPRE : 4); ++m)
#pragma unroll
                    for (int bj = 0; bj < 2; ++bj) xo2[ai][m][bj] = *(const u32x4*)((MK_RESID_BF16 ? XB : XH) + (size_t)(row0 + ai * HALF + m * 16) * DM + col0 + bj * HALF);
        }
#pragma unroll
        for (int ai = 0; ai < 2; ++ai) { u32x4 xo[4][2];
#pragma unroll
            for (int m = 0; m < 4; ++m)
#pragma unroll
                for (int bj = 0; bj < 2; ++bj) { if (L16 && (ai == 0 || m < NPRE)) xo[m][bj] = xo2[ai][m][bj]; else xo[m][bj] = *(const u32x4*)((MK_RESID_BF16 ? XB : XH) + (size_t)(row0 + ai * HALF + m * 16) * DM + col0 + bj * HALF); }
#pragma unroll
            for (int m = 0; m < 4; ++m) { const int row = row0 + ai * HALF + m * 16; const size_t off = (size_t)row * DM + col0; float ss = 0.f;
#pragma unroll
                for (int bj = 0; bj < 2; ++bj) { const u32x4 q = xo[m][bj];
                    const f32x4 x0 = MK_RESID_BF16 ? (f32x4){__uint_as_float(q.x << 16), __uint_as_float(q.x & 0xffff0000u), __uint_as_float(q.y << 16), __uint_as_float(q.y & 0xffff0000u)} : (f32x4){h_lo(q.x), h_hi(q.x), h_lo(q.y), h_hi(q.y)};
                    const f32x4 x1 = MK_RESID_BF16 ? (f32x4){__uint_as_float(q.z << 16), __uint_as_float(q.z & 0xffff0000u), __uint_as_float(q.w << 16), __uint_as_float(q.w & 0xffff0000u)} : (f32x4){h_lo(q.z), h_hi(q.z), h_lo(q.w), h_hi(q.w)};
                    f32x4 a0 = acc[ai][bj][m][0], a1 = acc[ai][bj][m][1]; if (BIAS) { a0 = a0 + bv[bj][0]; a1 = a1 + bv[bj][1]; }
                    const f32x4 v0 = x0 + a0 * mv[bj][0], v1 = x1 + a1 * mv[bj][1];
                    u32x4 w; w.x = cvt_pk_bf16(v0[0], v0[1]); w.y = cvt_pk_bf16(v0[2], v0[3]); w.z = cvt_pk_bf16(v1[0], v1[1]); w.w = cvt_pk_bf16(v1[2], v1[3]);
                    *(u32x4*)(XB + off + bj * HALF) = w;
                    if (MK_RESID_BF16) {
                        const float r0 = __uint_as_float(w.x << 16), r1 = __uint_as_float(w.x & 0xffff0000u), r2 = __uint_as_float(w.y << 16), r3 = __uint_as_float(w.y & 0xffff0000u);
                        const float r4 = __uint_as_float(w.z << 16), r5 = __uint_as_float(w.z & 0xffff0000u), r6 = __uint_as_float(w.w << 16), r7 = __uint_as_float(w.w & 0xffff0000u);
                        ss += ((r0 * r0 + r1 * r1) + (r2 * r2 + r3 * r3)) + ((r4 * r4 + r5 * r5) + (r6 * r6 + r7 * r7));
                    } else {
                        u32x4 wh; wh.x = cvt_pk_h16(v0[0], v0[1]); wh.y = cvt_pk_h16(v0[2], v0[3]); wh.z = cvt_pk_h16(v1[0], v1[1]); wh.w = cvt_pk_h16(v1[2], v1[3]);
                        *(u32x4*)(XH + off + bj * HALF) = wh;
                        ss += ((v0[0] * v0[0] + v0[1] * v0[1]) + (v0[2] * v0[2] + v0[3] * v0[3])) + ((v1[0] * v1[0] + v1[1] * v1[1]) + (v1[2] * v1[2] + v1[3] * v1[3])); } }
                ss += __shfl_xor(ss, 16); ss += __shfl_xor(ss, 32);
                if (fq == 0) red[(ai * HALF + wr * 64 + m * 16 + fr) * 4 + wc] = ss; }
            asm volatile("" ::: "memory"); }
        asm volatile("s_waitcnt lgkmcnt(0)" ::: "memory"); __builtin_amdgcn_s_barrier(); asm volatile("" ::: "memory");
        { const int t = threadIdx.x; if (t < BM) { const f32x4 r4 = *(const PG8_LAS f32x4*)(red + 4 * t); ssq[((size_t)(u.pm * BM + t)) * 8 + u.pn] = (r4[0] + r4[1]) + (r4[2] + r4[3]); } }
        asm volatile("s_waitcnt lgkmcnt(0)" ::: "memory"); __builtin_amdgcn_s_barrier(); asm volatile("" ::: "memory");
    }
};
struct EpiResidFinal {
    static constexpr bool PERM = true, TWICE_OK = false, RSTD_LDS = false;
    const bf16_t* XB; float* ssq; float alpha; PG8_LAS float* red; PG8_LAS float* rsl; float* out; const float* gfin; unsigned* cnt; unsigned* tmo;
    __device__ __forceinline__ void operator()(const f32x4 (&acc_)[2][2][4][2], const Unit& u, int wr, int wc, int fr_, int fq) const {
        f32x4 (&acc)[2][2][4][2] = const_cast<f32x4 (&)[2][2][4][2]>(acc_);
        int fr = fr_; asm volatile("" : "+v"(fr));
        const int rb = wr * 64 + fr, row0 = u.pm * BM + rb, col0 = u.pn * BM + wc * 32 + 8 * fq;
#pragma unroll
        for (int ai = 0; ai < 2; ++ai) { u32x4 xo[4][2];
#pragma unroll
            for (int m = 0; m < 4; ++m)
#pragma unroll
                for (int bj = 0; bj < 2; ++bj) xo[m][bj] = *(const u32x4*)(XB + (size_t)(row0 + ai * HALF + m * 16) * DM + col0 + bj * HALF);
#pragma unroll
            for (int m = 0; m < 4; ++m) { float ss = 0.f;
#pragma unroll
                for (int bj = 0; bj < 2; ++bj) { const u32x4 q = xo[m][bj];
                    const f32x4 x0 = (f32x4){__uint_as_float(q.x << 16), __uint_as_float(q.x & 0xffff0000u), __uint_as_float(q.y << 16), __uint_as_float(q.y & 0xffff0000u)};
                    const f32x4 x1 = (f32x4){__uint_as_float(q.z << 16), __uint_as_float(q.z & 0xffff0000u), __uint_as_float(q.w << 16), __uint_as_float(q.w & 0xffff0000u)};
                    const f32x4 v0 = x0 + acc[ai][bj][m][0] * alpha, v1 = x1 + acc[ai][bj][m][1] * alpha; acc[ai][bj][m][0] = v0; acc[ai][bj][m][1] = v1;
                    ss += ((v0[0] * v0[0] + v0[1] * v0[1]) + (v0[2] * v0[2] + v0[3] * v0[3])) + ((v1[0] * v1[0] + v1[1] * v1[1]) + (v1[2] * v1[2] + v1[3] * v1[3])); }
                ss += __shfl_xor(ss, 16); ss += __shfl_xor(ss, 32);
                if (fq == 0) red[(ai * HALF + m * 16 + rb) * 4 + wc] = ss; }
            asm volatile("" ::: "memory"); }
        asm volatile("s_waitcnt lgkmcnt(0)" ::: "memory"); __builtin_amdgcn_s_barrier(); asm volatile("" ::: "memory");
        const int t = threadIdx.x;
        if (t < BM) { const f32x4 r4 = *(const PG8_LAS f32x4*)(red + 4 * t); ssq[((size_t)(u.pm * BM + t)) * 8 + u.pn] = (r4[0] + r4[1]) + (r4[2] + r4[3]); }
        asm volatile("s_waitcnt vmcnt(0) lgkmcnt(0)" ::: "memory"); __builtin_amdgcn_s_barrier(); asm volatile("" ::: "memory");
        if (t == 0) { unsigned* cw = cnt + 64 * u.pm;
            __builtin_amdgcn_fence(__ATOMIC_RELEASE, "agent"); asm volatile("s_waitcnt vmcnt(0)" ::: "memory");
            (void)__hip_atomic_fetch_add(cw, 1u, __ATOMIC_RELAXED, __HIP_MEMORY_SCOPE_AGENT);
            unsigned sp = 0;
            while (__hip_atomic_load(cw, __ATOMIC_RELAXED, __HIP_MEMORY_SCOPE_AGENT) < 8u) { __builtin_amdgcn_s_sleep(1);
                if ((++sp & 255u) == 0u) { if (__hip_atomic_load(tmo, __ATOMIC_RELAXED, __HIP_MEMORY_SCOPE_AGENT)) break; if (sp > (1u << 18)) { atomicAdd(tmo, 1u); break; } } }
            __builtin_amdgcn_fence(__ATOMIC_ACQUIRE, "agent"); asm volatile("s_waitcnt vmcnt(0)" ::: "memory"); }
        asm volatile("" ::: "memory"); __builtin_amdgcn_s_barrier(); asm volatile("" ::: "memory");
        if (t < BM) { const f32x4* sp4 = (const f32x4*)(ssq + ((size_t)(u.pm * BM + t)) * 8); const f32x4 a = sp4[0], b = sp4[1];
            rsl[t] = __builtin_amdgcn_rsqf((((a[0] + a[1]) + (a[2] + a[3])) + ((b[0] + b[1]) + (b[2] + b[3]))) * (1.0f / DM) + RMS_EPS); }
        asm volatile("s_waitcnt vmcnt(0) lgkmcnt(0)" ::: "memory"); __builtin_amdgcn_s_barrier(); asm volatile("" ::: "memory");
        f32x4 gv[2][2];
#pragma unroll
        for (int bj = 0; bj < 2; ++bj)
#pragma unroll
            for (int n = 0; n < 2; ++n) gv[bj][n] = *(const f32x4*)(gfin + col0 + bj * HALF + 4 * n);
#pragma unroll
        for (int ai = 0; ai < 2; ++ai)
#pragma unroll
            for (int m = 0; m < 4; ++m) { const float r = rsl[ai * HALF + m * 16 + rb]; float* op = out + (size_t)(row0 + ai * HALF + m * 16) * DM + col0;
#pragma unroll
                for (int bj = 0; bj < 2; ++bj)
#pragma unroll
                    for (int n = 0; n < 2; ++n) *(f32x4*)(op + bj * HALF + 4 * n) = acc[ai][bj][m][n] * r * gv[bj][n]; }
    }
};
struct EpiWin {
    static constexpr bool PERM = true, TWICE_OK = false, RSTD_LDS = true;
    bf16_t *U, *V, *HB; float* lnp; RstdLds R; const float* bias;
    __device__ __forceinline__ void begin(const Unit& u, int tid) const { R.begin(u, tid); }
    __device__ __forceinline__ void late(int tid) const { R.late(tid); }
    __device__ __forceinline__ void operator()(const f32x4 (&acc)[2][2][4][2], const Unit& u, int wr, int wc, int fr, int fq) const {
        float rs[2][4]; R.rows8(wr, fr, rs);
        const int row0 = u.pm * BM + wr * 64 + fr;
        if (u.pn < 8) {
            const bool isv = u.pn >= 4; bf16_t* dst = isv ? V : U;
            const int colt = (u.pn & 3) * BM + wc * 32 + 8 * fq, bcol = u.pn * BM + wc * 32 + 8 * fq;
            f32x4 bv[2][2];
#pragma unroll
            for (int bj = 0; bj < 2; ++bj)
#pragma unroll
                for (int n = 0; n < 2; ++n) bv[bj][n] = *(const f32x4*)(bias + bcol + bj * HALF + 4 * n);
#pragma unroll
            for (int ai = 0; ai < 2; ++ai)
#pragma unroll
                for (int m = 0; m < 4; ++m) { const int row = row0 + ai * HALF + m * 16; const float r = rs[ai][m]; float s1 = 0.f, s2 = 0.f;
#pragma unroll
                    for (int bj = 0; bj < 2; ++bj) { float v[8];
#pragma unroll
                        for (int n = 0; n < 2; ++n)
#pragma unroll
                            for (int i = 0; i < 4; ++i) { const float g = fast_gelu_tanh(acc[ai][bj][m][n][i] * r + bv[bj][n][i]); v[4 * n + i] = g; s1 += g; s2 += g * g; }
                        u32x4 w; w.x = cvt_pk_bf16(v[0], v[1]); w.y = cvt_pk_bf16(v[2], v[3]); w.z = cvt_pk_bf16(v[4], v[5]); w.w = cvt_pk_bf16(v[6], v[7]);
                        *(u32x4*)(dst + (size_t)row * 1024 + colt + bj * HALF) = w; }
                    if (isv) { s1 += __shfl_xor(s1, 16); s1 += __shfl_xor(s1, 32); s2 += __shfl_xor(s2, 16); s2 += __shfl_xor(s2, 32);
                        if (fq == 0) *(f32x2*)(lnp + ((size_t)row * 16 + (u.pn - 4) * 4 + wc) * 2) = (f32x2){s1, s2}; } }
        } else {
            const int j0 = (u.pn - 8) * HALF + wc * 32 + 8 * fq;
            f32x4 ba[2], bg[2];
#pragma unroll
            for (int n = 0; n < 2; ++n) { ba[n] = *(const f32x4*)(bias + 2048 + j0 + 4 * n); bg[n] = *(const f32x4*)(bias + 3072 + j0 + 4 * n); }
#pragma unroll
            for (int ai = 0; ai < 2; ++ai)
#pragma unroll
                for (int m = 0; m < 4; ++m) { const int row = row0 + ai * HALF + m * 16; const float r = rs[ai][m]; float v[8];
#pragma unroll
                    for (int n = 0; n < 2; ++n)
#pragma unroll
                        for (int i = 0; i < 4; ++i) v[4 * n + i] = (acc[ai][0][m][n][i] * r + ba[n][i]) * fast_sigmoid(acc[ai][1][m][n][i] * r + bg[n][i]);
                    u32x4 w; w.x = cvt_pk_bf16(v[0], v[1]); w.y = cvt_pk_bf16(v[2], v[3]); w.z = cvt_pk_bf16(v[4], v[5]); w.w = cvt_pk_bf16(v[6], v[7]);
                    *(u32x4*)(HB + (size_t)row * 1024 + j0) = w; }
        }
    }
};
struct EpiNone {
    static constexpr bool PERM = true, TWICE_OK = false, RSTD_LDS = false;
    __device__ __forceinline__ void operator()(const f32x4 (&acc)[2][2][4][2], const Unit&, int, int, int, int) const {
#pragma unroll
        for (int ai = 0; ai < 2; ++ai)
#pragma unroll
            for (int bj = 0; bj < 2; ++bj)
#pragma unroll
                for (int m = 0; m < 4; ++m) asm volatile("" :: "v"(acc[ai][bj][m][0]), "v"(acc[ai][bj][m][1]));
    }
};
struct EpiQ {
    static constexpr bool PERM = true, TWICE_OK = false, RSTD_LDS = true;
    bf16_t* Q; RstdLds R; float qscale;
    __device__ __forceinline__ void begin(const Unit& u, int tid) const { R.begin(u, tid); }
    __device__ __forceinline__ void late(int tid) const { R.late(tid); }
    __device__ __forceinline__ void operator()(const f32x4 (&acc)[2][2][4][2], const Unit& u, int wr, int wc, int fr, int fq) const {
        float rs[2][4]; R.rows8(wr, fr, rs);
        const int row0 = u.pm * BM + wr * 64 + fr, col0 = u.pn * BM + wc * 32 + 8 * fq;
#pragma unroll
        for (int ai = 0; ai < 2; ++ai)
#pragma unroll
            for (int m = 0; m < 4; ++m) { const float r = rs[ai][m] * qscale; bf16_t* rowp = Q + (size_t)(row0 + ai * HALF + m * 16) * DM + col0;
#pragma unroll
                for (int bj = 0; bj < 2; ++bj) { const f32x4 v0 = acc[ai][bj][m][0] * r, v1 = acc[ai][bj][m][1] * r;
                    u32x4 w; w.x = cvt_pk_bf16(v0[0], v0[1]); w.y = cvt_pk_bf16(v0[2], v0[3]); w.z = cvt_pk_bf16(v1[0], v1[1]); w.w = cvt_pk_bf16(v1[2], v1[3]);
                    *(u32x4*)(rowp + bj * HALF) = w; } }
    }
};
struct EpiKV {
    static constexpr bool PERM = true, TWICE_OK = false, RSTD_LDS = false;
    bf16_t* KB; bf16_t* VB; const float* rstd_mem;
    __device__ __forceinline__ void operator()(const f32x4 (&acc)[2][2][4][2], const Unit& u, int wr, int wc, int fr, int fq) const {
        const int row0 = u.pm * BM + wr * 64 + fr, l = (u.pn >> 3) & 3, col0 = (u.pn & 7) * BM + wc * 32 + 8 * fq; bf16_t* dst = (u.pn < 32) ? KB : VB;
#pragma unroll
        for (int ai = 0; ai < 2; ++ai)
#pragma unroll
            for (int m = 0; m < 4; ++m) { const int row = row0 + ai * HALF + m * 16; const float r = rstd_mem[row]; bf16_t* rowp = dst + ((size_t)l * 1024 + row) * DM + col0;
#pragma unroll
                for (int bj = 0; bj < 2; ++bj) { const f32x4 v0 = acc[ai][bj][m][0] * r, v1 = acc[ai][bj][m][1] * r;
                    u32x4 w; w.x = cvt_pk_bf16(v0[0], v0[1]); w.y = cvt_pk_bf16(v0[2], v0[3]); w.z = cvt_pk_bf16(v1[0], v1[1]); w.w = cvt_pk_bf16(v1[2], v1[3]);
                    *(u32x4*)(rowp + bj * HALF) = w; } }
    }
};
struct EpiPre {
    static constexpr bool PERM = true, TWICE_OK = false, RSTD_LDS = false;
    bf16_t* VWt; bf16_t* KWg;
    __device__ __forceinline__ void operator()(const f32x4 (&acc)[2][2][4][2], const Unit& u, int wr, int wc, int fr, int fq) const {
        const int e = u.id, t = e & 7, b = (e >> 3) & 3, h = (e >> 5) & 3, l = (e >> 7) & 3; const bool kw = e >= 512; const int ldc = kw ? 2048 : 1024;
        bf16_t* base = kw ? KWg + ((size_t)(l * 4 + b) * 1024 + h * 256 + wr * 64 + fr) * 2048 + t * BM + wc * 32 + 8 * fq
                          : VWt + ((size_t)(l * 4 + b) * 2048 + t * BM + wr * 64 + fr) * 1024 + h * 256 + wc * 32 + 8 * fq;
#pragma unroll
        for (int ai = 0; ai < 2; ++ai)
#pragma unroll
            for (int m = 0; m < 4; ++m) { bf16_t* rowp = base + (size_t)(ai * HALF + m * 16) * ldc;
#pragma unroll
                for (int bj = 0; bj < 2; ++bj) { const f32x4 v0 = acc[ai][bj][m][0], v1 = acc[ai][bj][m][1];
                    u32x4 w; w.x = cvt_pk_bf16(v0[0], v0[1]); w.y = cvt_pk_bf16(v0[2], v0[3]); w.z = cvt_pk_bf16(v1[0], v1[1]); w.w = cvt_pk_bf16(v1[2], v1[3]);
                    *(u32x4*)(rowp + bj * HALF) = w; } }
    }
};
struct EpiSoftmax {
    static constexpr bool PERM = true, TWICE_OK = false, RSTD_LDS = true;
    bf16_t* P; RstdLds R; float qscale; PG8_LAS float* red; PG8_LAS float* red2;
    __device__ __forceinline__ void begin(const Unit& u, int tid) const { R.begin(u, tid); }
    __device__ __forceinline__ void late(int tid) const { R.late(tid); }
    __device__ __forceinline__ void operator()(const f32x4 (&acc_)[2][2][4][2], const Unit& u, int wr, int wc, int fr_, int fq) const {
        f32x4 (&acc)[2][2][4][2] = const_cast<f32x4 (&)[2][2][4][2]>(acc_);
        int fr = fr_; asm volatile("" : "+v"(fr));
        const int rb = wr * 64 + fr;
        const PG8_LAS float* rsl = (const PG8_LAS float*)(R.lds + LDS_RSL_OFF) + rb;
        PG8_LAS float* r1 = red + 4 * rb; PG8_LAS float* r2 = red2 + 4 * rb;
#pragma unroll
        for (int ai = 0; ai < 2; ++ai)
#pragma unroll
            for (int m = 0; m < 4; ++m) { float mx = acc[ai][0][m][0][0];
#pragma unroll
                for (int bj = 0; bj < 2; ++bj)
#pragma unroll
                    for (int n = 0; n < 2; ++n)
#pragma unroll
                        for (int i = 0; i < 4; ++i) mx = fmaxf(mx, acc[ai][bj][m][n][i]);
                mx = fmaxf(mx, __shfl_xor(mx, 16)); mx = fmaxf(mx, __shfl_xor(mx, 32));
                if (fq == 0) r1[(ai * HALF + m * 16) * 4 + wc] = mx * (rsl[ai * HALF + m * 16] * qscale); }
        asm volatile("s_waitcnt lgkmcnt(0)" ::: "memory"); __builtin_amdgcn_s_barrier(); asm volatile("" ::: "memory");
#pragma unroll
        for (int ai = 0; ai < 2; ++ai)
#pragma unroll
            for (int m = 0; m < 4; ++m) { const f32x4 m4 = *(const PG8_LAS f32x4*)(r1 + (ai * HALF + m * 16) * 4);
                const float mx = fmaxf(fmaxf(m4[0], m4[1]), fmaxf(m4[2], m4[3])), r = rsl[ai * HALF + m * 16] * qscale; float sum = 0.f;
#pragma unroll
                for (int bj = 0; bj < 2; ++bj)
#pragma unroll
                    for (int n = 0; n < 2; ++n)
#pragma unroll
                        for (int i = 0; i < 4; ++i) { const float pz = __builtin_amdgcn_exp2f(acc[ai][bj][m][n][i] * r - mx); acc[ai][bj][m][n][i] = pz; sum += pz; }
                sum += __shfl_xor(sum, 16); sum += __shfl_xor(sum, 32);
                if (fq == 0) r2[(ai * HALF + m * 16) * 4 + wc] = sum; }
        asm volatile("s_waitcnt lgkmcnt(0)" ::: "memory"); __builtin_amdgcn_s_barrier(); asm volatile("" ::: "memory");
        bf16_t* base = P + (size_t)(u.pm * BM + rb) * 1024 + u.pn * BM + wc * 32 + 8 * fq;
#pragma unroll
        for (int ai = 0; ai < 2; ++ai)
#pragma unroll
            for (int m = 0; m < 4; ++m) { const f32x4 s4 = *(const PG8_LAS f32x4*)(r2 + (ai * HALF + m * 16) * 4);
                const float inv = __builtin_amdgcn_rcpf((s4[0] + s4[1]) + (s4[2] + s4[3])); bf16_t* rowp = base + (size_t)(ai * HALF + m * 16) * 1024;
#pragma unroll
                for (int bj = 0; bj < 2; ++bj) { const f32x4 v0 = acc[ai][bj][m][0] * inv, v1 = acc[ai][bj][m][1] * inv;
                    u32x4 w; w.x = cvt_pk_bf16(v0[0], v0[1]); w.y = cvt_pk_bf16(v0[2], v0[3]); w.z = cvt_pk_bf16(v1[0], v1[1]); w.w = cvt_pk_bf16(v1[2], v1[3]);
                    *(u32x4*)(rowp + bj * HALF) = w; } }
    }
};
}
namespace mk {
using pg8::bf16_t; using pg8::bf16x8; using pg8::f32x4; using pg8::f32x2; using pg8::u32x4; using pg8::u32x2;
#define LAS __attribute__((address_space(3)))
typedef unsigned short bf16;
constexpr int D = 2048, NB = 4, S = 2048, M = NB * S, F = 5632, NM = 256, MM = NB * NM, NL = 4, NWAVES = 8, NTHREADS = 512;
constexpr float EPS = 1e-6f;
constexpr float QSCALE = 0.044194173824159216f * 1.4426950408889634f;

constexpr size_t MiB = 1u << 20;
constexpr size_t WS_CTL = 0, CTL_BYTES = 1 * MiB;
constexpr size_t SZ_WGU = (size_t)2 * F * D * 2, SZ_WDN = (size_t)D * F * 2, SZ_SQ = (size_t)D * D * 2;
constexpr size_t WS_WGU = 1 * MiB;
constexpr size_t WS_WDN = WS_WGU + 8 * SZ_WGU;
constexpr size_t WS_WQ = WS_WDN + 8 * SZ_WDN;
constexpr size_t WS_WO = WS_WQ + 4 * SZ_SQ;
constexpr size_t WS_WK = WS_WO + 4 * SZ_SQ;
constexpr size_t WS_WV = WS_WK + 4 * SZ_SQ;
constexpr size_t WS_WIN = WS_WV + 4 * SZ_SQ;
constexpr size_t WS_WOUT = WS_WIN + 2 * 2 * SZ_SQ;
constexpr size_t WS_WPOOL = WS_WOUT + 2 * SZ_SQ;
constexpr size_t WS_WSG = WS_WPOOL + 2 * (size_t)2048 * 512 * 2;
constexpr size_t WS_X = WS_WSG + 2 * (size_t)8 * 128 * 128 * 2;
constexpr size_t WS_XB = WS_X + (size_t)M * D * 4;
constexpr size_t WS_SSQ = WS_XB + (size_t)M * D * 2;
constexpr size_t WS_LNP = WS_SSQ + (size_t)M * 32 * 4;
constexpr size_t WS_MEMB = WS_LNP + (size_t)M * 32 * 4;
constexpr size_t WS_RMEM = WS_MEMB + (size_t)MM * D * 2;
constexpr size_t WS_KB = WS_RMEM + 4096;
constexpr size_t WS_VT = WS_KB + (size_t)NL * MM * D * 2;
constexpr size_t WS_HID = WS_VT + (size_t)NL * MM * D * 2;
constexpr size_t WS_U = WS_HID, WS_V = WS_U + (size_t)M * 1024 * 2, WS_HB = WS_V + (size_t)M * 1024 * 2, WS_YC = WS_HB + (size_t)M * 1024 * 2;
constexpr size_t WS_DD = WS_HID;
constexpr size_t WS_Q = WS_HID, WS_O = WS_Q + (size_t)M * D * 2;
constexpr size_t WS_P = WS_O;
constexpr size_t WS_VW = (WS_HID + (size_t)M * F * 2 + 4095) & ~(size_t)4095;
constexpr size_t WS_KW = WS_VW + (size_t)NL * NB * D * 1024 * 2;
constexpr size_t WS_END = WS_KW + (size_t)NL * NB * 1024 * D * 2;
static_assert(WS_YC + (size_t)M * D * 2 <= WS_HID + (size_t)M * F * 2 && WS_O + (size_t)M * D * 2 <= WS_HID + (size_t)M * F * 2, "overlays fit in HID");

constexpr int RING_BYTES = 131072, LDSCTL_OFF = RING_BYTES, MISC_OFF = LDSCTL_OFF + 320, LDS_RED2_OFF = 147456, LDS_BYTES = 151552;

typedef unsigned v4u __attribute__((ext_vector_type(4)));
#define LDS_WAIT() asm volatile("s_waitcnt lgkmcnt(0)" ::: "memory")
#define VM_WAIT() asm volatile("s_waitcnt vmcnt(0)" ::: "memory")
__device__ __forceinline__ unsigned f2bf(float f) { unsigned u = __builtin_bit_cast(unsigned, f); return (u + 0x7fffu + ((u >> 16) & 1u)) >> 16; }
__device__ __forceinline__ unsigned pk2(float lo, float hi) { return f2bf(lo) | (f2bf(hi) << 16); }
__device__ __forceinline__ float bflo(unsigned w) { return __builtin_bit_cast(float, w << 16); }
__device__ __forceinline__ float bfhi(unsigned w) { return __builtin_bit_cast(float, w & 0xffff0000u); }
__device__ __forceinline__ float wave_sum(float v) {
#pragma unroll
    for (int o = 1; o < 64; o <<= 1) v += __shfl_xor(v, o);
    return v;
}
typedef __attribute__((address_space(1))) unsigned gu32;
#define RLX_AGENT __ATOMIC_RELAXED, __HIP_MEMORY_SCOPE_AGENT
#define XB_TMO      128
#define XB_XCNT(j)  (256  + 64 * (j))
#define XB_XSUB(j)  (1280 + 64 * (j))
#define XB_XGEN(j)  (2304 + 64 * (j))
#define XB_TOP      3328
#define XB_TOPGEN   3392
#define XCD_BAR_WORDS 3456
#define XB_SPIN_CAP (1u << 18)

__device__ __forceinline__ unsigned xb_ld(unsigned* p)              { return __hip_atomic_load(p, __ATOMIC_RELAXED, __HIP_MEMORY_SCOPE_AGENT); }
__device__ __forceinline__ unsigned xb_add(unsigned* p, unsigned v) { return __hip_atomic_fetch_add(p, v, __ATOMIC_RELAXED, __HIP_MEMORY_SCOPE_AGENT); }
__device__ __forceinline__ unsigned xb_xcc_id() { return (unsigned)__builtin_amdgcn_s_getreg((3 << 11) | 20) & 0xFu; }
#define XB_SPIN(cond, bar) do { unsigned _sp = 0; while (cond) { __builtin_amdgcn_s_sleep(1); \
    if ((++_sp & 255u) == 0u) { if (xb_ld(&(bar)[XB_TMO])) break; if (_sp > XB_SPIN_CAP) { atomicAdd(&(bar)[XB_TMO], 1u); break; } } } } while (0)

struct XcdBarrier {
    unsigned* bar; unsigned x;
    volatile LAS unsigned* st;
};

__device__ __forceinline__ XcdBarrier xcd_barrier_post(unsigned* bar, volatile LAS unsigned* st) {
    XcdBarrier b; b.bar = bar; b.x = xb_xcc_id(); b.st = st;
    if (threadIdx.x == 0) (void)xb_add(&bar[XB_XCNT(b.x)], 1u);
    return b;
}
__device__ __forceinline__ void xcd_barrier_complete(unsigned* bar, unsigned x, unsigned& nloc, unsigned& nx) {
    const unsigned G = gridDim.x * gridDim.y * gridDim.z;
    unsigned sum, cnt, mine, sp = 0u;
    for (;;) {
        sum = 0u; cnt = 0u; mine = 0u;
#pragma unroll
        for (unsigned j = 0; j < 16; ++j) { const unsigned c = xb_ld(&bar[XB_XCNT(j)]); sum += c; cnt += (c > 0u) ? 1u : 0u; }
        if (sum == G) break;
        __builtin_amdgcn_s_sleep(1);
        if ((++sp & 255u) == 0u) { if (xb_ld(&bar[XB_TMO])) break; if (sp > XB_SPIN_CAP) { atomicAdd(&bar[XB_TMO], 1u); break; } }
    }
    mine = xb_ld(&bar[XB_XCNT(x)]);
    nloc = mine > 0u ? mine : 1u; nx = cnt > 0u ? cnt : 1u;
}

__device__ __forceinline__ void xcd_barrier(const XcdBarrier& b) {
    asm volatile("s_waitcnt vmcnt(0)" ::: "memory");
    __syncthreads();
    if (threadIdx.x == 0) {
        unsigned* bar = b.bar;
        __builtin_amdgcn_s_waitcnt(0);
        unsigned nloc = b.st[0], nx = b.st[1];
        if (nloc == 0u) { xcd_barrier_complete(bar, b.x, nloc, nx); b.st[0] = nloc; b.st[1] = nx; }
        const unsigned old = xb_add(&bar[XB_XSUB(b.x)], 1u);
        const unsigned gen = old / nloc;
        if (old + 1u == (gen + 1u) * nloc) {
            __builtin_amdgcn_fence(__ATOMIC_RELEASE, "agent");
            asm volatile("s_waitcnt vmcnt(0)" ::: "memory");
            const unsigned og = xb_add(&bar[XB_TOP], 1u);
            const unsigned tg = og / nx;
            if (og + 1u == (tg + 1u) * nx) xb_add(&bar[XB_TOPGEN], 1u);
            else XB_SPIN(xb_ld(&bar[XB_TOPGEN]) == tg, bar);
#if defined(MK_EARLY_INV)
            __builtin_amdgcn_fence(__ATOMIC_ACQUIRE, "agent");
            asm volatile("s_waitcnt vmcnt(0)" ::: "memory");
            xb_add(&bar[XB_XGEN(b.x)], 1u);
        } else {
            __builtin_amdgcn_fence(__ATOMIC_ACQUIRE, "agent");
            asm volatile("s_waitcnt vmcnt(0)" ::: "memory");
            XB_SPIN(xb_ld(&bar[XB_XGEN(b.x)]) == gen, bar);
            __builtin_amdgcn_fence(__ATOMIC_ACQUIRE, "workgroup");
        }
#else
            __builtin_amdgcn_fence(__ATOMIC_ACQUIRE, "agent");
            xb_add(&bar[XB_XGEN(b.x)], 1u);
            asm volatile("s_waitcnt vmcnt(0)" ::: "memory");
        } else {
            XB_SPIN(xb_ld(&bar[XB_XGEN(b.x)]) == gen, bar);
            __builtin_amdgcn_fence(__ATOMIC_ACQUIRE, "agent");
            asm volatile("s_waitcnt vmcnt(0)" ::: "memory");
        }
#endif
    }
    __syncthreads();
}

struct Ctx { LAS unsigned char* lds; int tid, lane, wave, vcu, G; unsigned char* ws; const float* const* in; };
#define WSP(T, off) ((T*)(c.ws + (off)))
__device__ __forceinline__ int deal_item(int vcu, int G, int N, int k) {
    if (G == 256 && (N & 255) == 0) return (k < (N >> 8)) ? (vcu >> 5) * (N >> 3) + (vcu & 31) + 32 * k : -1;
    const int it = vcu + k * G; return it < N ? it : -1;
}
#define SBAR() do { asm volatile("" ::: "memory"); __builtin_amdgcn_s_barrier(); asm volatile("" ::: "memory"); } while (0)

struct Job { const float* W; const float* gain; bf16* WT; int ldw, c0, K, rmul, radd, kb, nb; };
__device__ __forceinline__ void job_load(const Job& j, float (&v)[32], int lane) {
    const float* src = j.W + (size_t)(64 * j.kb + (lane >> 5)) * j.ldw + j.c0 + 32 * j.nb + (lane & 31);
#pragma unroll
    for (int i = 0; i < 32; ++i) v[i] = __builtin_nontemporal_load(src + (size_t)(2 * i) * j.ldw);
}
__device__ __forceinline__ void job_finish(const Job& j, float (&v)[32], LAS float* scr, int lane) {
    const int k0 = 64 * j.kb, n0 = 32 * j.nb;
    if (j.gain) { const float* gp = j.gain + k0 + (lane >> 5);
#pragma unroll
        for (int i = 0; i < 32; ++i) v[i] *= gp[2 * i]; }
#pragma unroll
    for (int i = 0; i < 32; ++i) scr[(2 * i + (lane >> 5)) * 33 + (lane & 31)] = v[i];
    LDS_WAIT(); asm volatile("" ::: "memory");
    const int cc = lane & 7;
#pragma unroll
    for (int q = 0; q < 4; ++q) { const int n = (lane >> 3) + 8 * q; const LAS float* sp = scr + (8 * cc) * 33 + n;
        v4u o; o.x = pk2(sp[0 * 33], sp[1 * 33]); o.y = pk2(sp[2 * 33], sp[3 * 33]); o.z = pk2(sp[4 * 33], sp[5 * 33]); o.w = pk2(sp[6 * 33], sp[7 * 33]);
        const int nn = n0 + n, drow = (nn >> 7) * j.rmul + (nn & 127) + j.radd;
        __builtin_nontemporal_store(o, (v4u*)(j.WT + (size_t)drow * j.K + k0 + 8 * cc)); }
    LDS_WAIT(); asm volatile("" ::: "memory");
}
constexpr int IT_GU = (D / 64) * (F / 32), IT_SQ = (D / 64) * (D / 32), IT_POOL = (512 / 64) * (512 / 32);
static_assert((F / 64) * (D / 32) == IT_GU, "down-projection item count equals gate/up item count");
constexpr int L_COMMON = 6 * IT_GU, L_EVEN = L_COMMON + 3 * IT_SQ, L_ODD = L_COMMON + 4 * IT_POOL, KV_ITEMS = NL * 3 * IT_SQ;
__host__ __device__ constexpr int layer_items(int l) { return (l & 1) ? L_ODD : L_EVEN; }
__host__ __device__ constexpr int mixer_items(int l) { return (l & 1) ? 4 * IT_POOL : 3 * IT_SQ; }
__device__ __forceinline__ Job decode_job(const Ctx& c, int l, int r) {
    Job j; j.c0 = 0; j.rmul = 128; j.radd = 0; j.gain = nullptr; int nblk;
    if (l < 0) { const int ll = r / (3 * IT_SQ); r -= ll * 3 * IT_SQ; const int t = r / IT_SQ; r -= t * IT_SQ;
        j.W = c.in[25 + t] + (size_t)ll * D * D; j.ldw = D; j.K = D; nblk = D / 32;
        if (t < 2) { j.gain = c.in[23] + ll * D; j.WT = WSP(bf16, t ? WS_WV : WS_WK); j.radd = ll * D; } else j.WT = WSP(bf16, WS_WO + (size_t)ll * SZ_SQ); }
    else { int f = -1;
        if (r < 3 * IT_GU) f = 0; else { r -= 3 * IT_GU; const int mi = mixer_items(l);
            if (r < mi) {
                if ((l & 1) == 0) { const int e = l >> 1;
                    if (r < 2 * IT_SQ) { j.W = c.in[7] + (size_t)e * D * 4096; j.ldw = 4096; j.K = D; j.gain = c.in[6] + l * D; j.WT = WSP(bf16, WS_WIN + (size_t)e * 2 * SZ_SQ);
                        if (r < IT_SQ) { nblk = 64; }
                        else if (r < IT_SQ + IT_SQ / 2) { r -= IT_SQ; j.c0 = 2048; nblk = 32; j.rmul = 256; j.radd = 2048; }
                        else { r -= IT_SQ + IT_SQ / 2; j.c0 = 3072; nblk = 32; j.rmul = 256; j.radd = 2048 + 128; }
                    } else { r -= 2 * IT_SQ; j.W = c.in[17] + (size_t)e * 2048 * D; j.ldw = D; j.K = 2048; j.WT = WSP(bf16, WS_WOUT + (size_t)e * SZ_SQ); nblk = D / 32; }
                } else { const int o = l >> 1, g = r / IT_POOL; r -= g * IT_POOL; j.W = c.in[19] + (size_t)(o * 4 + g) * 512 * 512; j.ldw = 512; j.K = 512; j.WT = WSP(bf16, WS_WPOOL + (size_t)o * 2048 * 512 * 2); j.radd = g * 512; nblk = 16; }
            } else { r -= mi; f = 1; } }
        if (f >= 0) { const int t = r / IT_GU, base = f ? 28 : 2; r -= t * IT_GU;
            if (t < 2) { j.W = c.in[base + 1 + t] + (size_t)l * D * F; j.ldw = F; j.K = D; j.gain = c.in[base] + l * D; j.WT = WSP(bf16, WS_WGU + (size_t)(l * 2 + f) * SZ_WGU); j.rmul = 256; j.radd = t * 128; nblk = F / 32; }
            else { j.W = c.in[base + 3] + (size_t)l * F * D; j.ldw = D; j.K = F; j.WT = WSP(bf16, WS_WDN + (size_t)(l * 2 + f) * SZ_WDN); nblk = D / 32; } }
    }
    j.kb = r / nblk; j.nb = r - j.kb * nblk; return j;
}
template <int NI> __device__ __forceinline__ void convert_range(const Ctx& c, int l, int lo, int hi, int rank, int nranks) {
    LAS float* scr = (LAS float*)(c.lds + c.wave * 16384);
    const int step = nranks * NWAVES, lane = c.lane;
    for (int it = lo + rank * NWAVES + c.wave; it < hi; it += NI * step) {
        Job j[NI]; float v[NI][32];
#pragma unroll
        for (int q = 0; q < NI; ++q) if (it + q * step < hi) { j[q] = decode_job(c, l, it + q * step); job_load(j[q], v[q], lane); }
#pragma unroll
        for (int q = 0; q < NI; ++q) if (it + q * step < hi) job_finish(j[q], v[q], scr, lane);
    }
}
#ifndef MK_CONV_Q1
#define MK_CONV_Q1 26
#define MK_CONV_Q2 52
#endif
constexpr int NSCORE = 128;
constexpr int NGEMM_UP = 235;
__host__ __device__ constexpr int conv_cut(int l, int pct) { return (int)((long)layer_items(l) * pct / 100); }

__device__ __forceinline__ void p0_prologue(const Ctx& c) {
    const int gw = c.vcu * NWAVES + c.wave, NGW = c.G * NWAVES, lane = c.lane;
    convert_range<2>(c, -1, 0, KV_ITEMS, c.vcu, c.G);
    convert_range<2>(c, 0, 0, layer_items(0), c.vcu, c.G);
    for (int l = 1; l < NL; ++l) convert_range<2>(c, l, conv_cut(l, MK_CONV_Q2), layer_items(l), c.vcu, c.G);
    { const float* x = c.in[0]; bf16* XH = WSP(bf16, WS_X); bf16* XB = WSP(bf16, WS_XB); float* ssq = WSP(float, WS_SSQ);
      for (int m = gw; m < M; m += NGW) { const f32x4* xr = (const f32x4*)(x + (size_t)m * D) + lane; u32x2* xh = (u32x2*)(XH + (size_t)m * D) + lane; u32x2* xb = (u32x2*)(XB + (size_t)m * D) + lane; float s = 0.f;
#pragma unroll
          for (int j = 0; j < 8; ++j) { const f32x4 v = xr[64 * j]; u32x2 w; w.x = pk2(v[0], v[1]); w.y = pk2(v[2], v[3]); xb[64 * j] = w;
              if (MK_RESID_BF16) { const float r0 = bflo(w.x), r1 = bfhi(w.x), r2 = bflo(w.y), r3 = bfhi(w.y); s += (r0 * r0 + r1 * r1) + (r2 * r2 + r3 * r3); }
              else { u32x2 wh; wh.x = pg8::cvt_pk_h16(v[0], v[1]); wh.y = pg8::cvt_pk_h16(v[2], v[3]); xh[64 * j] = wh; s += (v[0] * v[0] + v[1] * v[1]) + (v[2] * v[2] + v[3] * v[3]); } }
          s = wave_sum(s);
          if (lane < 8) ssq[(size_t)m * 8 + lane] = lane == 0 ? s : 0.f; } }
    { const float* x = c.in[1]; bf16* XB = WSP(bf16, WS_MEMB); float* rm = WSP(float, WS_RMEM);
      for (int m = gw; m < MM; m += NGW) { const f32x4* xr = (const f32x4*)(x + (size_t)m * D) + lane; f32x4 v[8]; float s = 0.f;
#pragma unroll
          for (int j = 0; j < 8; ++j) { v[j] = xr[64 * j]; s += (v[j][0] * v[j][0] + v[j][1] * v[j][1]) + (v[j][2] * v[j][2] + v[j][3] * v[j][3]); }
          s = wave_sum(s);
          u32x2* xb = (u32x2*)(XB + (size_t)m * D) + lane;
#pragma unroll
          for (int j = 0; j < 8; ++j) { u32x2 w; w.x = pk2(v[j][0], v[j][1]); w.y = pk2(v[j][2], v[j][3]); xb[64 * j] = w; }
          if (lane == 0) rm[m] = __builtin_amdgcn_rsqf(s * (1.0f / D) + EPS); } }
    { const float* wq = c.in[24]; const float* gq = c.in[22]; bf16* o = WSP(bf16, WS_WQ);
      for (int m = gw; m < NL * D; m += NGW) { const f32x4* xr = (const f32x4*)(wq + (size_t)m * D) + lane; u32x2* xb = (u32x2*)(o + (size_t)m * D) + lane; const float g = gq[m];
#pragma unroll
          for (int j = 0; j < 8; ++j) { const f32x4 v = __builtin_nontemporal_load(xr + 64 * j) * g; u32x2 w; w.x = pk2(v[0], v[1]); w.y = pk2(v[2], v[3]); xb[64 * j] = w; } } }
    { const float* ws = c.in[9]; bf16* o = WSP(bf16, WS_WSG);
      for (int i = gw * 64 + lane; i < 2 * 8 * 128 * 128; i += NGW * 64) { const int q = i & 127, p = (i >> 7) & 127; o[i] = (bf16)f2bf(((q >> 6) <= (p >> 6)) ? ws[i] : 0.f); } }
}

template <int WIN> __device__ __forceinline__ void pool_rows(const bf16* X, int row0, int t0, int ch, f32x4 gv, const LAS float* rsl, bf16* DD) {
    f32x4 hv[31];
#pragma unroll
    for (int r = 16 - WIN; r < 31; ++r) { const float rr = rsl[r]; f32x4 xv = (f32x4){0.f, 0.f, 0.f, 0.f}; if (t0 - 15 + r >= 0) { const u32x2 q = *(const u32x2*)(X + (size_t)(row0 - 15 + r) * D + ch); xv = MK_RESID_BF16 ? (f32x4){bflo(q.x), bfhi(q.x), bflo(q.y), bfhi(q.y)} : (f32x4){pg8::h_lo(q.x), pg8::h_hi(q.x), pg8::h_lo(q.y), pg8::h_hi(q.y)}; } hv[r] = xv * rr * gv; }
#pragma unroll
    for (int t = 0; t < 16; ++t) { f32x4 s = hv[15 + t];
#pragma unroll
        for (int i = 1; i < WIN; ++i) s += hv[15 + t - i];
        const int n = (t0 + t + 1 < WIN) ? t0 + t + 1 : WIN; const float inv = 1.0f / (float)n;
        const f32x4 d = s * inv - hv[15 + t];
        u32x2 w; w.x = pk2(d[0], d[1]); w.y = pk2(d[2], d[3]); *(u32x2*)(DD + (size_t)(row0 + t) * D + ch) = w; }
}
__device__ __forceinline__ void pool_phase(const Ctx& c, const float* gain  ) {
    const bf16* X = WSP(bf16, MK_RESID_BF16 ? WS_XB : WS_X); const float* ssq = WSP(float, WS_SSQ); bf16* DD = WSP(bf16, WS_DD);
    LAS float* rsl = (LAS float*)c.lds;
    const int ch = 4 * c.tid; const f32x4 gv = *(const f32x4*)(gain + ch);
    for (int k0 = 0; deal_item(c.vcu, c.G, M / 16, k0) >= 0; k0 += 4) {
        { const int q = c.tid >> 6, t = c.tid & 63, it = deal_item(c.vcu, c.G, M / 16, k0 + (q & 3));
          if (q < 4 && it >= 0) { const int row0 = it * 16, t0 = row0 & (S - 1), r = t >> 1, part = t & 1; const bool valid = (r < 31) && (t0 - 15 + r >= 0); float s = 0.f;
              if (valid) { const f32x4 a = *(const f32x4*)(ssq + (size_t)(row0 - 15 + r) * 8 + part * 4); s = (a[0] + a[1]) + (a[2] + a[3]); }
              s += __shfl_xor(s, 1);
              if (part == 0 && r < 31) rsl[q * 32 + r] = valid ? __builtin_amdgcn_rsqf(s * (1.0f / D) + EPS) : 0.f; } }
        LDS_WAIT(); __syncthreads();
        for (int kk = 0, it; kk < 4 && (it = deal_item(c.vcu, c.G, M / 16, k0 + kk)) >= 0; ++kk) { const int row0 = it * 16, t0 = row0 & (S - 1); const LAS float* rs = rsl + kk * 32;
            switch (c.wave >> 1) { case 0: pool_rows<2>(X, row0, t0, ch, gv, rs, DD); break; case 1: pool_rows<4>(X, row0, t0, ch, gv, rs, DD); break;
                                   case 2: pool_rows<8>(X, row0, t0, ch, gv, rs, DD); break; default: pool_rows<16>(X, row0, t0, ch, gv, rs, DD); break; } }
        __syncthreads(); }
}

__device__ __forceinline__ void gate_item(const Ctx& c, int idx, int e, const bf16* U, const bf16* V, const float* lnp, const bf16* WSG, const float* bs, const float* lng, const float* lnb, bf16* YC) {
    LAS unsigned char* vnT = c.lds;
    LAS f32x2* st = (LAS f32x2*)(c.lds + 36864);
    const int h = idx & 7, row0 = (idx >> 3) * 128, lane = c.lane, fr = lane & 15, fq = lane >> 4, w = c.wave;
    if (c.tid < 128) { const f32x4* p = (const f32x4*)(lnp + (size_t)(row0 + c.tid) * 32); float s1 = 0.f, s2 = 0.f;
#pragma unroll
        for (int j = 0; j < 8; ++j) { const f32x4 a = p[j]; s1 += a[0] + a[2]; s2 += a[1] + a[3]; }
        const float mu = s1 * (1.0f / 1024.f), var = fmaxf(s2 * (1.0f / 1024.f) - mu * mu, 0.f);
        st[c.tid] = (f32x2){mu, __builtin_amdgcn_rsqf(var + EPS)}; }
    LDS_WAIT(); __syncthreads();
#pragma unroll
    for (int i = 0; i < 4; ++i) { const int j = c.tid + 512 * i, q = j >> 4, cc = (j & 15) * 8;
        const v4u raw = *(const v4u*)(V + (size_t)(row0 + q) * 1024 + h * 128 + cc); const f32x2 ms = st[q];
        const f32x4 g0 = *(const f32x4*)(lng + h * 128 + cc), g1 = *(const f32x4*)(lng + h * 128 + cc + 4), b0 = *(const f32x4*)(lnb + h * 128 + cc), b1 = *(const f32x4*)(lnb + h * 128 + cc + 4);
        const float v[8] = {bflo(raw.x), bfhi(raw.x), bflo(raw.y), bfhi(raw.y), bflo(raw.z), bfhi(raw.z), bflo(raw.w), bfhi(raw.w)};
        const float g[8] = {g0[0], g0[1], g0[2], g0[3], g1[0], g1[1], g1[2], g1[3]}, bb[8] = {b0[0], b0[1], b0[2], b0[3], b1[0], b1[1], b1[2], b1[3]};
#pragma unroll
        for (int k = 0; k < 8; ++k) *(LAS unsigned short*)(vnT + ((cc + k) * 136 + q) * 2) = (unsigned short)f2bf((v[k] - ms.x) * ms.y * g[k] + bb[k]); }
    LDS_WAIT(); __syncthreads();
    bf16x8 Af[4]; const bf16* wrow = WSG + ((size_t)(e * 8 + h) * 128 + 16 * w + fr) * 128 + 8 * fq;
#pragma unroll
    for (int ks = 0; ks < 4; ++ks) Af[ks] = *(const bf16x8*)(wrow + 32 * ks);
    const float bsv = bs[(e * 8 + h) * 128 + 16 * w + fr]; const size_t orow = (size_t)(row0 + 16 * w + fr);
#pragma unroll
    for (int cb = 0; cb < 8; ++cb) { f32x4 acc = (f32x4){0.f, 0.f, 0.f, 0.f};
#pragma unroll
        for (int ks = 0; ks < 4; ++ks) { const bf16x8 Bf = *(const LAS bf16x8*)(vnT + ((16 * cb + fr) * 136 + 32 * ks + 8 * fq) * 2); acc = __builtin_amdgcn_mfma_f32_16x16x32_bf16(Bf, Af[ks], acc, 0, 0, 0); }
        const u32x2 uu = *(const u32x2*)(U + orow * 1024 + h * 128 + 16 * cb + 4 * fq);
        u32x2 o; o.x = pk2(bflo(uu.x) * (acc[0] + bsv), bfhi(uu.x) * (acc[1] + bsv)); o.y = pk2(bflo(uu.y) * (acc[2] + bsv), bfhi(uu.y) * (acc[3] + bsv));
        *(u32x2*)(YC + orow * 2048 + h * 128 + 16 * cb + 4 * fq) = o; }
    __syncthreads();
}
__device__ __forceinline__ void mix_phase(const Ctx& c, int e) {
    const bf16* U = WSP(bf16, WS_U); const bf16* V = WSP(bf16, WS_V); const bf16* HB = WSP(bf16, WS_HB); bf16* YC = WSP(bf16, WS_YC); const float* lnp = WSP(float, WS_LNP);
#ifndef MK_MIXREP_G
#define MK_MIXREP_G 1
#define MK_MIXREP_C 1
#endif
    for (int rep = 0; rep < MK_MIXREP_G; ++rep)
    for (int k = 0, it; (it = deal_item(c.vcu, c.G, 512, k)) >= 0; ++k) gate_item(c, it, e, U, V, lnp, WSP(bf16, WS_WSG), c.in[10], c.in[11] + e * 1024, c.in[12] + e * 1024, YC);
    { const int ch = 2 * c.tid; const float* cw = c.in[13] + (size_t)e * 31 * 1024 + ch; LAS f32x2* red = (LAS f32x2*)(c.lds + 40960);
      f32x2 wv[31];
#pragma unroll
      for (int j = 0; j < 31; ++j) wv[j] = *(const f32x2*)(cw + j * 1024);
      const f32x2 cbv = *(const f32x2*)(c.in[14] + e * 1024 + ch), gv = *(const f32x2*)(c.in[15] + e * 1024 + ch), bv = *(const f32x2*)(c.in[16] + e * 1024 + ch);
      for (int rep = 0; rep < MK_MIXREP_C; ++rep)
      for (int k = 0, it; (it = deal_item(c.vcu, c.G, M / 16, k)) >= 0; ++k) { const int r0 = it * 16, t0 = r0 & (S - 1);
          unsigned hw[46];
#pragma unroll
          for (int i = 0; i < 46; ++i) { unsigned raw = 0u; if (t0 - 30 + i >= 0) raw = *(const unsigned*)(HB + (size_t)(r0 - 30 + i) * 1024 + ch); hw[i] = raw; }
          f32x2 o[16];
#pragma unroll
          for (int r = 0; r < 16; ++r) { o[r] = cbv;
#pragma unroll
              for (int j = 0; j < 31; ++j) o[r] += (f32x2){bflo(hw[r + j]), bfhi(hw[r + j])} * wv[j]; }
#pragma unroll
          for (int r = 0; r < 16; ++r) { const float s1 = wave_sum(o[r][0] + o[r][1]), s2 = wave_sum(o[r][0] * o[r][0] + o[r][1] * o[r][1]); if (c.lane == 0) red[c.wave * 16 + r] = (f32x2){s1, s2}; }
          LDS_WAIT(); __syncthreads();
#pragma unroll
          for (int r = 0; r < 16; ++r) { float s1 = 0.f, s2 = 0.f;
#pragma unroll
              for (int w = 0; w < 8; ++w) { const f32x2 p = red[w * 16 + r]; s1 += p[0]; s2 += p[1]; }
              const float mu = s1 * (1.0f / 1024.f), var = fmaxf(s2 * (1.0f / 1024.f) - mu * mu, 0.f), rs = __builtin_amdgcn_rsqf(var + EPS);
              const float y0 = (o[r][0] - mu) * rs * gv[0] + bv[0], y1 = (o[r][1] - mu) * rs * gv[1] + bv[1];
              *(unsigned*)(YC + (size_t)(r0 + r) * 2048 + 1024 + ch) = pk2(pg8::fast_silu(y0), pg8::fast_silu(y1)); }
          __syncthreads(); } }
}


__device__ __forceinline__ void final_phase(const Ctx& c, float* out) {
    const bf16* X = WSP(bf16, MK_RESID_BF16 ? WS_XB : WS_X); const float* ssq = WSP(float, WS_SSQ); const float* g = c.in[32];
    const int gw = c.vcu * NWAVES + c.wave, NGW = c.G * NWAVES, lane = c.lane;
    f32x4 gv[8];
#pragma unroll
    for (int j = 0; j < 8; ++j) gv[j] = ((const f32x4*)g)[lane + 64 * j];
    for (int k = 0, m; (m = deal_item(gw, NGW, M, k)) >= 0; ++k) { float s = 0.f; if (lane < 2) { const f32x4 a = ((const f32x4*)(ssq + (size_t)m * 8))[lane]; s = (a[0] + a[1]) + (a[2] + a[3]); }
        const float rs = __builtin_amdgcn_rsqf(wave_sum(s) * (1.0f / D) + EPS);
        const u32x2* xr = (const u32x2*)(X + (size_t)m * D) + lane; f32x4* o = (f32x4*)(out + (size_t)m * D) + lane;
#pragma unroll
        for (int j = 0; j < 8; ++j) { const u32x2 q = xr[64 * j]; o[64 * j] = (MK_RESID_BF16 ? (f32x4){bflo(q.x), bfhi(q.x), bflo(q.y), bfhi(q.y)} : (f32x4){pg8::h_lo(q.x), pg8::h_hi(q.x), pg8::h_lo(q.y), pg8::h_hi(q.y)}) * rs * gv[j]; } }
}

struct Args { const float* in[33]; float* out; unsigned char* ws; int s_lo, s_hi, flags, bar_region; };
__global__ void __launch_bounds__(NTHREADS, 2) mega(Args a) {
    extern __shared__ __attribute__((aligned(16))) unsigned char lds_raw[];
    Ctx c; c.lds = (LAS unsigned char*)lds_raw; c.tid = threadIdx.x; c.lane = c.tid & 63; c.wave = __builtin_amdgcn_readfirstlane(c.tid >> 6);
    c.G = gridDim.x; { const int bx = blockIdx.x; c.vcu = (c.G % 8 == 0) ? (bx % 8) * (c.G / 8) + bx / 8 : bx; }
    c.ws = a.ws; c.in = a.in; const int vcu0 = c.vcu;
    volatile LAS unsigned* MISC = (volatile LAS unsigned*)(c.lds + MISC_OFF);
    for (int u = c.tid; u < (LDS_BYTES - LDSCTL_OFF) / 4; u += NTHREADS) ((LAS unsigned*)(c.lds + LDSCTL_OFF))[u] = 0u;
    __syncthreads();
    XcdBarrier bar = xcd_barrier_post((unsigned*)(c.ws + WS_CTL) + a.bar_region * XCD_BAR_WORDS, MISC + 8);
#if defined(MK_BAR_TWICE)
#define GRID_BAR() do { xcd_barrier(bar); xcd_barrier(bar); } while (0)
#else
#define GRID_BAR() xcd_barrier(bar)
#endif
#ifndef MK_REPEAT
#define MK_REPEAT -1
#endif
#define REPS(type) ((MK_REPEAT == (type)) ? 2 : 1)
    const int bx = blockIdx.x;
    PG8_LAS float* lds_red = (PG8_LAS float*)(c.lds + pg8::LDS_RED_OFF);
    bf16* XB = WSP(bf16, WS_XB); float* ssq = WSP(float, WS_SSQ);

#define RLOOP(type) for (int rp = 0; rp < REPS(type); ++rp)
#ifndef MK_FUSE_FINAL
#define MK_FUSE_FINAL 1
#endif
    bool fused_final = false;
    if (a.flags & 1) {
        RLOOP(0) { p0_prologue(c); GRID_BAR(); }
        RLOOP(1) { pg8::Gemm g{WSP(bf16, WS_MEMB), WSP(bf16, WS_WK), D, D, D, 0}; pg8::ListOrder so{0, 256, c.G, bx, 4, 0}; pg8::EpiKV E{WSP(bf16, WS_KB), WSP(bf16, WS_VT), WSP(float, WS_RMEM)};
          pg8::gemm_phase(c.lds, g, so, E); GRID_BAR(); }
        { pg8::Gemm g{(const bf16*)c.ws, (const bf16*)c.ws, D, D, 512, 0}; pg8::PreOrder so{c.G, bx, 0, (c.G > NSCORE) ? 1 : NL, (int)(WS_WO / 2), (int)(WS_VT / 2), (int)(WS_KB / 2), (int)(WS_WQ / 2)}; pg8::EpiPre E{WSP(bf16, WS_VW), WSP(bf16, WS_KW)};
          pg8::gemm_phase(c.lds, g, so, E);
        }
    }
    for (int it = 0; it <= NL; ++it) {
        const int l = it - 1;
        { int t = threadIdx.x, vc = vcu0, gg = gridDim.x; size_t z = 0; asm volatile("" : "+v"(t), "+s"(z), "+s"(vc), "+s"(gg));
          c.tid = t; c.lane = t & 63; c.wave = __builtin_amdgcn_readfirstlane(t >> 6); c.ws = a.ws + z; c.vcu = vc; c.G = gg;
          XB = WSP(bf16, WS_XB); ssq = WSP(float, WS_SSQ); }
        if (it > 0 && 4 * l + 1 >= a.s_lo && 4 * l + 1 < a.s_hi) {
            if ((l & 1) == 0) { const int e = l >> 1;
                RLOOP(4) { pg8::Gemm g{XB, WSP(bf16, WS_WIN + (size_t)e * 2 * SZ_SQ), D, D, D, 0}; pg8::StaticOrder so; so.init(M, 4096, c.G, bx);
                  pg8::EpiWin E{WSP(bf16, WS_U), WSP(bf16, WS_V), WSP(bf16, WS_HB), WSP(float, WS_LNP), pg8::RstdLds{ssq, c.lds}, c.in[8] + e * 4096};
                  pg8::gemm_phase(c.lds, g, so, E); GRID_BAR(); }
                RLOOP(5) { mix_phase(c, e); GRID_BAR(); }
                RLOOP(6) { pg8::Gemm g{WSP(bf16, WS_YC), WSP(bf16, WS_WOUT + (size_t)e * SZ_SQ), D, D, D, 0}; pg8::StaticOrder so; so.init(M, D, c.G, bx);
                  pg8::EpiResid<true, false> E{WSP(bf16, WS_X), XB, ssq, c.in[18] + e * D, nullptr, rp ? 0.0f : 1.0f, lds_red};
                  pg8::gemm_phase(c.lds, g, so, E); GRID_BAR(); }
            } else { const int o = l >> 1;
                RLOOP(7) { pool_phase(c, c.in[6] + l * D); GRID_BAR(); }
                RLOOP(8) { pg8::Gemm g{WSP(bf16, WS_DD), WSP(bf16, WS_WPOOL + (size_t)o * 2048 * 512 * 2), D, 512, 512, 512}; pg8::StaticOrder so; so.init(M, D, c.G, bx);
                  pg8::EpiResid<true, true> E{WSP(bf16, WS_X), XB, ssq, c.in[20] + o * D, c.in[21] + o * D, rp ? 0.0f : 1.0f, lds_red};
                  pg8::gemm_phase(c.lds, g, so, E); GRID_BAR(); }
            }
        }
        if (it > 0 && 4 * l + 2 >= a.s_lo && 4 * l + 2 < a.s_hi) {
            RLOOP(9) { pg8::Gemm g{XB, WSP(bf16, WS_KW + (size_t)l * NB * 1024 * D * 2), D, D, D, 0}; pg8::BatchBOrder so; so.init(M, 1024, c.G, bx); so.bstride = 1024 * D;
              pg8::EpiSoftmax E{WSP(bf16, WS_P), pg8::RstdLds{ssq, c.lds}, QSCALE, lds_red, (PG8_LAS float*)(c.lds + LDS_RED2_OFF)};
              pg8::gemm_phase(c.lds, g, so, E);
              if (c.G > NSCORE && bx >= NSCORE && l + 1 < NL && rp == 0) {
                  pg8::Gemm g2{(const bf16*)c.ws, (const bf16*)c.ws, D, D, 512, 0}; pg8::PreOrder so2{c.G - NSCORE, bx - NSCORE, l + 1, 1, (int)(WS_WO / 2), (int)(WS_VT / 2), (int)(WS_KB / 2), (int)(WS_WQ / 2)}; pg8::EpiPre E2{WSP(bf16, WS_VW), WSP(bf16, WS_KW)};
                  pg8::gemm_phase(c.lds, g2, so2, E2); }
              GRID_BAR(); }
            RLOOP(11) { pg8::Gemm g{WSP(bf16, WS_P), WSP(bf16, WS_VW + (size_t)l * NB * D * 1024 * 2), 1024, 1024, 1024, 0}; pg8::BatchBOrder so; so.init(M, D, c.G, bx); so.bstride = D * 1024;
              pg8::EpiResid<false, false> E{WSP(bf16, WS_X), XB, ssq, nullptr, nullptr, rp ? 0.0f : 1.0f, lds_red};
              pg8::gemm_phase(c.lds, g, so, E); GRID_BAR(); }
        }
        for (int j = 0; j < 2; ++j) {
            const int s = (j == 0) ? 4 * l + 3 : 4 * it, ll = (j == 0) ? l : it;
            if ((j == 0 && it == 0) || (j == 1 && it == NL) || s < a.s_lo || s >= a.s_hi) continue;
            RLOOP(2) { const int ngemm = (c.G > NGEMM_UP) ? NGEMM_UP : c.G;
              if (bx < ngemm) { pg8::Gemm g{XB, WSP(bf16, WS_WGU + (size_t)(ll * 2 + (1 - j)) * SZ_WGU), D, D, D, 0}; pg8::StaticOrder so; so.init(M, 2 * F, ngemm, bx);
                pg8::EpiSwiglu E{WSP(bf16, WS_HID), F, pg8::RstdLds{ssq, c.lds}};
                pg8::gemm_phase(c.lds, g, so, E); }
              if (ll + 1 < NL && rp == 0) { const int nl = ll + 1, nsp = c.G - ngemm, lo = (j == 1) ? 0 : conv_cut(nl, MK_CONV_Q1), hi = (j == 1) ? conv_cut(nl, MK_CONV_Q1) : conv_cut(nl, MK_CONV_Q2);
                  if (nsp > 0) { if (bx >= ngemm) convert_range<2>(c, nl, lo, hi, bx - ngemm, nsp); }
                  else convert_range<2>(c, nl, lo, hi, c.vcu, c.G); }
              GRID_BAR(); }
#if defined(MK_PROBE_CHEAP)
            { pg8::Gemm g{XB, WSP(bf16, WS_WGU + (size_t)(ll * 2 + (1 - j)) * SZ_WGU), D, D, D, 0}; pg8::StaticOrder so; so.init(M, 2 * F, c.G, bx);
              pg8::EpiQ E{WSP(bf16, WS_END + 4096), pg8::RstdLds{ssq, c.lds}, 1.0f};
              pg8::gemm_phase(c.lds, g, so, E); GRID_BAR(); }
#endif
#if defined(MK_PROBE_SHORT)
            { pg8::Gemm g{XB, WSP(bf16, WS_WGU + (size_t)(ll * 2 + (1 - j)) * SZ_WGU), D, D, 256, 0}; pg8::StaticOrder so; so.init(M, D, c.G, bx);
              pg8::EpiNone E{};
              pg8::gemm_phase(c.lds, g, so, E); GRID_BAR(); }
#endif
#if defined(MK_PROBE_HOTB)
            { struct HotB : pg8::StaticOrder { __device__ bool next(int i, pg8::Unit& u) const { const bool ok = pg8::StaticOrder::next(i, u); u.pn = 0; return ok; } };
              pg8::Gemm g{XB, WSP(bf16, WS_WGU + (size_t)(ll * 2 + (1 - j)) * SZ_WGU), D, D, D, 0}; HotB so; so.init(M, 2 * F, c.G, bx);
              pg8::EpiNone E{};
              pg8::gemm_phase(c.lds, g, so, E); GRID_BAR(); }
#endif
#if defined(MK_PROBE_HOTAB)
            { struct HotAB : pg8::StaticOrder { __device__ bool next(int i, pg8::Unit& u) const { const bool ok = pg8::StaticOrder::next(i, u); u.pn = 0; u.pm = 0; return ok; } };
              pg8::Gemm g{XB, WSP(bf16, WS_WGU + (size_t)(ll * 2 + (1 - j)) * SZ_WGU), D, D, D, 0}; HotAB so; so.init(M, 2 * F, c.G, bx);
              pg8::EpiNone E{};
              pg8::gemm_phase(c.lds, g, so, E); GRID_BAR(); }
#endif
#if defined(MK_PROBE_COLDB)
            { pg8::Gemm g{XB, (const bf16*)c.in[j ? 3 : 29] + (size_t)ll * D * F * 2, D, D, D, 0}; pg8::StaticOrder so; so.init(M, 2 * F, c.G, bx);
              pg8::EpiNone E{};
              pg8::gemm_phase(c.lds, g, so, E); GRID_BAR(); }
#endif
#if defined(MK_PROBE_ZERO)
            { const bf16* zz = WSP(bf16, WS_CTL + 512 * 1024);
              pg8::Gemm g{zz, zz, 0, 0, D, 0}; pg8::StaticOrder so; so.init(M, 2 * F, c.G, bx);
              pg8::EpiNone E{};
              pg8::gemm_phase(c.lds, g, so, E); GRID_BAR(); }
#endif
#if defined(MK_PROBE_NONE)
            { pg8::Gemm g{XB, WSP(bf16, WS_WGU + (size_t)(ll * 2 + (1 - j)) * SZ_WGU), D, D, D, 0}; pg8::StaticOrder so; so.init(M, 2 * F, c.G, bx);
              pg8::EpiNone E{};
              pg8::gemm_phase(c.lds, g, so, E); GRID_BAR(); }
#endif
            RLOOP(3) { pg8::Gemm g{WSP(bf16, WS_HID), WSP(bf16, WS_WDN + (size_t)(ll * 2 + (1 - j)) * SZ_WDN), F, F, F, 0}; pg8::StaticOrder so; so.init(M, D, c.G, bx);
              if (MK_FUSE_FINAL && s == 4 * NL - 1 && (a.flags & 2) && c.G >= (M / 256) * (D / 256) && rp == REPS(3) - 1) {
                  pg8::EpiResidFinal E{XB, ssq, 0.5f, lds_red, (PG8_LAS float*)(c.lds + pg8::LDS_RSL_OFF), a.out, c.in[32], (unsigned*)(c.ws + WS_CTL + 768 * 1024), (unsigned*)(c.ws + WS_CTL) + a.bar_region * XCD_BAR_WORDS + XB_TMO};
                  pg8::gemm_phase(c.lds, g, so, E); fused_final = true; }
              else { pg8::EpiResid<false, false> E{WSP(bf16, WS_X), XB, ssq, nullptr, nullptr, rp ? 0.0f : 0.5f, lds_red};
                  pg8::gemm_phase(c.lds, g, so, E); GRID_BAR(); } }
        }
    }
    if ((a.flags & 2) && !fused_final) final_phase(c, a.out);
}
}
#ifndef MK_DEBUG
#define MK_DEBUG 0
#endif
#if MK_DEBUG
__global__ void k_bf16_to_f32(const unsigned short* a, float* o, size_t n) {
    for (size_t i = (size_t)blockIdx.x * blockDim.x + threadIdx.x; i < n; i += (size_t)gridDim.x * blockDim.x) o[i] = __uint_as_float(((unsigned)a[i]) << 16);
}
__global__ void k_cmp(const unsigned short* a, const float* ref, size_t n, double* acc) {
    double d = 0.0, r = 0.0;
    for (size_t i = (size_t)blockIdx.x * blockDim.x + threadIdx.x; i < n; i += (size_t)gridDim.x * blockDim.x) { const double x = __uint_as_float(((unsigned)a[i]) << 16), y = ref[i]; d += (x - y) * (x - y); r += y * y; }
    for (int o = 32; o >= 1; o >>= 1) { d += __shfl_xor(d, o); r += __shfl_xor(r, o); }
    if ((threadIdx.x & 63) == 0) { atomicAdd(acc, d); atomicAdd(acc + 1, r); }
}
__global__ void k_cmp_attn(const unsigned short* mine, const float* ref, int which, double* acc) {
    double d = 0.0, r = 0.0; const size_t n = (which == 1 || which == 2) ? (size_t)mk::MM * mk::D : (size_t)mk::M * mk::D;
    for (size_t i = (size_t)blockIdx.x * blockDim.x + threadIdx.x; i < n; i += (size_t)gridDim.x * blockDim.x) {
        const size_t row = i / mk::D, col = i % mk::D; size_t mi = i; double sc = 1.0;
        if (which == 0) sc = 1.0 / (double)mk::QSCALE;
        double y = ref[i];
        if (which == 4) { const size_t b = row / mk::S; y = 0.0; for (int k = 0; k < 256; ++k) y += ref[(b * 256 + k) * mk::D + col]; y *= (1.0 / 256.0); }
        const double x = (double)__uint_as_float(((unsigned)mine[mi]) << 16) * sc; d += (x - y) * (x - y); r += y * y; }
    for (int o = 32; o >= 1; o >>= 1) { d += __shfl_xor(d, o); r += __shfl_xor(r, o); }
    if ((threadIdx.x & 63) == 0) { atomicAdd(acc, d); atomicAdd(acc + 1, r); }
}
__global__ void k_frac(const unsigned short* mine, const float* ref, int mode, int wsel, double* acc) {
    double m = 0.0, t = 0.0; const size_t n = (size_t)mk::M * mk::D;
    for (size_t i = (size_t)blockIdx.x * blockDim.x + threadIdx.x; i < n; i += (size_t)gridDim.x * blockDim.x) { const size_t row = i / mk::D, col = i % mk::D;
        if (wsel >= 0 && (int)((row % 128) / 16) != wsel) continue;
        double y = (mode == 3) ? ref[((row / mk::S) * 256) * mk::D + col] : ref[(mode == 1) ? 0 : i]; if (mode == 1) { const size_t b = row / mk::S; y = 0.0; for (int k = 0; k < 256; ++k) y += ref[(b * 256 + k) * mk::D + col]; y *= (1.0 / 256.0); }
        double x = (double)__uint_as_float(((unsigned)mine[i]) << 16); if (mode == 2) x *= 1.0 / (double)mk::QSCALE; t += 1.0; if (fabs(x - y) <= 0.02 * fabs(y) + 1e-3) m += 1.0; }
    for (int o = 32; o >= 1; o >>= 1) { m += __shfl_xor(m, o); t += __shfl_xor(t, o); }
    if ((threadIdx.x & 63) == 0) { atomicAdd(acc, m); atomicAdd(acc + 1, t); }
}
__global__ void k_verdict3(const double* acc, float* out, size_t n) {
    const float c1 = 2.0f + floorf((float)(10.0 * acc[0] / acc[1])), c2 = 2.0f + floorf((float)(10.0 * acc[2] / acc[3]));
    for (size_t i = (size_t)blockIdx.x * blockDim.x + threadIdx.x; i < n; i += (size_t)gridDim.x * blockDim.x) out[i] = (i < n / 2) ? c1 : c2;
}
__global__ void k_verdict2(const double* acc, int lo, int hi, int code0, float* out, size_t n, double thr) {
    int code = 0; for (int s = lo; s < hi; ++s) if (!(acc[2 * s] <= thr * acc[2 * s + 1])) { code = code0 + (s - lo); break; }
    if (code) for (size_t i = (size_t)blockIdx.x * blockDim.x + threadIdx.x; i < n; i += (size_t)gridDim.x * blockDim.x) out[i] = (float)code;
}
__global__ void k_verdict(const double* acc, int ns, float* out, size_t n, double thr) {
    int code = 0; for (int s = 0; s < ns; ++s) if (!(acc[2 * s] <= thr * acc[2 * s + 1])) { code = s + 1; break; }
    if (code) for (size_t i = (size_t)blockIdx.x * blockDim.x + threadIdx.x; i < n; i += (size_t)gridDim.x * blockDim.x) out[i] = (float)code;
}
#endif
extern "C" void kernel_launch(void* const* d_in, const int* in_sizes, int n_in, void* d_out, int out_size, void* d_ws, size_t ws_size, hipStream_t stream) {
    using namespace mk;
    static int grid = 0;
    if (grid == 0) {
        if (n_in != 33 || out_size != M * D || ws_size < WS_END) { fprintf(stderr, "kernel_launch: unexpected problem (n_in %d, out %d, ws %zu < %zu); nothing launched\n", n_in, out_size, ws_size, (size_t)WS_END); grid = -1; return; }
        int dev = 0, cus = 0, per_cu = 0;
        if (hipGetDevice(&dev) != hipSuccess || hipDeviceGetAttribute(&cus, hipDeviceAttributeMultiprocessorCount, dev) != hipSuccess) { grid = -1; return; }
        if (hipFuncSetAttribute((const void*)mega, hipFuncAttributeMaxDynamicSharedMemorySize, LDS_BYTES) != hipSuccess) { fprintf(stderr, "kernel_launch: hipFuncSetAttribute failed\n"); grid = -1; return; }
        if (hipOccupancyMaxActiveBlocksPerMultiprocessor(&per_cu, (const void*)mega, NTHREADS, LDS_BYTES) != hipSuccess || per_cu < 1) fprintf(stderr, "kernel_launch: occupancy query reports %d workgroups per CU\n", per_cu);
        (void)hipGetLastError();
        grid = cus;
    }
    if (grid < 0) return;
    (void)hipMemsetAsync((char*)d_ws + WS_CTL, 0, CTL_BYTES, stream);
    Args a{};
    for (int i = 0; i < 33; ++i) a.in[i] = (const float*)d_in[i];
    a.out = (float*)d_out; a.ws = (unsigned char*)d_ws;
#if !MK_DEBUG
    a.s_lo = 0; a.s_hi = 16; a.flags = 3; a.bar_region = 0;
    hipLaunchKernelGGL(mega, dim3(grid), dim3(NTHREADS), LDS_BYTES, stream, a);
#else
    const size_t NV_OFF = (WS_END + 4095) & ~(size_t)4095;
    if (ws_size < NV_OFF + nv::bufs_bytes()) { fprintf(stderr, "debug build: workspace too small\n"); return; }
    const nv::Bufs nb = nv::carve((unsigned char*)d_ws + NV_OFF);
    double* acc = (double*)((char*)d_ws + WS_CTL + 512 * 1024);
    a.s_lo = 0; a.s_hi = 0; a.flags = 1; a.bar_region = 0;
    hipLaunchKernelGGL(mega, dim3(grid), dim3(NTHREADS), LDS_BYTES, stream, a);
    for (int s = MK_DEBUG_LO; s < MK_DEBUG_HI; ++s) {
        hipLaunchKernelGGL(k_bf16_to_f32, dim3(2048), dim3(256), 0, stream, (const unsigned short*)((char*)d_ws + WS_XB), nb.X, (size_t)M * D);
        a.s_lo = s; a.s_hi = s + 1; a.flags = 0; a.bar_region = 1 + s;
        hipLaunchKernelGGL(mega, dim3(grid), dim3(NTHREADS), LDS_BYTES, stream, a);
        nv::sublayer(nb, d_in, s, stream);
        hipLaunchKernelGGL(k_cmp, dim3(2048), dim3(256), 0, stream, (const unsigned short*)((char*)d_ws + WS_XB), (const float*)nb.X, (size_t)M * D, acc + 2 * s);
        if (s == 2) {
            hipLaunchKernelGGL(k_cmp_attn, dim3(2048), dim3(256), 0, stream, (const unsigned short*)((char*)d_ws + WS_Q), (const float*)nb.T2, 0, acc + 2 * 20);
            hipLaunchKernelGGL(k_cmp_attn, dim3(2048), dim3(256), 0, stream, (const unsigned short*)((char*)d_ws + WS_KB), (const float*)nb.K, 1, acc + 2 * 21);
            hipLaunchKernelGGL(k_cmp_attn, dim3(2048), dim3(256), 0, stream, (const unsigned short*)((char*)d_ws + WS_VT), (const float*)nb.V, 2, acc + 2 * 22);
        }
    }
    a.s_lo = 0; a.s_hi = 0; a.flags = 2; a.bar_region = 17;
    hipLaunchKernelGGL(mega, dim3(grid), dim3(NTHREADS), LDS_BYTES, stream, a);
    hipLaunchKernelGGL(k_verdict, dim3(2048), dim3(256), 0, stream, (const double*)acc, 16, (float*)d_out, (size_t)M * D, 1e-4);
    hipLaunchKernelGGL(k_verdict2, dim3(2048), dim3(256), 0, stream, (const double*)acc, 20, 24, 5, (float*)d_out, (size_t)M * D, 1e-3);
#endif
}
```

```cpp
#include <hip/hip_runtime.h>
#include <cstdio>
#include <cstdint>
namespace pg8 {
#define PG8_LAS __attribute__((address_space(3)))
typedef unsigned short bf16_t;
typedef short bf16x8 __attribute__((ext_vector_type(8)));
typedef float f32x4 __attribute__((ext_vector_type(4)));
typedef float f32x2 __attribute__((ext_vector_type(2)));
typedef unsigned u32x4 __attribute__((ext_vector_type(4)));
typedef unsigned u32x2 __attribute__((ext_vector_type(2)));
#ifndef MK_WGM
#define MK_WGM 4
#endif
constexpr int BM = 256, BK = 64, HALF = 128, HTB = HALF * BK * 2  , STAGE_BYTES = 8 * HTB, NXCD = 8, WGM = MK_WGM;

__host__ __device__ __forceinline__ int lds_byte(int r, int c) { const int st = (r >> 4) * 2 + (c >> 5), rr = r & 15, cc = c & 31, ob = rr * 64 + cc * 2; return st * 1024 + (ob ^ (((ob >> 9) & 1) << 5)); }
__host__ __device__ __forceinline__ void stage_rc(int b, int& R, int& C) { const int st = b / 1024, sb = b % 1024, swz = sb ^ (((sb >> 9) & 1) << 5); R = (st >> 1) * 16 + swz / 64; C = (st & 1) * 32 + (swz % 64) / 2; }
__host__ __device__ __forceinline__ int perm32(int rho) { const int n = rho >> 4, i = rho & 15; return 8 * (i >> 2) + 4 * n + (i & 3); }

struct Unit { int pm, pn, xa, xb, id; };
struct Gemm { const bf16_t* A; const bf16_t* Bt; int lda, ldb, K, agrp; };

struct StaticOrder {
    int nM, nN, nwg, G, c;
    __host__ __device__ void init(int M, int N, int G_, int c_) { nM = M / BM; nN = N / BM; nwg = nM * nN; G = G_; c = c_; }
    __host__ __device__ bool next(int i, Unit& u) const {
        const long L = (long)i * G + c; if (L >= nwg) return false;
        int wgid = (int)L; { const int q = nwg / NXCD, r = nwg % NXCD, xcd = wgid % NXCD, off = wgid / NXCD; wgid = (xcd < r ? xcd * (q + 1) : r * (q + 1) + (xcd - r) * q) + off; }
        const int nig = WGM * nN, gid = wgid / nig, fm = gid * WGM, gsz = (nM - fm) < WGM ? (nM - fm) : WGM;
        u.pm = fm + ((wgid % nig) % gsz); u.pn = (wgid % nig) / gsz; u.xa = 0; u.xb = 0; u.id = 0; return true;
    }
};
struct ListOrder {
    int lo, hi, G, c, nN, rowmajor;
    __host__ __device__ bool next(int i, Unit& u) const {
        const int i0 = (lo > c) ? (lo - c + G - 1) / G : 0; const int L = (i0 + i) * G + c; if (L >= hi) return false; const int k = L - lo;
        if (rowmajor) { u.pm = k / nN; u.pn = k % nN; } else { u.pm = k % nN; u.pn = k / nN; } u.xa = 0; u.xb = 0; u.id = 0; return true;
    }
};

struct BatchBOrder : StaticOrder {
    int bstride;
    __host__ __device__ bool next(int i, Unit& u) const { const bool ok = StaticOrder::next(i, u); if (ok) u.xb = (u.pm >> 3) * bstride; return ok; }
};
struct PreOrder {
    int G, c, l0, nl, oWO, oV, oK, oWQ;
    __host__ __device__ bool next(int i, Unit& u) const {
        const int e = i * G + c; if (e >= nl * 256) return false;
        const int t = e & 7, b = (e >> 3) & 3, h = (e >> 5) & 3, kind = (e >> 7) & 1, l = l0 + (e >> 8), big = l * 2048 * 2048 + h * 512, small = (l * 1024 + b * 256) * 2048 + h * 512;
        if (kind == 0) { u.pm = t; u.pn = 0; u.xa = oWO + big; u.xb = oV + small; } else { u.pm = 0; u.pn = t; u.xa = oK + small; u.xb = oWQ + big; }
        u.id = (kind << 9) | (l << 7) | (h << 5) | (b << 3) | t; return true;
    }
};

typedef __bf16 bf16x2_t __attribute__((ext_vector_type(2)));
__device__ __forceinline__ unsigned cvt_pk_bf16(float lo, float hi) { const f32x2 v = {lo, hi}; const bf16x2_t b = __builtin_convertvector(v, bf16x2_t); return __builtin_bit_cast(unsigned, b); }

typedef _Float16 h16x2_t __attribute__((ext_vector_type(2)));
__device__ __forceinline__ unsigned cvt_pk_h16(float lo, float hi) { const f32x2 v = {lo, hi}; const h16x2_t b = __builtin_convertvector(v, h16x2_t); return __builtin_bit_cast(unsigned, b); }
__device__ __forceinline__ float h_lo(unsigned w) { return (float)__builtin_bit_cast(h16x2_t, w)[0]; }
__device__ __forceinline__ float h_hi(unsigned w) { return (float)__builtin_bit_cast(h16x2_t, w)[1]; }

#ifndef MK_SP2
#define MK_SP2 true
#endif
template <class Epi, class Sched, bool SP2 = MK_SP2>
__device__ __forceinline__ void gemm_phase(PG8_LAS unsigned char* lds, const Gemm g, const Sched& S, const Epi& E) {
    int tid = threadIdx.x; asm volatile("" : "+v"(tid));
    const int wid = __builtin_amdgcn_readfirstlane(tid >> 6), lane = tid & 63, wr = wid >> 2, wc = wid & 3, fr = lane & 15, fq = lane >> 4;
    const int K = g.K, nt = K / BK;
    unsigned voffA[2], voffB[2];
#pragma unroll
    for (int i = 0; i < 2; ++i) { int R, C; stage_rc(tid * 16 + i * 8192, R, C); const int Rb = Epi::PERM ? ((R & ~31) + perm32(R & 31)) : R;
        voffA[i] = (unsigned)(R * g.lda + C) * 2u; voffB[i] = (unsigned)(Rb * g.ldb + C) * 2u; }
    const size_t kstep = (size_t)(BK * 2);
    const size_t hstepA = (size_t)HALF * g.lda * 2, hstepB = (size_t)HALF * g.ldb * 2;
    const size_t tstepA = 2 * hstepA, tstepB = 2 * hstepB;
    const unsigned ldsw = (unsigned)wid * 1024u;
    const int aoff = lds_byte(wr * 64 + fr, fq * 8), boff = lds_byte(wc * 32 + fr, fq * 8);
#define PG8_SA(b, h) (((b) * 2 + (h)) * HTB)
#define PG8_SB(b, h) ((4 + (b) * 2 + (h)) * HTB)
#ifndef MK_STAGE_AUX
#define MK_STAGE_AUX 1
#endif
#define PG8_STAGE(bufoff, gbase, voff) do { _Pragma("unroll") for (int _i = 0; _i < 2; ++_i) \
        __builtin_amdgcn_global_load_lds((const unsigned*)((const char*)(gbase) + (voff)[_i]), (PG8_LAS unsigned*)(lds + (bufoff) + ldsw + _i * 8192), 16, 0, MK_STAGE_AUX); } while (0)
#define PG8_LDA(dst, b, h) do { _Pragma("unroll") for (int m = 0; m < 4; ++m) _Pragma("unroll") for (int k = 0; k < 2; ++k) dst[m][k] = *(const PG8_LAS bf16x8*)(lds + PG8_SA(b, h) + aoff + m * 2048 + k * 1024); } while (0)
#define PG8_LDB(dst, b, h) do { _Pragma("unroll") for (int n = 0; n < 2; ++n) _Pragma("unroll") for (int k = 0; k < 2; ++k) dst[n][k] = *(const PG8_LAS bf16x8*)(lds + PG8_SB(b, h) + boff + n * 2048 + k * 1024); } while (0)
#ifndef MK_NOPRIO
#define PG8_PRIO(x) __builtin_amdgcn_s_setprio(x)
#else
#define PG8_PRIO(x) do { } while (0)
#endif
#if !defined(MK_MMA_PLAIN)
#define PG8_MM1(ai, bj, At, Bt, m, n, k) acc[ai][bj][m][n] = __builtin_amdgcn_mfma_f32_16x16x32_bf16(Bt[n][k], At[m][k], acc[ai][bj][m][n], 0, 0, 0); __builtin_amdgcn_sched_barrier(0)
#define PG8_MMA(ai, bj, At, Bt) do { PG8_PRIO(1); _Pragma("unroll") for (int k = 0; k < 2; ++k) { PG8_MM1(ai, bj, At, Bt, 0, 0, k); PG8_MM1(ai, bj, At, Bt, 0, 1, k); PG8_MM1(ai, bj, At, Bt, 1, 1, k); PG8_MM1(ai, bj, At, Bt, 1, 0, k); \
        PG8_MM1(ai, bj, At, Bt, 2, 0, k); PG8_MM1(ai, bj, At, Bt, 2, 1, k); PG8_MM1(ai, bj, At, Bt, 3, 1, k); PG8_MM1(ai, bj, At, Bt, 3, 0, k); } PG8_PRIO(0); } while (0)
#else
#define PG8_MMA(ai, bj, At, Bt) do { PG8_PRIO(1); _Pragma("unroll") for (int m = 0; m < 4; ++m) _Pragma("unroll") for (int n = 0; n < 2; ++n) _Pragma("unroll") for (int k = 0; k < 2; ++k) \
        acc[ai][bj][m][n] = __builtin_amdgcn_mfma_f32_16x16x32_bf16(Bt[n][k], At[m][k], acc[ai][bj][m][n], 0, 0, 0); PG8_PRIO(0); } while (0)
#endif
#if !defined(MK_MMA_PLAIN)
#define PG8_MMAR(ai, bj, At, Bt) do { PG8_PRIO(1); _Pragma("unroll") for (int k = 1; k >= 0; --k) { PG8_MM1(ai, bj, At, Bt, 3, 0, k); PG8_MM1(ai, bj, At, Bt, 3, 1, k); PG8_MM1(ai, bj, At, Bt, 2, 1, k); PG8_MM1(ai, bj, At, Bt, 2, 0, k); \
        PG8_MM1(ai, bj, At, Bt, 1, 0, k); PG8_MM1(ai, bj, At, Bt, 1, 1, k); PG8_MM1(ai, bj, At, Bt, 0, 1, k); PG8_MM1(ai, bj, At, Bt, 0, 0, k); } PG8_PRIO(0); } while (0)
#define PG8_MMAX(ai) do { PG8_MMA(ai, 0, At, B0); PG8_MMAR(ai, 1, At, B1); } while (0)
#else
#define PG8_MMAX(ai) do { PG8_MMA(ai, 0, At, B0); PG8_MMA(ai, 1, At, B1); } while (0)
#endif
#define PG8_WAIT_V(n) asm volatile("s_waitcnt vmcnt(" #n ")" ::: "memory")
#define PG8_WAIT_L(n) asm volatile("s_waitcnt lgkmcnt(" #n ")" ::: "memory")
#define PG8_BAR __builtin_amdgcn_s_barrier()
#define PG8_SCHED __builtin_amdgcn_sched_barrier(0)
    Unit cur, nxt; int ui = 0;
    if (!S.next(0, cur)) return;
    f32x4 acc[2][2][4][2];
#pragma unroll
    for (int a = 0; a < 2; ++a)
#pragma unroll
        for (int b = 0; b < 2; ++b)
#pragma unroll
            for (int m = 0; m < 4; ++m)
#pragma unroll
                for (int n = 0; n < 2; ++n) acc[a][b][m][n] = (f32x4){0.f, 0.f, 0.f, 0.f};
    bf16x8 At[4][2], B0[2][2], B1[2][2];
    const char* cA = (const char*)g.A + (size_t)cur.pm * tstepA + (size_t)(cur.pn >> 1) * (size_t)g.agrp * 2 + (size_t)cur.xa * 2; const char* cB = (const char*)g.Bt + (size_t)cur.pn * tstepB + (size_t)cur.xb * 2;
    if constexpr (Epi::RSTD_LDS) E.begin(cur, tid);
    if constexpr (SP2) {
    PG8_STAGE(PG8_SB(0, 0), cB, voffB); PG8_STAGE(PG8_SB(0, 1), cB + hstepB, voffB); PG8_STAGE(PG8_SA(0, 0), cA, voffA); PG8_STAGE(PG8_SA(0, 1), cA + hstepA, voffA);
    if (wr == 1) PG8_BAR;
    PG8_WAIT_V(2); PG8_BAR;
    PG8_STAGE(PG8_SB(1, 0), cB + kstep, voffB); PG8_STAGE(PG8_SA(1, 0), cA + kstep, voffA); PG8_STAGE(PG8_SB(1, 1), cB + hstepB + kstep, voffB);
    PG8_WAIT_V(6); PG8_BAR;
    } else {
    PG8_STAGE(PG8_SB(0, 0), cB, voffB); PG8_STAGE(PG8_SA(0, 0), cA, voffA); PG8_STAGE(PG8_SB(0, 1), cB + hstepB, voffB); PG8_STAGE(PG8_SA(0, 1), cA + hstepA, voffA);
    if (wr == 1) PG8_BAR;
    PG8_WAIT_V(4); PG8_BAR;
    PG8_STAGE(PG8_SB(1, 0), cB + kstep, voffB); PG8_STAGE(PG8_SA(1, 0), cA + kstep, voffA); PG8_STAGE(PG8_SB(1, 1), cB + hstepB + kstep, voffB);
    PG8_WAIT_V(6); PG8_BAR;
    }
    for (;;) {
        const bool has_next = S.next(ui + 1, nxt);
        const char* nA = has_next ? (const char*)g.A + (size_t)nxt.pm * tstepA + (size_t)(nxt.pn >> 1) * (size_t)g.agrp * 2 + (size_t)nxt.xa * 2 : cA; const char* nB = has_next ? (const char*)g.Bt + (size_t)nxt.pn * tstepB + (size_t)nxt.xb * 2 : cB;
        for (int t = 0; t < nt; t += 2) {
            const bool last = (t == nt - 2);
            if constexpr (Epi::RSTD_LDS) { if (last) E.late(tid); }
            const char* a1 = cA + (size_t)(t + 1) * kstep;
            const char* a2 = last ? nA : cA + (size_t)(t + 2) * kstep; const char* b2 = last ? nB : cB + (size_t)(t + 2) * kstep;
            const char* a3 = a2 + kstep; const char* b3 = b2 + kstep;
            if constexpr (SP2) {
            PG8_LDB(B0, 0, 0); PG8_LDB(B1, 0, 1); PG8_SCHED; PG8_LDA(At, 0, 0); PG8_STAGE(PG8_SA(1, 1), a1 + hstepA, voffA);
            PG8_WAIT_V(8); PG8_WAIT_L(0); PG8_BAR; PG8_MMAX(0); PG8_BAR; PG8_SCHED;
            PG8_LDA(At, 0, 1); PG8_STAGE(PG8_SB(0, 0), b2, voffB); PG8_STAGE(PG8_SB(0, 1), b2 + hstepB, voffB); PG8_STAGE(PG8_SA(0, 0), a2, voffA);
            PG8_WAIT_V(8); PG8_WAIT_L(0); PG8_BAR; PG8_MMAX(1); PG8_BAR; PG8_SCHED;
            PG8_LDB(B0, 1, 0); PG8_LDB(B1, 1, 1); PG8_SCHED; PG8_LDA(At, 1, 0); PG8_STAGE(PG8_SA(0, 1), a2 + hstepA, voffA);
            PG8_WAIT_V(8); PG8_WAIT_L(0); PG8_BAR; PG8_MMAX(0); PG8_BAR; PG8_SCHED;
            PG8_LDA(At, 1, 1); PG8_STAGE(PG8_SB(1, 0), b3, voffB); PG8_STAGE(PG8_SB(1, 1), b3 + hstepB, voffB); PG8_STAGE(PG8_SA(1, 0), a3, voffA);
            PG8_WAIT_V(8); PG8_WAIT_L(0); PG8_BAR; PG8_MMAX(1); PG8_BAR; PG8_SCHED;
            } else {
            PG8_LDB(B0, 0, 0); PG8_SCHED; PG8_LDA(At, 0, 0); PG8_STAGE(PG8_SA(1, 1), a1 + hstepA, voffA);
            PG8_WAIT_L(8); PG8_BAR; PG8_WAIT_L(0); PG8_MMA(0, 0, At, B0); PG8_BAR; PG8_SCHED;
            PG8_LDB(B1, 0, 1); PG8_STAGE(PG8_SB(0, 0), b2, voffB);
            PG8_BAR; PG8_WAIT_L(0); PG8_MMA(0, 1, At, B1); PG8_BAR;
            PG8_LDA(At, 0, 1); PG8_STAGE(PG8_SA(0, 0), a2, voffA);
            PG8_BAR; PG8_WAIT_L(0); PG8_MMA(1, 0, At, B0); PG8_BAR; PG8_SCHED;
            PG8_STAGE(PG8_SB(0, 1), b2 + hstepB, voffB);
            PG8_WAIT_V(6); PG8_BAR; PG8_MMA(1, 1, At, B1); PG8_BAR;
            PG8_LDB(B0, 1, 0); PG8_SCHED; PG8_LDA(At, 1, 0); PG8_STAGE(PG8_SA(0, 1), a2 + hstepA, voffA);
            PG8_WAIT_L(8); PG8_BAR; PG8_WAIT_L(0); PG8_MMA(0, 0, At, B0); PG8_BAR; PG8_SCHED;
            PG8_LDB(B1, 1, 1); PG8_STAGE(PG8_SB(1, 0), b3, voffB);
            PG8_BAR; PG8_WAIT_L(0); PG8_MMA(0, 1, At, B1); PG8_BAR;
            PG8_LDA(At, 1, 1); PG8_STAGE(PG8_SA(1, 0), a3, voffA);
            PG8_BAR; PG8_WAIT_L(0); PG8_MMA(1, 0, At, B0); PG8_BAR; PG8_SCHED;
            PG8_STAGE(PG8_SB(1, 1), b3 + hstepB, voffB);
            PG8_WAIT_V(6); PG8_BAR; PG8_MMA(1, 1, At, B1); PG8_BAR;
            }
        }
        if (wr == 0) PG8_BAR;
        E(acc, cur, wr, wc, fr, fq);
#if defined(MK_EPI_TWICE)
        if (Epi::TWICE_OK) { asm volatile("" ::: "memory"); E(acc, cur, wr, wc, fr, fq); }
#endif
        if (!has_next) break;
#pragma unroll
        for (int a = 0; a < 2; ++a)
#pragma unroll
            for (int b = 0; b < 2; ++b)
#pragma unroll
                for (int m = 0; m < 4; ++m)
#pragma unroll
                    for (int n = 0; n < 2; ++n) acc[a][b][m][n] = (f32x4){0.f, 0.f, 0.f, 0.f};
        cur = nxt; cA = nA; cB = nB; ++ui;
        if constexpr (Epi::RSTD_LDS) E.begin(cur, tid);
        if (wr == 1) PG8_BAR;
    }
    PG8_WAIT_V(0);
    PG8_BAR;
#undef PG8_SA
#undef PG8_SB
#undef PG8_STAGE
#undef PG8_LDA
#undef PG8_LDB
#undef PG8_MMA
#undef PG8_MM1
#undef PG8_MMAR
#undef PG8_MMAX
#undef PG8_WAIT_V
#undef PG8_WAIT_L
#undef PG8_BAR
#undef PG8_SCHED
}
}
#ifndef MK_RESID_BF16
#define MK_RESID_BF16 1
#endif
namespace pg8 {
constexpr float RMS_EPS = 1e-6f;
constexpr int DM = 2048;
constexpr int LDS_RED_OFF = 131072 + 1024, LDS_RSL_OFF = 131072 + 5120, LDS_RAW_OFF = 131072 + 6144;
struct RstdLds {
    const float* ssq; PG8_LAS unsigned char* lds;
    __device__ __forceinline__ void begin(const Unit& u, int tid) const {
        const int w = __builtin_amdgcn_readfirstlane(tid >> 6), lane = tid & 63;
        __builtin_amdgcn_global_load_lds((const unsigned*)(ssq + ((size_t)(u.pm * BM + 32 * w)) * 8 + 4 * lane), (PG8_LAS unsigned*)(lds + LDS_RAW_OFF + w * 1024), 16, 0, 0);
    }
    __device__ __forceinline__ void late(int tid) const {
        const f32x4 v = *(const PG8_LAS f32x4*)(lds + LDS_RAW_OFF + tid * 16);
        float s = (v[0] + v[1]) + (v[2] + v[3]); s += __shfl_xor(s, 1);
        if ((tid & 1) == 0) ((PG8_LAS float*)(lds + LDS_RSL_OFF))[tid >> 1] = __builtin_amdgcn_rsqf(s * (1.0f / DM) + RMS_EPS);
    }
    __device__ __forceinline__ void rows8(int wr, int fr, float (&r)[2][4]) const {
        const PG8_LAS float* rsl = (const PG8_LAS float*)(lds + LDS_RSL_OFF);
#pragma unroll
        for (int ai = 0; ai < 2; ++ai)
#pragma unroll
            for (int m = 0; m < 4; ++m) r[ai][m] = rsl[ai * HALF + wr * 64 + m * 16 + fr];
    }
};
__device__ __forceinline__ float fast_sigmoid(float x) { return __builtin_amdgcn_rcpf(1.0f + __builtin_amdgcn_exp2f(-1.4426950408889634f * x)); }
__device__ __forceinline__ float fast_silu(float x) { return x * fast_sigmoid(x); }
__device__ __forceinline__ float fast_gelu_tanh(float x) { return x * fast_sigmoid(1.5957691216057308f * (x + 0.044715f * x * x * x)); }

struct EpiSwiglu {
    static constexpr bool PERM = true, TWICE_OK = true, RSTD_LDS = true;
    bf16_t* H; int ldh; RstdLds R;
    __device__ __forceinline__ void begin(const Unit& u, int tid) const { R.begin(u, tid); }
    __device__ __forceinline__ void late(int tid) const { R.late(tid); }
    __device__ __forceinline__ void operator()(const f32x4 (&acc)[2][2][4][2], const Unit& u, int wr, int wc, int fr, int fq) const {
        float rs[2][4]; R.rows8(wr, fr, rs);
        const int row0 = u.pm * BM + wr * 64 + fr, col0 = u.pn * HALF + wc * 32 + 8 * fq;
#pragma unroll
        for (int ai = 0; ai < 2; ++ai)
#pragma unroll
            for (int m = 0; m < 4; ++m) { const float r = rs[ai][m]; float v[8];
#pragma unroll
                for (int n = 0; n < 2; ++n)
#pragma unroll
                    for (int i = 0; i < 4; ++i) v[4 * n + i] = fast_silu(acc[ai][0][m][n][i] * r) * (acc[ai][1][m][n][i] * r);
                u32x4 w; w.x = cvt_pk_bf16(v[0], v[1]); w.y = cvt_pk_bf16(v[2], v[3]); w.z = cvt_pk_bf16(v[4], v[5]); w.w = cvt_pk_bf16(v[6], v[7]);
#if defined(MK_HID_NT)
                __builtin_nontemporal_store(w, (u32x4*)(H + (size_t)(row0 + ai * HALF + m * 16) * ldh + col0)); }
#else
                *(u32x4*)(H + (size_t)(row0 + ai * HALF + m * 16) * ldh + col0) = w; }
#endif
    }
};
template <bool BIAS, bool SCALE> struct EpiResid {
    static constexpr bool PERM = true, TWICE_OK = false, RSTD_LDS = false;
    bf16_t* XH; bf16_t* XB; float* ssq; const float* bias; const float* cscale; float alpha; PG8_LAS float* red;
    __device__ __forceinline__ void operator()(const f32x4 (&acc)[2][2][4][2], const Unit& u, int wr, int wc, int fr, int fq) const {
        const int row0 = u.pm * BM + wr * 64 + fr, col0 = u.pn * BM + wc * 32 + 8 * fq;
        f32x4 bv[2][2], mv[2][2];
#pragma unroll
        for (int bj = 0; bj < 2; ++bj)
#pragma unroll
            for (int n = 0; n < 2; ++n) { bv[bj][n] = BIAS ? *(const f32x4*)(bias + col0 + bj * HALF + 4 * n) : (f32x4){0.f, 0.f, 0.f, 0.f};
                                          mv[bj][n] = SCALE ? *(const f32x4*)(cscale + col0 + bj * HALF + 4 * n) * alpha : (f32x4){alpha, alpha, alpha, alpha}; }
#if !defined(MK_RESID_NOPRE)
        constexpr bool L16 = !BIAS && !SCALE;
#else
        constexpr bool L16 = false;
#endif
#ifndef MK_RESID_NPRE
#define MK_RESID_NPRE 2
#endif
        constexpr int NPRE = L16 ? MK_RESID_NPRE : 0;
        u32x4 xo2[2][4][2];
        if constexpr (L16) {
#pragma unroll
            for (int ai = 0; ai < 2; ++ai)
#pragma unroll
                for (int m = 0; m < (ai ? NPRE : 4); ++m)
#pragma unroll
                    for (int bj = 0; bj < 2; ++bj) xo2[ai][m][bj] = *(const u32x4*)((MK_RESID_BF16 ? XB : XH) + (size_t)(row0 + ai * HALF + m * 16) * DM + col0 + bj * HALF);
        }
#pragma unroll
        for (int ai = 0; ai < 2; ++ai) { u32x4 xo[4][2];
#pragma unroll
            for (int m = 0; m < 4; ++m)
#pragma unroll
                for (int bj = 0; bj < 2; ++bj) { if (L16 && (ai == 0 || m < NPRE)) xo[m][bj] = xo2[ai][m][bj]; else xo[m][bj] = *(const u32x4*)((MK_RESID_BF16 ? XB : XH) + (size_t)(row0 + ai * HALF + m * 16) * DM + col0 + bj * HALF); }
#pragma unroll
            for (int m = 0; m < 4; ++m) { const int row = row0 + ai * HALF + m * 16; const size_t off = (size_t)row * DM + col0; float ss = 0.f;
#pragma unroll
                for (int bj = 0; bj < 2; ++bj) { const u32x4 q = xo[m][bj];
                    const f32x4 x0 = MK_RESID_BF16 ? (f32x4){__uint_as_float(q.x << 16), __uint_as_float(q.x & 0xffff0000u), __uint_as_float(q.y << 16), __uint_as_float(q.y & 0xffff0000u)} : (f32x4){h_lo(q.x), h_hi(q.x), h_lo(q.y), h_hi(q.y)};
                    const f32x4 x1 = MK_RESID_BF16 ? (f32x4){__uint_as_float(q.z << 16), __uint_as_float(q.z & 0xffff0000u), __uint_as_float(q.w << 16), __uint_as_float(q.w & 0xffff0000u)} : (f32x4){h_lo(q.z), h_hi(q.z), h_lo(q.w), h_hi(q.w)};
                    f32x4 a0 = acc[ai][bj][m][0], a1 = acc[ai][bj][m][1]; if (BIAS) { a0 = a0 + bv[bj][0]; a1 = a1 + bv[bj][1]; }
                    const f32x4 v0 = x0 + a0 * mv[bj][0], v1 = x1 + a1 * mv[bj][1];
                    u32x4 w; w.x = cvt_pk_bf16(v0[0], v0[1]); w.y = cvt_pk_bf16(v0[2], v0[3]); w.z = cvt_pk_bf16(v1[0], v1[1]); w.w = cvt_pk_bf16(v1[2], v1[3]);
                    *(u32x4*)(XB + off + bj * HALF) = w;
                    if (MK_RESID_BF16) {
                        const float r0 = __uint_as_float(w.x << 16), r1 = __uint_as_float(w.x & 0xffff0000u), r2 = __uint_as_float(w.y << 16), r3 = __uint_as_float(w.y & 0xffff0000u);
                        const float r4 = __uint_as_float(w.z << 16), r5 = __uint_as_float(w.z & 0xffff0000u), r6 = __uint_as_float(w.w << 16), r7 = __uint_as_float(w.w & 0xffff0000u);
                        ss += ((r0 * r0 + r1 * r1) + (r2 * r2 + r3 * r3)) + ((r4 * r4 + r5 * r5) + (r6 * r6 + r7 * r7));
                    } else {
                        u32x4 wh; wh.x = cvt_pk_h16(v0[0], v0[1]); wh.y = cvt_pk_h16(v0[2], v0[3]); wh.z = cvt_pk_h16(v1[0], v1[1]); wh.w = cvt_pk_h16(v1[2], v1[3]);
                        *(u32x4*)(XH + off + bj * HALF) = wh;
                        ss += ((v0[0] * v0[0] + v0[1] * v0[1]) + (v0[2] * v0[2] + v0[3] * v0[3])) + ((v1[0] * v1[0] + v1[1] * v1[1]) + (v1[2] * v1[2] + v1[3] * v1[3])); } }
                ss += __shfl_xor(ss, 16); ss += __shfl_xor(ss, 32);
                if (fq == 0) red[(ai * HALF + wr * 64 + m * 16 + fr) * 4 + wc] = ss; }
            asm volatile("" ::: "memory"); }
        asm volatile("s_waitcnt lgkmcnt(0)" ::: "memory"); __builtin_amdgcn_s_barrier(); asm volatile("" ::: "memory");
        { const int t = threadIdx.x; if (t < BM) { const f32x4 r4 = *(const PG8_LAS f32x4*)(red + 4 * t); ssq[((size_t)(u.pm * BM + t)) * 8 + u.pn] = (r4[0] + r4[1]) + (r4[2] + r4[3]); } }
        asm volatile("s_waitcnt lgkmcnt(0)" ::: "memory"); __builtin_amdgcn_s_barrier(); asm volatile("" ::: "memory");
    }
};
struct EpiResidFinal {
    static constexpr bool PERM = true, TWICE_OK = false, RSTD_LDS = false;
    const bf16_t* XB; float* ssq; float alpha; PG8_LAS float* red; PG8_LAS float* rsl; float* out; const float* gfin; unsigned* cnt; unsigned* tmo;
    __device__ __forceinline__ void operator()(const f32x4 (&acc_)[2][2][4][2], const Unit& u, int wr, int wc, int fr_, int fq) const {
        f32x4 (&acc)[2][2][4][2] = const_cast<f32x4 (&)[2][2][4][2]>(acc_);
        int fr = fr_; asm volatile("" : "+v"(fr));
        const int rb = wr * 64 + fr, row0 = u.pm * BM + rb, col0 = u.pn * BM + wc * 32 + 8 * fq;
#pragma unroll
        for (int ai = 0; ai < 2; ++ai) { u32x4 xo[4][2];
#pragma unroll
            for (int m = 0; m < 4; ++m)
#pragma unroll
                for (int bj = 0; bj < 2; ++bj) xo[m][bj] = *(const u32x4*)(XB + (size_t)(row0 + ai * HALF + m * 16) * DM + col0 + bj * HALF);
#pragma unroll
            for (int m = 0; m < 4; ++m) { float ss = 0.f;
#pragma unroll
                for (int bj = 0; bj < 2; ++bj) { const u32x4 q = xo[m][bj];
                    const f32x4 x0 = (f32x4){__uint_as_float(q.x << 16), __uint_as_float(q.x & 0xffff0000u), __uint_as_float(q.y << 16), __uint_as_float(q.y & 0xffff0000u)};
                    const f32x4 x1 = (f32x4){__uint_as_float(q.z << 16), __uint_as_float(q.z & 0xffff0000u), __uint_as_float(q.w << 16), __uint_as_float(q.w & 0xffff0000u)};
                    const f32x4 v0 = x0 + acc[ai][bj][m][0] * alpha, v1 = x1 + acc[ai][bj][m][1] * alpha; acc[ai][bj][m][0] = v0; acc[ai][bj][m][1] = v1;
                    ss += ((v0[0] * v0[0] + v0[1] * v0[1]) + (v0[2] * v0[2] + v0[3] * v0[3])) + ((v1[0] * v1[0] + v1[1] * v1[1]) + (v1[2] * v1[2] + v1[3] * v1[3])); }
                ss += __shfl_xor(ss, 16); ss += __shfl_xor(ss, 32);
                if (fq == 0) red[(ai * HALF + m * 16 + rb) * 4 + wc] = ss; }
            asm volatile("" ::: "memory"); }
        asm volatile("s_waitcnt lgkmcnt(0)" ::: "memory"); __builtin_amdgcn_s_barrier(); asm volatile("" ::: "memory");
        const int t = threadIdx.x;
        if (t < BM) { const f32x4 r4 = *(const PG8_LAS f32x4*)(red + 4 * t); ssq[((size_t)(u.pm * BM + t)) * 8 + u.pn] = (r4[0] + r4[1]) + (r4[2] + r4[3]); }
        asm volatile("s_waitcnt vmcnt(0) lgkmcnt(0)" ::: "memory"); __builtin_amdgcn_s_barrier(); asm volatile("" ::: "memory");
        if (t == 0) { unsigned* cw = cnt + 64 * u.pm;
            __builtin_amdgcn_fence(__ATOMIC_RELEASE, "agent"); asm volatile("s_waitcnt vmcnt(0)" ::: "memory");
            (void)__hip_atomic_fetch_add(cw, 1u, __ATOMIC_RELAXED, __HIP_MEMORY_SCOPE_AGENT);
            unsigned sp = 0;
            while (__hip_atomic_load(cw, __ATOMIC_RELAXED, __HIP_MEMORY_SCOPE_AGENT) < 8u) { __builtin_amdgcn_s_sleep(1);
                if ((++sp & 255u) == 0u) { if (__hip_atomic_load(tmo, __ATOMIC_RELAXED, __HIP_MEMORY_SCOPE_AGENT)) break; if (sp > (1u << 18)) { atomicAdd(tmo, 1u); break; } } }
            __builtin_amdgcn_fence(__ATOMIC_ACQUIRE, "agent"); asm volatile("s_waitcnt vmcnt(0)" ::: "memory"); }
        asm volatile("" ::: "memory"); __builtin_amdgcn_s_barrier(); asm volatile("" ::: "memory");
        if (t < BM) { const f32x4* sp4 = (const f32x4*)(ssq + ((size_t)(u.pm * BM + t)) * 8); const f32x4 a = sp4[0], b = sp4[1];
            rsl[t] = __builtin_amdgcn_rsqf((((a[0] + a[1]) + (a[2] + a[3])) + ((b[0] + b[1]) + (b[2] + b[3]))) * (1.0f / DM) + RMS_EPS); }
        asm volatile("s_waitcnt vmcnt(0) lgkmcnt(0)" ::: "memory"); __builtin_amdgcn_s_barrier(); asm volatile("" ::: "memory");
        f32x4 gv[2][2];
#pragma unroll
        for (int bj = 0; bj < 2; ++bj)
#pragma unroll
            for (int n = 0; n < 2; ++n) gv[bj][n] = *(const f32x4*)(gfin + col0 + bj * HALF + 4 * n);
#pragma unroll
        for (int ai = 0; ai < 2; ++ai)
#pragma unroll
            for (int m = 0; m < 4; ++m) { const float r = rsl[ai * HALF + m * 16 + rb]; float* op = out + (size_t)(row0 + ai * HALF + m * 16) * DM + col0;
#pragma unroll
                for (int bj = 0; bj < 2; ++bj)
#pragma unroll
                    for (int n = 0; n < 2; ++n) *(f32x4*)(op + bj * HALF + 4 * n) = acc[ai][bj][m][n] * r * gv[bj][n]; }
    }
};
struct EpiWin {
    static constexpr bool PERM = true, TWICE_OK = false, RSTD_LDS = true;
    bf16_t *U, *V, *HB; float* lnp; RstdLds R; const float* bias;
    __device__ __forceinline__ void begin(const Unit& u, int tid) const { R.begin(u, tid); }
    __device__ __forceinline__ void late(int tid) const { R.late(tid); }
    __device__ __forceinline__ void operator()(const f32x4 (&acc)[2][2][4][2], const Unit& u, int wr, int wc, int fr, int fq) const {
        float rs[2][4]; R.rows8(wr, fr, rs);
        const int row0 = u.pm * BM + wr * 64 + fr;
        if (u.pn < 8) {
            const bool isv = u.pn >= 4; bf16_t* dst = isv ? V : U;
            const int colt = (u.pn & 3) * BM + wc * 32 + 8 * fq, bcol = u.pn * BM + wc * 32 + 8 * fq;
            f32x4 bv[2][2];
#pragma unroll
            for (int bj = 0; bj < 2; ++bj)
#pragma unroll
                for (int n = 0; n < 2; ++n) bv[bj][n] = *(const f32x4*)(bias + bcol + bj * HALF + 4 * n);
#pragma unroll
            for (int ai = 0; ai < 2; ++ai)
#pragma unroll
                for (int m = 0; m < 4; ++m) { const int row = row0 + ai * HALF + m * 16; const float r = rs[ai][m]; float s1 = 0.f, s2 = 0.f;
#pragma unroll
                    for (int bj = 0; bj < 2; ++bj) { float v[8];
#pragma unroll
                        for (int n = 0; n < 2; ++n)
#pragma unroll
                            for (int i = 0; i < 4; ++i) { const float g = fast_gelu_tanh(acc[ai][bj][m][n][i] * r + bv[bj][n][i]); v[4 * n + i] = g; s1 += g; s2 += g * g; }
                        u32x4 w; w.x = cvt_pk_bf16(v[0], v[1]); w.y = cvt_pk_bf16(v[2], v[3]); w.z = cvt_pk_bf16(v[4], v[5]); w.w = cvt_pk_bf16(v[6], v[7]);
                        *(u32x4*)(dst + (size_t)row * 1024 + colt + bj * HALF) = w; }
                    if (isv) { s1 += __shfl_xor(s1, 16); s1 += __shfl_xor(s1, 32); s2 += __shfl_xor(s2, 16); s2 += __shfl_xor(s2, 32);
                        if (fq == 0) *(f32x2*)(lnp + ((size_t)row * 16 + (u.pn - 4) * 4 + wc) * 2) = (f32x2){s1, s2}; } }
        } else {
            const int j0 = (u.pn - 8) * HALF + wc * 32 + 8 * fq;
            f32x4 ba[2], bg[2];
#pragma unroll
            for (int n = 0; n < 2; ++n) { ba[n] = *(const f32x4*)(bias + 2048 + j0 + 4 * n); bg[n] = *(const f32x4*)(bias + 3072 + j0 + 4 * n); }
#pragma unroll
            for (int ai = 0; ai < 2; ++ai)
#pragma unroll
                for (int m = 0; m < 4; ++m) { const int row = row0 + ai * HALF + m * 16; const float r = rs[ai][m]; float v[8];
#pragma unroll
                    for (int n = 0; n < 2; ++n)
#pragma unroll
                        for (int i = 0; i < 4; ++i) v[4 * n + i] = (acc[ai][0][m][n][i] * r + ba[n][i]) * fast_sigmoid(acc[ai][1][m][n][i] * r + bg[n][i]);
                    u32x4 w; w.x = cvt_pk_bf16(v[0], v[1]); w.y = cvt_pk_bf16(v[2], v[3]); w.z = cvt_pk_bf16(v[4], v[5]); w.w = cvt_pk_bf16(v[6], v[7]);
                    *(u32x4*)(HB + (size_t)row * 1024 + j0) = w; }
        }
    }
};
struct EpiNone {
    static constexpr bool PERM = true, TWICE_OK = false, RSTD_LDS = false;
    __device__ __forceinline__ void operator()(const f32x4 (&acc)[2][2][4][2], const Unit&, int, int, int, int) const {
#pragma unroll
        for (int ai = 0; ai < 2; ++ai)
#pragma unroll
            for (int bj = 0; bj < 2; ++bj)
#pragma unroll
                for (int m = 0; m < 4; ++m) asm volatile("" :: "v"(acc[ai][bj][m][0]), "v"(acc[ai][bj][m][1]));
    }
};
struct EpiQ {
    static constexpr bool PERM = true, TWICE_OK = false, RSTD_LDS = true;
    bf16_t* Q; RstdLds R; float qscale;
    __device__ __forceinline__ void begin(const Unit& u, int tid) const { R.begin(u, tid); }
    __device__ __forceinline__ void late(int tid) const { R.late(tid); }
    __device__ __forceinline__ void operator()(const f32x4 (&acc)[2][2][4][2], const Unit& u, int wr, int wc, int fr, int fq) const {
        float rs[2][4]; R.rows8(wr, fr, rs);
        const int row0 = u.pm * BM + wr * 64 + fr, col0 = u.pn * BM + wc * 32 + 8 * fq;
#pragma unroll
        for (int ai = 0; ai < 2; ++ai)
#pragma unroll
            for (int m = 0; m < 4; ++m) { const float r = rs[ai][m] * qscale; bf16_t* rowp = Q + (size_t)(row0 + ai * HALF + m * 16) * DM + col0;
#pragma unroll
                for (int bj = 0; bj < 2; ++bj) { const f32x4 v0 = acc[ai][bj][m][0] * r, v1 = acc[ai][bj][m][1] * r;
                    u32x4 w; w.x = cvt_pk_bf16(v0[0], v0[1]); w.y = cvt_pk_bf16(v0[2], v0[3]); w.z = cvt_pk_bf16(v1[0], v1[1]); w.w = cvt_pk_bf16(v1[2], v1[3]);
                    *(u32x4*)(rowp + bj * HALF) = w; } }
    }
};
struct EpiKV {
    static constexpr bool PERM = true, TWICE_OK = false, RSTD_LDS = false;
    bf16_t* KB; bf16_t* VB; const float* rstd_mem;
    __device__ __forceinline__ void operator()(const f32x4 (&acc)[2][2][4][2], const Unit& u, int wr, int wc, int fr, int fq) const {
        const int row0 = u.pm * BM + wr * 64 + fr, l = (u.pn >> 3) & 3, col0 = (u.pn & 7) * BM + wc * 32 + 8 * fq; bf16_t* dst = (u.pn < 32) ? KB : VB;
#pragma unroll
        for (int ai = 0; ai < 2; ++ai)
#pragma unroll
            for (int m = 0; m < 4; ++m) { const int row = row0 + ai * HALF + m * 16; const float r = rstd_mem[row]; bf16_t* rowp = dst + ((size_t)l * 1024 + row) * DM + col0;
#pragma unroll
                for (int bj = 0; bj < 2; ++bj) { const f32x4 v0 = acc[ai][bj][m][0] * r, v1 = acc[ai][bj][m][1] * r;
                    u32x4 w; w.x = cvt_pk_bf16(v0[0], v0[1]); w.y = cvt_pk_bf16(v0[2], v0[3]); w.z = cvt_pk_bf16(v1[0], v1[1]); w.w = cvt_pk_bf16(v1[2], v1[3]);
                    *(u32x4*)(rowp + bj * HALF) = w; } }
    }
};
struct EpiPre {
    static constexpr bool PERM = true, TWICE_OK = false, RSTD_LDS = false;
    bf16_t* VWt; bf16_t* KWg;
    __device__ __forceinline__ void operator()(const f32x4 (&acc)[2][2][4][2], const Unit& u, int wr, int wc, int fr, int fq) const {
        const int e = u.id, t = e & 7, b = (e >> 3) & 3, h = (e >> 5) & 3, l = (e >> 7) & 3; const bool kw = e >= 512; const int ldc = kw ? 2048 : 1024;
        bf16_t* base = kw ? KWg + ((size_t)(l * 4 + b) * 1024 + h * 256 + wr * 64 + fr) * 2048 + t * BM + wc * 32 + 8 * fq
                          : VWt + ((size_t)(l * 4 + b) * 2048 + t * BM + wr * 64 + fr) * 1024 + h * 256 + wc * 32 + 8 * fq;
#pragma unroll
        for (int ai = 0; ai < 2; ++ai)
#pragma unroll
            for (int m = 0; m < 4; ++m) { bf16_t* rowp = base + (size_t)(ai * HALF + m * 16) * ldc;
#pragma unroll
                for (int bj = 0; bj < 2; ++bj) { const f32x4 v0 = acc[ai][bj][m][0], v1 = acc[ai][bj][m][1];
                    u32x4 w; w.x = cvt_pk_bf16(v0[0], v0[1]); w.y = cvt_pk_bf16(v0[2], v0[3]); w.z = cvt_pk_bf16(v1[0], v1[1]); w.w = cvt_pk_bf16(v1[2], v1[3]);
                    *(u32x4*)(rowp + bj * HALF) = w; } }
    }
};
struct EpiSoftmax {
    static constexpr bool PERM = true, TWICE_OK = false, RSTD_LDS = true;
    bf16_t* P; RstdLds R; float qscale; PG8_LAS float* red; PG8_LAS float* red2;
    __device__ __forceinline__ void begin(const Unit& u, int tid) const { R.begin(u, tid); }
    __device__ __forceinline__ void late(int tid) const { R.late(tid); }
    __device__ __forceinline__ void operator()(const f32x4 (&acc_)[2][2][4][2], const Unit& u, int wr, int wc, int fr_, int fq) const {
        f32x4 (&acc)[2][2][4][2] = const_cast<f32x4 (&)[2][2][4][2]>(acc_);
        int fr = fr_; asm volatile("" : "+v"(fr));
        const int rb = wr * 64 + fr;
        const PG8_LAS float* rsl = (const PG8_LAS float*)(R.lds + LDS_RSL_OFF) + rb;
        PG8_LAS float* r1 = red + 4 * rb; PG8_LAS float* r2 = red2 + 4 * rb;
#pragma unroll
        for (int ai = 0; ai < 2; ++ai)
#pragma unroll
            for (int m = 0; m < 4; ++m) { float mx = acc[ai][0][m][0][0];
#pragma unroll
                for (int bj = 0; bj < 2; ++bj)
#pragma unroll
                    for (int n = 0; n < 2; ++n)
#pragma unroll
                        for (int i = 0; i < 4; ++i) mx = fmaxf(mx, acc[ai][bj][m][n][i]);
                mx = fmaxf(mx, __shfl_xor(mx, 16)); mx = fmaxf(mx, __shfl_xor(mx, 32));
                if (fq == 0) r1[(ai * HALF + m * 16) * 4 + wc] = mx * (rsl[ai * HALF + m * 16] * qscale); }
        asm volatile("s_waitcnt lgkmcnt(0)" ::: "memory"); __builtin_amdgcn_s_barrier(); asm volatile("" ::: "memory");
#pragma unroll
        for (int ai = 0; ai < 2; ++ai)
#pragma unroll
            for (int m = 0; m < 4; ++m) { const f32x4 m4 = *(const PG8_LAS f32x4*)(r1 + (ai * HALF + m * 16) * 4);
                const float mx = fmaxf(fmaxf(m4[0], m4[1]), fmaxf(m4[2], m4[3])), r = rsl[ai * HALF + m * 16] * qscale; float sum = 0.f;
#pragma unroll
                for (int bj = 0; bj < 2; ++bj)
#pragma unroll
                    for (int n = 0; n < 2; ++n)
#pragma unroll
                        for (int i = 0; i < 4; ++i) { const float pz = __builtin_amdgcn_exp2f(acc[ai][bj][m][n][i] * r - mx); acc[ai][bj][m][n][i] = pz; sum += pz; }
                sum += __shfl_xor(sum, 16); sum += __shfl_xor(sum, 32);
                if (fq == 0) r2[(ai * HALF + m * 16) * 4 + wc] = sum; }
        asm volatile("s_waitcnt lgkmcnt(0)" ::: "memory"); __builtin_amdgcn_s_barrier(); asm volatile("" ::: "memory");
        bf16_t* base = P + (size_t)(u.pm * BM + rb) * 1024 + u.pn * BM + wc * 32 + 8 * fq;
#pragma unroll
        for (int ai = 0; ai < 2; ++ai)
#pragma unroll
            for (int m = 0; m < 4; ++m) { const f32x4 s4 = *(const PG8_LAS f32x4*)(r2 + (ai * HALF + m * 16) * 4);
                const float inv = __builtin_amdgcn_rcpf((s4[0] + s4[1]) + (s4[2] + s4[3])); bf16_t* rowp = base + (size_t)(ai * HALF + m * 16) * 1024;
#pragma unroll
                for (int bj = 0; bj < 2; ++bj) { const f32x4 v0 = acc[ai][bj][m][0] * inv, v1 = acc[ai][bj][m][1] * inv;
                    u32x4 w; w.x = cvt_pk_bf16(v0[0], v0[1]); w.y = cvt_pk_bf16(v0[2], v0[3]); w.z = cvt_pk_bf16(v1[0], v1[1]); w.w = cvt_pk_bf16(v1[2], v1[3]);
                    *(u32x4*)(rowp + bj * HALF) = w; } }
    }
};
}
namespace mk {
using pg8::bf16_t; using pg8::bf16x8; using pg8::f32x4; using pg8::f32x2; using pg8::u32x4; using pg8::u32x2;
#define LAS __attribute__((address_space(3)))
typedef unsigned short bf16;
constexpr int D = 2048, NB = 4, S = 2048, M = NB * S, F = 5632, NM = 256, MM = NB * NM, NL = 4, NWAVES = 8, NTHREADS = 512;
constexpr float EPS = 1e-6f;
constexpr float QSCALE = 0.044194173824159216f * 1.4426950408889634f;

constexpr size_t MiB = 1u << 20;
constexpr size_t WS_CTL = 0, CTL_BYTES = 1 * MiB;
constexpr size_t SZ_WGU = (size_t)2 * F * D * 2, SZ_WDN = (size_t)D * F * 2, SZ_SQ = (size_t)D * D * 2;
constexpr size_t WS_WGU = 1 * MiB;
constexpr size_t WS_WDN = WS_WGU + 8 * SZ_WGU;
constexpr size_t WS_WQ = WS_WDN + 8 * SZ_WDN;
constexpr size_t WS_WO = WS_WQ + 4 * SZ_SQ;
constexpr size_t WS_WK = WS_WO + 4 * SZ_SQ;
constexpr size_t WS_WV = WS_WK + 4 * SZ_SQ;
constexpr size_t WS_WIN = WS_WV + 4 * SZ_SQ;
constexpr size_t WS_WOUT = WS_WIN + 2 * 2 * SZ_SQ;
constexpr size_t WS_WPOOL = WS_WOUT + 2 * SZ_SQ;
constexpr size_t WS_WSG = WS_WPOOL + 2 * (size_t)2048 * 512 * 2;
constexpr size_t WS_X = WS_WSG + 2 * (size_t)8 * 128 * 128 * 2;
constexpr size_t WS_XB = WS_X + (size_t)M * D * 4;
constexpr size_t WS_SSQ = WS_XB + (size_t)M * D * 2;
constexpr size_t WS_LNP = WS_SSQ + (size_t)M * 32 * 4;
constexpr size_t WS_MEMB = WS_LNP + (size_t)M * 32 * 4;
constexpr size_t WS_RMEM = WS_MEMB + (size_t)MM * D * 2;
constexpr size_t WS_KB = WS_RMEM + 4096;
constexpr size_t WS_VT = WS_KB + (size_t)NL * MM * D * 2;
constexpr size_t WS_HID = WS_VT + (size_t)NL * MM * D * 2;
constexpr size_t WS_U = WS_HID, WS_V = WS_U + (size_t)M * 1024 * 2, WS_HB = WS_V + (size_t)M * 1024 * 2, WS_YC = WS_HB + (size_t)M * 1024 * 2;
constexpr size_t WS_DD = WS_HID;
constexpr size_t WS_Q = WS_HID, WS_O = WS_Q + (size_t)M * D * 2;
constexpr size_t WS_P = WS_O;
constexpr size_t WS_VW = (WS_HID + (size_t)M * F * 2 + 4095) & ~(size_t)4095;
constexpr size_t WS_KW = WS_VW + (size_t)NL * NB * D * 1024 * 2;
constexpr size_t WS_END = WS_KW + (size_t)NL * NB * 1024 * D * 2;
static_assert(WS_YC + (size_t)M * D * 2 <= WS_HID + (size_t)M * F * 2 && WS_O + (size_t)M * D * 2 <= WS_HID + (size_t)M * F * 2, "overlays fit in HID");

constexpr int RING_BYTES = 131072, LDSCTL_OFF = RING_BYTES, MISC_OFF = LDSCTL_OFF + 320, LDS_RED2_OFF = 147456, LDS_BYTES = 151552;

typedef unsigned v4u __attribute__((ext_vector_type(4)));
#define LDS_WAIT() asm volatile("s_waitcnt lgkmcnt(0)" ::: "memory")
#define VM_WAIT() asm volatile("s_waitcnt vmcnt(0)" ::: "memory")
__device__ __forceinline__ unsigned f2bf(float f) { unsigned u = __builtin_bit_cast(unsigned, f); return (u + 0x7fffu + ((u >> 16) & 1u)) >> 16; }
__device__ __forceinline__ unsigned pk2(float lo, float hi) { return f2bf(lo) | (f2bf(hi) << 16); }
__device__ __forceinline__ float bflo(unsigned w) { return __builtin_bit_cast(float, w << 16); }
__device__ __forceinline__ float bfhi(unsigned w) { return __builtin_bit_cast(float, w & 0xffff0000u); }
__device__ __forceinline__ float wave_sum(float v) {
#pragma unroll
    for (int o = 1; o < 64; o <<= 1) v += __shfl_xor(v, o);
    return v;
}
typedef __attribute__((address_space(1))) unsigned gu32;
#define RLX_AGENT __ATOMIC_RELAXED, __HIP_MEMORY_SCOPE_AGENT
#define XB_TMO      128
#define XB_XCNT(j)  (256  + 64 * (j))
#define XB_XSUB(j)  (1280 + 64 * (j))
#define XB_XGEN(j)  (2304 + 64 * (j))
#define XB_TOP      3328
#define XB_TOPGEN   3392
#define XCD_BAR_WORDS 3456
#define XB_SPIN_CAP (1u << 18)

__device__ __forceinline__ unsigned xb_ld(unsigned* p)              { return __hip_atomic_load(p, __ATOMIC_RELAXED, __HIP_MEMORY_SCOPE_AGENT); }
__device__ __forceinline__ unsigned xb_add(unsigned* p, unsigned v) { return __hip_atomic_fetch_add(p, v, __ATOMIC_RELAXED, __HIP_MEMORY_SCOPE_AGENT); }
__device__ __forceinline__ unsigned xb_xcc_id() { return (unsigned)__builtin_amdgcn_s_getreg((3 << 11) | 20) & 0xFu; }
#define XB_SPIN(cond, bar) do { unsigned _sp = 0; while (cond) { __builtin_amdgcn_s_sleep(1); \
    if ((++_sp & 255u) == 0u) { if (xb_ld(&(bar)[XB_TMO])) break; if (_sp > XB_SPIN_CAP) { atomicAdd(&(bar)[XB_TMO], 1u); break; } } } } while (0)

struct XcdBarrier {
    unsigned* bar; unsigned x;
    volatile LAS unsigned* st;
};

__device__ __forceinline__ XcdBarrier xcd_barrier_post(unsigned* bar, volatile LAS unsigned* st) {
    XcdBarrier b; b.bar = bar; b.x = xb_xcc_id(); b.st = st;
    if (threadIdx.x == 0) (void)xb_add(&bar[XB_XCNT(b.x)], 1u);
    return b;
}
__device__ __forceinline__ void xcd_barrier_complete(unsigned* bar, unsigned x, unsigned& nloc, unsigned& nx) {
    const unsigned G = gridDim.x * gridDim.y * gridDim.z;
    unsigned sum, cnt, mine, sp = 0u;
    for (;;) {
        sum = 0u; cnt = 0u; mine = 0u;
#pragma unroll
        for (unsigned j = 0; j < 16; ++j) { const unsigned c = xb_ld(&bar[XB_XCNT(j)]); sum += c; cnt += (c > 0u) ? 1u : 0u; }
        if (sum == G) break;
        __builtin_amdgcn_s_sleep(1);
        if ((++sp & 255u) == 0u) { if (xb_ld(&bar[XB_TMO])) break; if (sp > XB_SPIN_CAP) { atomicAdd(&bar[XB_TMO], 1u); break; } }
    }
    mine = xb_ld(&bar[XB_XCNT(x)]);
    nloc = mine > 0u ? mine : 1u; nx = cnt > 0u ? cnt : 1u;
}

__device__ __forceinline__ void xcd_barrier(const XcdBarrier& b) {
    asm volatile("s_waitcnt vmcnt(0)" ::: "memory");
    __syncthreads();
    if (threadIdx.x == 0) {
        unsigned* bar = b.bar;
        __builtin_amdgcn_s_waitcnt(0);
        unsigned nloc = b.st[0], nx = b.st[1];
        if (nloc == 0u) { xcd_barrier_complete(bar, b.x, nloc, nx); b.st[0] = nloc; b.st[1] = nx; }
        const unsigned old = xb_add(&bar[XB_XSUB(b.x)], 1u);
        const unsigned gen = old / nloc;
        if (old + 1u == (gen + 1u) * nloc) {
            __builtin_amdgcn_fence(__ATOMIC_RELEASE, "agent");
            asm volatile("s_waitcnt vmcnt(0)" ::: "memory");
#if defined(MK_LEADER_EARLY_INV)
            __builtin_amdgcn_fence(__ATOMIC_ACQUIRE, "agent");
            asm volatile("s_waitcnt vmcnt(0)" ::: "memory");
#endif
            const unsigned og = xb_add(&bar[XB_TOP], 1u);
            if (og + 1u == (gen + 1u) * nx) xb_add(&bar[XB_TOPGEN], 1u);
            else XB_SPIN(xb_ld(&bar[XB_TOPGEN]) == gen, bar);
#if !defined(MK_LEADER_EARLY_INV)
            __builtin_amdgcn_fence(__ATOMIC_ACQUIRE, "agent");
            asm volatile("s_waitcnt vmcnt(0)" ::: "memory");
#endif
            xb_add(&bar[XB_XGEN(b.x)], 1u);
        } else {
            __builtin_amdgcn_fence(__ATOMIC_ACQUIRE, "agent");
            asm volatile("s_waitcnt vmcnt(0)" ::: "memory");
            XB_SPIN(xb_ld(&bar[XB_XGEN(b.x)]) == gen, bar);
        }
        __builtin_amdgcn_fence(__ATOMIC_ACQUIRE, "workgroup");
    }
    __syncthreads();
}

struct Ctx { LAS unsigned char* lds; int tid, lane, wave, vcu, G; unsigned char* ws; const float* const* in; };
#define WSP(T, off) ((T*)(c.ws + (off)))
__device__ __forceinline__ int deal_item(int vcu, int G, int N, int k) {
    if (G == 256 && (N & 255) == 0) return (k < (N >> 8)) ? (vcu >> 5) * (N >> 3) + (vcu & 31) + 32 * k : -1;
    const int it = vcu + k * G; return it < N ? it : -1;
}
#define SBAR() do { asm volatile("" ::: "memory"); __builtin_amdgcn_s_barrier(); asm volatile("" ::: "memory"); } while (0)

struct Job { const float* W; const float* gain; bf16* WT; int ldw, c0, K, rmul, radd, kb, nb; };
__device__ __forceinline__ void job_load(const Job& j, float (&v)[32], int lane) {
    const float* src = j.W + (size_t)(64 * j.kb + (lane >> 5)) * j.ldw + j.c0 + 32 * j.nb + (lane & 31);
#pragma unroll
    for (int i = 0; i < 32; ++i) v[i] = __builtin_nontemporal_load(src + (size_t)(2 * i) * j.ldw);
}
__device__ __forceinline__ void job_finish(const Job& j, float (&v)[32], LAS float* scr, int lane) {
    const int k0 = 64 * j.kb, n0 = 32 * j.nb;
    if (j.gain) { const float* gp = j.gain + k0 + (lane >> 5);
#pragma unroll
        for (int i = 0; i < 32; ++i) v[i] *= gp[2 * i]; }
#pragma unroll
    for (int i = 0; i < 32; ++i) scr[(2 * i + (lane >> 5)) * 33 + (lane & 31)] = v[i];
    LDS_WAIT(); asm volatile("" ::: "memory");
    const int cc = lane & 7;
#pragma unroll
    for (int q = 0; q < 4; ++q) { const int n = (lane >> 3) + 8 * q; const LAS float* sp = scr + (8 * cc) * 33 + n;
        v4u o; o.x = pk2(sp[0 * 33], sp[1 * 33]); o.y = pk2(sp[2 * 33], sp[3 * 33]); o.z = pk2(sp[4 * 33], sp[5 * 33]); o.w = pk2(sp[6 * 33], sp[7 * 33]);
        const int nn = n0 + n, drow = (nn >> 7) * j.rmul + (nn & 127) + j.radd;
        __builtin_nontemporal_store(o, (v4u*)(j.WT + (size_t)drow * j.K + k0 + 8 * cc)); }
    LDS_WAIT(); asm volatile("" ::: "memory");
}
constexpr int IT_GU = (D / 64) * (F / 32), IT_SQ = (D / 64) * (D / 32), IT_POOL = (512 / 64) * (512 / 32);
static_assert((F / 64) * (D / 32) == IT_GU, "down-projection item count equals gate/up item count");
constexpr int L_COMMON = 6 * IT_GU, L_EVEN = L_COMMON + 3 * IT_SQ, L_ODD = L_COMMON + 4 * IT_POOL, KV_ITEMS = NL * 3 * IT_SQ;
__host__ __device__ constexpr int layer_items(int l) { return (l & 1) ? L_ODD : L_EVEN; }
__host__ __device__ constexpr int mixer_items(int l) { return (l & 1) ? 4 * IT_POOL : 3 * IT_SQ; }
__device__ __forceinline__ Job decode_job(const Ctx& c, int l, int r) {
    Job j; j.c0 = 0; j.rmul = 128; j.radd = 0; j.gain = nullptr; int nblk;
    if (l < 0) { const int ll = r / (3 * IT_SQ); r -= ll * 3 * IT_SQ; const int t = r / IT_SQ; r -= t * IT_SQ;
        j.W = c.in[25 + t] + (size_t)ll * D * D; j.ldw = D; j.K = D; nblk = D / 32;
        if (t < 2) { j.gain = c.in[23] + ll * D; j.WT = WSP(bf16, t ? WS_WV : WS_WK); j.radd = ll * D; } else j.WT = WSP(bf16, WS_WO + (size_t)ll * SZ_SQ); }
    else { int f = -1;
        if (r < 3 * IT_GU) f = 0; else { r -= 3 * IT_GU; const int mi = mixer_items(l);
            if (r < mi) {
                if ((l & 1) == 0) { const int e = l >> 1;
                    if (r < 2 * IT_SQ) { j.W = c.in[7] + (size_t)e * D * 4096; j.ldw = 4096; j.K = D; j.gain = c.in[6] + l * D; j.WT = WSP(bf16, WS_WIN + (size_t)e * 2 * SZ_SQ);
                        if (r < IT_SQ) { nblk = 64; }
                        else if (r < IT_SQ + IT_SQ / 2) { r -= IT_SQ; j.c0 = 2048; nblk = 32; j.rmul = 256; j.radd = 2048; }
                        else { r -= IT_SQ + IT_SQ / 2; j.c0 = 3072; nblk = 32; j.rmul = 256; j.radd = 2048 + 128; }
                    } else { r -= 2 * IT_SQ; j.W = c.in[17] + (size_t)e * 2048 * D; j.ldw = D; j.K = 2048; j.WT = WSP(bf16, WS_WOUT + (size_t)e * SZ_SQ); nblk = D / 32; }
                } else { const int o = l >> 1, g = r / IT_POOL; r -= g * IT_POOL; j.W = c.in[19] + (size_t)(o * 4 + g) * 512 * 512; j.ldw = 512; j.K = 512; j.WT = WSP(bf16, WS_WPOOL + (size_t)o * 2048 * 512 * 2); j.radd = g * 512; nblk = 16; }
            } else { r -= mi; f = 1; } }
        if (f >= 0) { const int t = r / IT_GU, base = f ? 28 : 2; r -= t * IT_GU;
            if (t < 2) { j.W = c.in[base + 1 + t] + (size_t)l * D * F; j.ldw = F; j.K = D; j.gain = c.in[base] + l * D; j.WT = WSP(bf16, WS_WGU + (size_t)(l * 2 + f) * SZ_WGU); j.rmul = 256; j.radd = t * 128; nblk = F / 32; }
            else { j.W = c.in[base + 3] + (size_t)l * F * D; j.ldw = D; j.K = F; j.WT = WSP(bf16, WS_WDN + (size_t)(l * 2 + f) * SZ_WDN); nblk = D / 32; } }
    }
    j.kb = r / nblk; j.nb = r - j.kb * nblk; return j;
}
template <int NI> __device__ __forceinline__ void convert_range(const Ctx& c, int l, int lo, int hi, int rank, int nranks) {
    LAS float* scr = (LAS float*)(c.lds + c.wave * 16384);
    const int step = nranks * NWAVES, lane = c.lane;
    for (int it = lo + rank * NWAVES + c.wave; it < hi; it += NI * step) {
        Job j[NI]; float v[NI][32];
#pragma unroll
        for (int q = 0; q < NI; ++q) if (it + q * step < hi) { j[q] = decode_job(c, l, it + q * step); job_load(j[q], v[q], lane); }
#pragma unroll
        for (int q = 0; q < NI; ++q) if (it + q * step < hi) job_finish(j[q], v[q], scr, lane);
    }
}
#ifndef MK_CONV_Q1
#define MK_CONV_Q1 26
#define MK_CONV_Q2 52
#endif
constexpr int NSCORE = 128;
constexpr int NGEMM_UP = 235;
__host__ __device__ constexpr int conv_cut(int l, int pct) { return (int)((long)layer_items(l) * pct / 100); }

__device__ __forceinline__ void p0_prologue(const Ctx& c) {
    const int gw = c.vcu * NWAVES + c.wave, NGW = c.G * NWAVES, lane = c.lane;
    convert_range<2>(c, -1, 0, KV_ITEMS, c.vcu, c.G);
    convert_range<2>(c, 0, 0, layer_items(0), c.vcu, c.G);
    for (int l = 1; l < NL; ++l) convert_range<2>(c, l, conv_cut(l, MK_CONV_Q2), layer_items(l), c.vcu, c.G);
    { const float* x = c.in[0]; bf16* XH = WSP(bf16, WS_X); bf16* XB = WSP(bf16, WS_XB); float* ssq = WSP(float, WS_SSQ);
      for (int m = gw; m < M; m += NGW) { const f32x4* xr = (const f32x4*)(x + (size_t)m * D) + lane; u32x2* xh = (u32x2*)(XH + (size_t)m * D) + lane; u32x2* xb = (u32x2*)(XB + (size_t)m * D) + lane; float s = 0.f;
#pragma unroll
          for (int j = 0; j < 8; ++j) { const f32x4 v = xr[64 * j]; u32x2 w; w.x = pk2(v[0], v[1]); w.y = pk2(v[2], v[3]); xb[64 * j] = w;
              if (MK_RESID_BF16) { const float r0 = bflo(w.x), r1 = bfhi(w.x), r2 = bflo(w.y), r3 = bfhi(w.y); s += (r0 * r0 + r1 * r1) + (r2 * r2 + r3 * r3); }
              else { u32x2 wh; wh.x = pg8::cvt_pk_h16(v[0], v[1]); wh.y = pg8::cvt_pk_h16(v[2], v[3]); xh[64 * j] = wh; s += (v[0] * v[0] + v[1] * v[1]) + (v[2] * v[2] + v[3] * v[3]); } }
          s = wave_sum(s);
          if (lane < 8) ssq[(size_t)m * 8 + lane] = lane == 0 ? s : 0.f; } }
    { const float* x = c.in[1]; bf16* XB = WSP(bf16, WS_MEMB); float* rm = WSP(float, WS_RMEM);
      for (int m = gw; m < MM; m += NGW) { const f32x4* xr = (const f32x4*)(x + (size_t)m * D) + lane; f32x4 v[8]; float s = 0.f;
#pragma unroll
          for (int j = 0; j < 8; ++j) { v[j] = xr[64 * j]; s += (v[j][0] * v[j][0] + v[j][1] * v[j][1]) + (v[j][2] * v[j][2] + v[j][3] * v[j][3]); }
          s = wave_sum(s);
          u32x2* xb = (u32x2*)(XB + (size_t)m * D) + lane;
#pragma unroll
          for (int j = 0; j < 8; ++j) { u32x2 w; w.x = pk2(v[j][0], v[j][1]); w.y = pk2(v[j][2], v[j][3]); xb[64 * j] = w; }
          if (lane == 0) rm[m] = __builtin_amdgcn_rsqf(s * (1.0f / D) + EPS); } }
    { const float* wq = c.in[24]; const float* gq = c.in[22]; bf16* o = WSP(bf16, WS_WQ);
      for (int m = gw; m < NL * D; m += NGW) { const f32x4* xr = (const f32x4*)(wq + (size_t)m * D) + lane; u32x2* xb = (u32x2*)(o + (size_t)m * D) + lane; const float g = gq[m];
#pragma unroll
          for (int j = 0; j < 8; ++j) { const f32x4 v = __builtin_nontemporal_load(xr + 64 * j) * g; u32x2 w; w.x = pk2(v[0], v[1]); w.y = pk2(v[2], v[3]); xb[64 * j] = w; } } }
    { const float* ws = c.in[9]; bf16* o = WSP(bf16, WS_WSG);
      for (int i = gw * 64 + lane; i < 2 * 8 * 128 * 128; i += NGW * 64) { const int q = i & 127, p = (i >> 7) & 127; o[i] = (bf16)f2bf(((q >> 6) <= (p >> 6)) ? ws[i] : 0.f); } }
}

template <int WIN> __device__ __forceinline__ void pool_rows(const bf16* X, int row0, int t0, int ch, f32x4 gv, const LAS float* rsl, bf16* DD) {
    f32x4 hv[31];
#pragma unroll
    for (int r = 16 - WIN; r < 31; ++r) { const float rr = rsl[r]; f32x4 xv = (f32x4){0.f, 0.f, 0.f, 0.f}; if (t0 - 15 + r >= 0) { const u32x2 q = *(const u32x2*)(X + (size_t)(row0 - 15 + r) * D + ch); xv = MK_RESID_BF16 ? (f32x4){bflo(q.x), bfhi(q.x), bflo(q.y), bfhi(q.y)} : (f32x4){pg8::h_lo(q.x), pg8::h_hi(q.x), pg8::h_lo(q.y), pg8::h_hi(q.y)}; } hv[r] = xv * rr * gv; }
#pragma unroll
    for (int t = 0; t < 16; ++t) { f32x4 s = hv[15 + t];
#pragma unroll
        for (int i = 1; i < WIN; ++i) s += hv[15 + t - i];
        const int n = (t0 + t + 1 < WIN) ? t0 + t + 1 : WIN; const float inv = 1.0f / (float)n;
        const f32x4 d = s * inv - hv[15 + t];
        u32x2 w; w.x = pk2(d[0], d[1]); w.y = pk2(d[2], d[3]); *(u32x2*)(DD + (size_t)(row0 + t) * D + ch) = w; }
}
__device__ __forceinline__ void pool_phase(const Ctx& c, const float* gain  ) {
    const bf16* X = WSP(bf16, MK_RESID_BF16 ? WS_XB : WS_X); const float* ssq = WSP(float, WS_SSQ); bf16* DD = WSP(bf16, WS_DD);
    LAS float* rsl = (LAS float*)c.lds;
    const int ch = 4 * c.tid; const f32x4 gv = *(const f32x4*)(gain + ch);
    for (int k0 = 0; deal_item(c.vcu, c.G, M / 16, k0) >= 0; k0 += 4) {
        { const int q = c.tid >> 6, t = c.tid & 63, it = deal_item(c.vcu, c.G, M / 16, k0 + (q & 3));
          if (q < 4 && it >= 0) { const int row0 = it * 16, t0 = row0 & (S - 1), r = t >> 1, part = t & 1; const bool valid = (r < 31) && (t0 - 15 + r >= 0); float s = 0.f;
              if (valid) { const f32x4 a = *(const f32x4*)(ssq + (size_t)(row0 - 15 + r) * 8 + part * 4); s = (a[0] + a[1]) + (a[2] + a[3]); }
              s += __shfl_xor(s, 1);
              if (part == 0 && r < 31) rsl[q * 32 + r] = valid ? __builtin_amdgcn_rsqf(s * (1.0f / D) + EPS) : 0.f; } }
        LDS_WAIT(); __syncthreads();
        for (int kk = 0, it; kk < 4 && (it = deal_item(c.vcu, c.G, M / 16, k0 + kk)) >= 0; ++kk) { const int row0 = it * 16, t0 = row0 & (S - 1); const LAS float* rs = rsl + kk * 32;
            switch (c.wave >> 1) { case 0: pool_rows<2>(X, row0, t0, ch, gv, rs, DD); break; case 1: pool_rows<4>(X, row0, t0, ch, gv, rs, DD); break;
                                   case 2: pool_rows<8>(X, row0, t0, ch, gv, rs, DD); break; default: pool_rows<16>(X, row0, t0, ch, gv, rs, DD); break; } }
        __syncthreads(); }
}

__device__ __forceinline__ void gate_item(const Ctx& c, int idx, int e, const bf16* U, const bf16* V, const float* lnp, const bf16* WSG, const float* bs, const float* lng, const float* lnb, bf16* YC) {
    LAS unsigned char* vnT = c.lds;
    LAS f32x2* st = (LAS f32x2*)(c.lds + 36864);
    const int h = idx & 7, row0 = (idx >> 3) * 128, lane = c.lane, fr = lane & 15, fq = lane >> 4, w = c.wave;
    if (c.tid < 128) { const f32x4* p = (const f32x4*)(lnp + (size_t)(row0 + c.tid) * 32); float s1 = 0.f, s2 = 0.f;
#pragma unroll
        for (int j = 0; j < 8; ++j) { const f32x4 a = p[j]; s1 += a[0] + a[2]; s2 += a[1] + a[3]; }
        const float mu = s1 * (1.0f / 1024.f), var = fmaxf(s2 * (1.0f / 1024.f) - mu * mu, 0.f);
        st[c.tid] = (f32x2){mu, __builtin_amdgcn_rsqf(var + EPS)}; }
    LDS_WAIT(); __syncthreads();
#pragma unroll
    for (int i = 0; i < 4; ++i) { const int j = c.tid + 512 * i, q = j >> 4, cc = (j & 15) * 8;
        const v4u raw = *(const v4u*)(V + (size_t)(row0 + q) * 1024 + h * 128 + cc); const f32x2 ms = st[q];
        const f32x4 g0 = *(const f32x4*)(lng + h * 128 + cc), g1 = *(const f32x4*)(lng + h * 128 + cc + 4), b0 = *(const f32x4*)(lnb + h * 128 + cc), b1 = *(const f32x4*)(lnb + h * 128 + cc + 4);
        const float v[8] = {bflo(raw.x), bfhi(raw.x), bflo(raw.y), bfhi(raw.y), bflo(raw.z), bfhi(raw.z), bflo(raw.w), bfhi(raw.w)};
        const float g[8] = {g0[0], g0[1], g0[2], g0[3], g1[0], g1[1], g1[2], g1[3]}, bb[8] = {b0[0], b0[1], b0[2], b0[3], b1[0], b1[1], b1[2], b1[3]};
#pragma unroll
        for (int k = 0; k < 8; ++k) *(LAS unsigned short*)(vnT + ((cc + k) * 136 + q) * 2) = (unsigned short)f2bf((v[k] - ms.x) * ms.y * g[k] + bb[k]); }
    LDS_WAIT(); __syncthreads();
    bf16x8 Af[4]; const bf16* wrow = WSG + ((size_t)(e * 8 + h) * 128 + 16 * w + fr) * 128 + 8 * fq;
#pragma unroll
    for (int ks = 0; ks < 4; ++ks) Af[ks] = *(const bf16x8*)(wrow + 32 * ks);
    const float bsv = bs[(e * 8 + h) * 128 + 16 * w + fr]; const size_t orow = (size_t)(row0 + 16 * w + fr);
#pragma unroll
    for (int cb = 0; cb < 8; ++cb) { f32x4 acc = (f32x4){0.f, 0.f, 0.f, 0.f};
#pragma unroll
        for (int ks = 0; ks < 4; ++ks) { const bf16x8 Bf = *(const LAS bf16x8*)(vnT + ((16 * cb + fr) * 136 + 32 * ks + 8 * fq) * 2); acc = __builtin_amdgcn_mfma_f32_16x16x32_bf16(Bf, Af[ks], acc, 0, 0, 0); }
        const u32x2 uu = *(const u32x2*)(U + orow * 1024 + h * 128 + 16 * cb + 4 * fq);
        u32x2 o; o.x = pk2(bflo(uu.x) * (acc[0] + bsv), bfhi(uu.x) * (acc[1] + bsv)); o.y = pk2(bflo(uu.y) * (acc[2] + bsv), bfhi(uu.y) * (acc[3] + bsv));
        *(u32x2*)(YC + orow * 2048 + h * 128 + 16 * cb + 4 * fq) = o; }
    __syncthreads();
}
__device__ __forceinline__ void mix_phase(const Ctx& c, int e) {
    const bf16* U = WSP(bf16, WS_U); const bf16* V = WSP(bf16, WS_V); const bf16* HB = WSP(bf16, WS_HB); bf16* YC = WSP(bf16, WS_YC); const float* lnp = WSP(float, WS_LNP);
#ifndef MK_MIXREP_G
#define MK_MIXREP_G 1
#define MK_MIXREP_C 1
#endif
    for (int rep = 0; rep < MK_MIXREP_G; ++rep)
    for (int k = 0, it; (it = deal_item(c.vcu, c.G, 512, k)) >= 0; ++k) gate_item(c, it, e, U, V, lnp, WSP(bf16, WS_WSG), c.in[10], c.in[11] + e * 1024, c.in[12] + e * 1024, YC);
    { const int ch = 2 * c.tid; const float* cw = c.in[13] + (size_t)e * 31 * 1024 + ch; LAS f32x2* red = (LAS f32x2*)(c.lds + 40960);
      f32x2 wv[31];
#pragma unroll
      for (int j = 0; j < 31; ++j) wv[j] = *(const f32x2*)(cw + j * 1024);
      const f32x2 cbv = *(const f32x2*)(c.in[14] + e * 1024 + ch), gv = *(const f32x2*)(c.in[15] + e * 1024 + ch), bv = *(const f32x2*)(c.in[16] + e * 1024 + ch);
      for (int rep = 0; rep < MK_MIXREP_C; ++rep)
      for (int k = 0, it; (it = deal_item(c.vcu, c.G, M / 16, k)) >= 0; ++k) { const int r0 = it * 16, t0 = r0 & (S - 1);
          unsigned hw[46];
#pragma unroll
          for (int i = 0; i < 46; ++i) { unsigned raw = 0u; if (t0 - 30 + i >= 0) raw = *(const unsigned*)(HB + (size_t)(r0 - 30 + i) * 1024 + ch); hw[i] = raw; }
          f32x2 o[16];
#pragma unroll
          for (int r = 0; r < 16; ++r) { o[r] = cbv;
#pragma unroll
              for (int j = 0; j < 31; ++j) o[r] += (f32x2){bflo(hw[r + j]), bfhi(hw[r + j])} * wv[j]; }
#pragma unroll
          for (int r = 0; r < 16; ++r) { const float s1 = wave_sum(o[r][0] + o[r][1]), s2 = wave_sum(o[r][0] * o[r][0] + o[r][1] * o[r][1]); if (c.lane == 0) red[c.wave * 16 + r] = (f32x2){s1, s2}; }
          LDS_WAIT(); __syncthreads();
#pragma unroll
          for (int r = 0; r < 16; ++r) { float s1 = 0.f, s2 = 0.f;
#pragma unroll
              for (int w = 0; w < 8; ++w) { const f32x2 p = red[w * 16 + r]; s1 += p[0]; s2 += p[1]; }
              const float mu = s1 * (1.0f / 1024.f), var = fmaxf(s2 * (1.0f / 1024.f) - mu * mu, 0.f), rs = __builtin_amdgcn_rsqf(var + EPS);
              const float y0 = (o[r][0] - mu) * rs * gv[0] + bv[0], y1 = (o[r][1] - mu) * rs * gv[1] + bv[1];
              *(unsigned*)(YC + (size_t)(r0 + r) * 2048 + 1024 + ch) = pk2(pg8::fast_silu(y0), pg8::fast_silu(y1)); }
          __syncthreads(); } }
}


__device__ __forceinline__ void final_phase(const Ctx& c, float* out) {
    const bf16* X = WSP(bf16, MK_RESID_BF16 ? WS_XB : WS_X); const float* ssq = WSP(float, WS_SSQ); const float* g = c.in[32];
    const int gw = c.vcu * NWAVES + c.wave, NGW = c.G * NWAVES, lane = c.lane;
    f32x4 gv[8];
#pragma unroll
    for (int j = 0; j < 8; ++j) gv[j] = ((const f32x4*)g)[lane + 64 * j];
    for (int k = 0, m; (m = deal_item(gw, NGW, M, k)) >= 0; ++k) { float s = 0.f; if (lane < 2) { const f32x4 a = ((const f32x4*)(ssq + (size_t)m * 8))[lane]; s = (a[0] + a[1]) + (a[2] + a[3]); }
        const float rs = __builtin_amdgcn_rsqf(wave_sum(s) * (1.0f / D) + EPS);
        const u32x2* xr = (const u32x2*)(X + (size_t)m * D) + lane; f32x4* o = (f32x4*)(out + (size_t)m * D) + lane;
#pragma unroll
        for (int j = 0; j < 8; ++j) { const u32x2 q = xr[64 * j]; o[64 * j] = (MK_RESID_BF16 ? (f32x4){bflo(q.x), bfhi(q.x), bflo(q.y), bfhi(q.y)} : (f32x4){pg8::h_lo(q.x), pg8::h_hi(q.x), pg8::h_lo(q.y), pg8::h_hi(q.y)}) * rs * gv[j]; } }
}

struct Args { const float* in[33]; float* out; unsigned char* ws; int s_lo, s_hi, flags, bar_region; };
__global__ void __launch_bounds__(NTHREADS, 2) mega(Args a) {
    extern __shared__ __attribute__((aligned(16))) unsigned char lds_raw[];
    Ctx c; c.lds = (LAS unsigned char*)lds_raw; c.tid = threadIdx.x; c.lane = c.tid & 63; c.wave = __builtin_amdgcn_readfirstlane(c.tid >> 6);
    c.G = gridDim.x; { const int bx = blockIdx.x; c.vcu = (c.G % 8 == 0) ? (bx % 8) * (c.G / 8) + bx / 8 : bx; }
    c.ws = a.ws; c.in = a.in; const int vcu0 = c.vcu;
    volatile LAS unsigned* MISC = (volatile LAS unsigned*)(c.lds + MISC_OFF);
    for (int u = c.tid; u < (LDS_BYTES - LDSCTL_OFF) / 4; u += NTHREADS) ((LAS unsigned*)(c.lds + LDSCTL_OFF))[u] = 0u;
    __syncthreads();
    XcdBarrier bar = xcd_barrier_post((unsigned*)(c.ws + WS_CTL) + a.bar_region * XCD_BAR_WORDS, MISC + 8);
#if defined(MK_BAR_TWICE)
#define GRID_BAR() do { xcd_barrier(bar); xcd_barrier(bar); } while (0)
#else
#define GRID_BAR() xcd_barrier(bar)
#endif
#ifndef MK_REPEAT
#define MK_REPEAT -1
#endif
#define REPS(type) ((MK_REPEAT == (type)) ? 2 : 1)
    const int bx = blockIdx.x;
    PG8_LAS float* lds_red = (PG8_LAS float*)(c.lds + pg8::LDS_RED_OFF);
    bf16* XB = WSP(bf16, WS_XB); float* ssq = WSP(float, WS_SSQ);

#define RLOOP(type) for (int rp = 0; rp < REPS(type); ++rp)
#ifndef MK_FUSE_FINAL
#define MK_FUSE_FINAL 1
#endif
    bool fused_final = false;
    if (a.flags & 1) {
        RLOOP(0) { p0_prologue(c); GRID_BAR(); }
        RLOOP(1) { pg8::Gemm g{WSP(bf16, WS_MEMB), WSP(bf16, WS_WK), D, D, D, 0}; pg8::ListOrder so{0, 256, c.G, bx, 4, 0}; pg8::EpiKV E{WSP(bf16, WS_KB), WSP(bf16, WS_VT), WSP(float, WS_RMEM)};
          pg8::gemm_phase(c.lds, g, so, E); GRID_BAR(); }
        { pg8::Gemm g{(const bf16*)c.ws, (const bf16*)c.ws, D, D, 512, 0}; pg8::PreOrder so{c.G, bx, 0, (c.G > NSCORE) ? 1 : NL, (int)(WS_WO / 2), (int)(WS_VT / 2), (int)(WS_KB / 2), (int)(WS_WQ / 2)}; pg8::EpiPre E{WSP(bf16, WS_VW), WSP(bf16, WS_KW)};
          pg8::gemm_phase(c.lds, g, so, E);
        }
    }
    for (int it = 0; it <= NL; ++it) {
        const int l = it - 1;
        { int t = threadIdx.x, vc = vcu0, gg = gridDim.x; size_t z = 0; asm volatile("" : "+v"(t), "+s"(z), "+s"(vc), "+s"(gg));
          c.tid = t; c.lane = t & 63; c.wave = __builtin_amdgcn_readfirstlane(t >> 6); c.ws = a.ws + z; c.vcu = vc; c.G = gg;
          XB = WSP(bf16, WS_XB); ssq = WSP(float, WS_SSQ); }
        if (it > 0 && 4 * l + 1 >= a.s_lo && 4 * l + 1 < a.s_hi) {
            if ((l & 1) == 0) { const int e = l >> 1;
                RLOOP(4) { pg8::Gemm g{XB, WSP(bf16, WS_WIN + (size_t)e * 2 * SZ_SQ), D, D, D, 0}; pg8::StaticOrder so; so.init(M, 4096, c.G, bx);
                  pg8::EpiWin E{WSP(bf16, WS_U), WSP(bf16, WS_V), WSP(bf16, WS_HB), WSP(float, WS_LNP), pg8::RstdLds{ssq, c.lds}, c.in[8] + e * 4096};
                  pg8::gemm_phase(c.lds, g, so, E); GRID_BAR(); }
                RLOOP(5) { mix_phase(c, e); GRID_BAR(); }
                RLOOP(6) { pg8::Gemm g{WSP(bf16, WS_YC), WSP(bf16, WS_WOUT + (size_t)e * SZ_SQ), D, D, D, 0}; pg8::StaticOrder so; so.init(M, D, c.G, bx);
                  pg8::EpiResid<true, false> E{WSP(bf16, WS_X), XB, ssq, c.in[18] + e * D, nullptr, rp ? 0.0f : 1.0f, lds_red};
                  pg8::gemm_phase(c.lds, g, so, E); GRID_BAR(); }
            } else { const int o = l >> 1;
                RLOOP(7) { pool_phase(c, c.in[6] + l * D); GRID_BAR(); }
                RLOOP(8) { pg8::Gemm g{WSP(bf16, WS_DD), WSP(bf16, WS_WPOOL + (size_t)o * 2048 * 512 * 2), D, 512, 512, 512}; pg8::StaticOrder so; so.init(M, D, c.G, bx);
                  pg8::EpiResid<true, true> E{WSP(bf16, WS_X), XB, ssq, c.in[20] + o * D, c.in[21] + o * D, rp ? 0.0f : 1.0f, lds_red};
                  pg8::gemm_phase(c.lds, g, so, E); GRID_BAR(); }
            }
        }
        if (it > 0 && 4 * l + 2 >= a.s_lo && 4 * l + 2 < a.s_hi) {
            RLOOP(9) { pg8::Gemm g{XB, WSP(bf16, WS_KW + (size_t)l * NB * 1024 * D * 2), D, D, D, 0}; pg8::BatchBOrder so; so.init(M, 1024, c.G, bx); so.bstride = 1024 * D;
              pg8::EpiSoftmax E{WSP(bf16, WS_P), pg8::RstdLds{ssq, c.lds}, QSCALE, lds_red, (PG8_LAS float*)(c.lds + LDS_RED2_OFF)};
              pg8::gemm_phase(c.lds, g, so, E);
              if (c.G > NSCORE && bx >= NSCORE && l + 1 < NL && rp == 0) {
                  pg8::Gemm g2{(const bf16*)c.ws, (const bf16*)c.ws, D, D, 512, 0}; pg8::PreOrder so2{c.G - NSCORE, bx - NSCORE, l + 1, 1, (int)(WS_WO / 2), (int)(WS_VT / 2), (int)(WS_KB / 2), (int)(WS_WQ / 2)}; pg8::EpiPre E2{WSP(bf16, WS_VW), WSP(bf16, WS_KW)};
                  pg8::gemm_phase(c.lds, g2, so2, E2); }
              GRID_BAR(); }
            RLOOP(11) { pg8::Gemm g{WSP(bf16, WS_P), WSP(bf16, WS_VW + (size_t)l * NB * D * 1024 * 2), 1024, 1024, 1024, 0}; pg8::BatchBOrder so; so.init(M, D, c.G, bx); so.bstride = D * 1024;
              pg8::EpiResid<false, false> E{WSP(bf16, WS_X), XB, ssq, nullptr, nullptr, rp ? 0.0f : 1.0f, lds_red};
              pg8::gemm_phase(c.lds, g, so, E); GRID_BAR(); }
        }
        for (int j = 0; j < 2; ++j) {
            const int s = (j == 0) ? 4 * l + 3 : 4 * it, ll = (j == 0) ? l : it;
            if ((j == 0 && it == 0) || (j == 1 && it == NL) || s < a.s_lo || s >= a.s_hi) continue;
            RLOOP(2) { const int ngemm = (c.G > NGEMM_UP) ? NGEMM_UP : c.G;
              if (bx < ngemm) { pg8::Gemm g{XB, WSP(bf16, WS_WGU + (size_t)(ll * 2 + (1 - j)) * SZ_WGU), D, D, D, 0}; pg8::StaticOrder so; so.init(M, 2 * F, ngemm, bx);
                pg8::EpiSwiglu E{WSP(bf16, WS_HID), F, pg8::RstdLds{ssq, c.lds}};
                pg8::gemm_phase(c.lds, g, so, E); }
              if (ll + 1 < NL && rp == 0) { const int nl = ll + 1, nsp = c.G - ngemm, lo = (j == 1) ? 0 : conv_cut(nl, MK_CONV_Q1), hi = (j == 1) ? conv_cut(nl, MK_CONV_Q1) : conv_cut(nl, MK_CONV_Q2);
                  if (nsp > 0) { if (bx >= ngemm) convert_range<2>(c, nl, lo, hi, bx - ngemm, nsp); }
                  else convert_range<2>(c, nl, lo, hi, c.vcu, c.G); }
              GRID_BAR(); }
#if defined(MK_PROBE_CHEAP)
            { pg8::Gemm g{XB, WSP(bf16, WS_WGU + (size_t)(ll * 2 + (1 - j)) * SZ_WGU), D, D, D, 0}; pg8::StaticOrder so; so.init(M, 2 * F, c.G, bx);
              pg8::EpiQ E{WSP(bf16, WS_END + 4096), pg8::RstdLds{ssq, c.lds}, 1.0f};
              pg8::gemm_phase(c.lds, g, so, E); GRID_BAR(); }
#endif
#if defined(MK_PROBE_SHORT)
            { pg8::Gemm g{XB, WSP(bf16, WS_WGU + (size_t)(ll * 2 + (1 - j)) * SZ_WGU), D, D, 256, 0}; pg8::StaticOrder so; so.init(M, D, c.G, bx);
              pg8::EpiNone E{};
              pg8::gemm_phase(c.lds, g, so, E); GRID_BAR(); }
#endif
#if defined(MK_PROBE_HOTB)
            { struct HotB : pg8::StaticOrder { __device__ bool next(int i, pg8::Unit& u) const { const bool ok = pg8::StaticOrder::next(i, u); u.pn = 0; return ok; } };
              pg8::Gemm g{XB, WSP(bf16, WS_WGU + (size_t)(ll * 2 + (1 - j)) * SZ_WGU), D, D, D, 0}; HotB so; so.init(M, 2 * F, c.G, bx);
              pg8::EpiNone E{};
              pg8::gemm_phase(c.lds, g, so, E); GRID_BAR(); }
#endif
#if defined(MK_PROBE_HOTAB)
            { struct HotAB : pg8::StaticOrder { __device__ bool next(int i, pg8::Unit& u) const { const bool ok = pg8::StaticOrder::next(i, u); u.pn = 0; u.pm = 0; return ok; } };
              pg8::Gemm g{XB, WSP(bf16, WS_WGU + (size_t)(ll * 2 + (1 - j)) * SZ_WGU), D, D, D, 0}; HotAB so; so.init(M, 2 * F, c.G, bx);
              pg8::EpiNone E{};
              pg8::gemm_phase(c.lds, g, so, E); GRID_BAR(); }
#endif
#if defined(MK_PROBE_COLDB)
            { pg8::Gemm g{XB, (const bf16*)c.in[j ? 3 : 29] + (size_t)ll * D * F * 2, D, D, D, 0}; pg8::StaticOrder so; so.init(M, 2 * F, c.G, bx);
              pg8::EpiNone E{};
              pg8::gemm_phase(c.lds, g, so, E); GRID_BAR(); }
#endif
#if defined(MK_PROBE_ZERO)
            { const bf16* zz = WSP(bf16, WS_CTL + 512 * 1024);
              pg8::Gemm g{zz, zz, 0, 0, D, 0}; pg8::StaticOrder so; so.init(M, 2 * F, c.G, bx);
              pg8::EpiNone E{};
              pg8::gemm_phase(c.lds, g, so, E); GRID_BAR(); }
#endif
#if defined(MK_PROBE_NONE)
            { pg8::Gemm g{XB, WSP(bf16, WS_WGU + (size_t)(ll * 2 + (1 - j)) * SZ_WGU), D, D, D, 0}; pg8::StaticOrder so; so.init(M, 2 * F, c.G, bx);
              pg8::EpiNone E{};
              pg8::gemm_phase(c.lds, g, so, E); GRID_BAR(); }
#endif
            RLOOP(3) { pg8::Gemm g{WSP(bf16, WS_HID), WSP(bf16, WS_WDN + (size_t)(ll * 2 + (1 - j)) * SZ_WDN), F, F, F, 0}; pg8::StaticOrder so; so.init(M, D, c.G, bx);
              if (MK_FUSE_FINAL && s == 4 * NL - 1 && (a.flags & 2) && c.G >= (M / 256) * (D / 256) && rp == REPS(3) - 1) {
                  pg8::EpiResidFinal E{XB, ssq, 0.5f, lds_red, (PG8_LAS float*)(c.lds + pg8::LDS_RSL_OFF), a.out, c.in[32], (unsigned*)(c.ws + WS_CTL + 768 * 1024), (unsigned*)(c.ws + WS_CTL) + a.bar_region * XCD_BAR_WORDS + XB_TMO};
                  pg8::gemm_phase(c.lds, g, so, E); fused_final = true; }
              else { pg8::EpiResid<false, false> E{WSP(bf16, WS_X), XB, ssq, nullptr, nullptr, rp ? 0.0f : 0.5f, lds_red};
                  pg8::gemm_phase(c.lds, g, so, E); GRID_BAR(); } }
        }
    }
    if ((a.flags & 2) && !fused_final) final_phase(c, a.out);
}
}
#ifndef MK_DEBUG
#define MK_DEBUG 0
#endif
#if MK_DEBUG
__global__ void k_bf16_to_f32(const unsigned short* a, float* o, size_t n) {
    for (size_t i = (size_t)blockIdx.x * blockDim.x + threadIdx.x; i < n; i += (size_t)gridDim.x * blockDim.x) o[i] = __uint_as_float(((unsigned)a[i]) << 16);
}
__global__ void k_cmp(const unsigned short* a, const float* ref, size_t n, double* acc) {
    double d = 0.0, r = 0.0;
    for (size_t i = (size_t)blockIdx.x * blockDim.x + threadIdx.x; i < n; i += (size_t)gridDim.x * blockDim.x) { const double x = __uint_as_float(((unsigned)a[i]) << 16), y = ref[i]; d += (x - y) * (x - y); r += y * y; }
    for (int o = 32; o >= 1; o >>= 1) { d += __shfl_xor(d, o); r += __shfl_xor(r, o); }
    if ((threadIdx.x & 63) == 0) { atomicAdd(acc, d); atomicAdd(acc + 1, r); }
}
__global__ void k_cmp_attn(const unsigned short* mine, const float* ref, int which, double* acc) {
    double d = 0.0, r = 0.0; const size_t n = (which == 1 || which == 2) ? (size_t)mk::MM * mk::D : (size_t)mk::M * mk::D;
    for (size_t i = (size_t)blockIdx.x * blockDim.x + threadIdx.x; i < n; i += (size_t)gridDim.x * blockDim.x) {
        const size_t row = i / mk::D, col = i % mk::D; size_t mi = i; double sc = 1.0;
        if (which == 0) sc = 1.0 / (double)mk::QSCALE;
        double y = ref[i];
        if (which == 4) { const size_t b = row / mk::S; y = 0.0; for (int k = 0; k < 256; ++k) y += ref[(b * 256 + k) * mk::D + col]; y *= (1.0 / 256.0); }
        const double x = (double)__uint_as_float(((unsigned)mine[mi]) << 16) * sc; d += (x - y) * (x - y); r += y * y; }
    for (int o = 32; o >= 1; o >>= 1) { d += __shfl_xor(d, o); r += __shfl_xor(r, o); }
    if ((threadIdx.x & 63) == 0) { atomicAdd(acc, d); atomicAdd(acc + 1, r); }
}
__global__ void k_frac(const unsigned short* mine, const float* ref, int mode, int wsel, double* acc) {
    double m = 0.0, t = 0.0; const size_t n = (size_t)mk::M * mk::D;
    for (size_t i = (size_t)blockIdx.x * blockDim.x + threadIdx.x; i < n; i += (size_t)gridDim.x * blockDim.x) { const size_t row = i / mk::D, col = i % mk::D;
        if (wsel >= 0 && (int)((row % 128) / 16) != wsel) continue;
        double y = (mode == 3) ? ref[((row / mk::S) * 256) * mk::D + col] : ref[(mode == 1) ? 0 : i]; if (mode == 1) { const size_t b = row / mk::S; y = 0.0; for (int k = 0; k < 256; ++k) y += ref[(b * 256 + k) * mk::D + col]; y *= (1.0 / 256.0); }
        double x = (double)__uint_as_float(((unsigned)mine[i]) << 16); if (mode == 2) x *= 1.0 / (double)mk::QSCALE; t += 1.0; if (fabs(x - y) <= 0.02 * fabs(y) + 1e-3) m += 1.0; }
    for (int o = 32; o >= 1; o >>= 1) { m += __shfl_xor(m, o); t += __shfl_xor(t, o); }
    if ((threadIdx.x & 63) == 0) { atomicAdd(acc, m); atomicAdd(acc + 1, t); }
}
__global__ void k_verdict3(const double* acc, float* out, size_t n) {
    const float c1 = 2.0f + floorf((float)(10.0 * acc[0] / acc[1])), c2 = 2.0f + floorf((float)(10.0 * acc[2] / acc[3]));
    for (size_t i = (size_t)blockIdx.x * blockDim.x + threadIdx.x; i < n; i += (size_t)gridDim.x * blockDim.x) out[i] = (i < n / 2) ? c1 : c2;
}
__global__ void k_verdict2(const double* acc, int lo, int hi, int code0, float* out, size_t n, double thr) {
    int code = 0; for (int s = lo; s < hi; ++s) if (!(acc[2 * s] <= thr * acc[2 * s + 1])) { code = code0 + (s - lo); break; }
    if (code) for (size_t i = (size_t)blockIdx.x * blockDim.x + threadIdx.x; i < n; i += (size_t)gridDim.x * blockDim.x) out[i] = (float)code;
}
__global__ void k_verdict(const double* acc, int ns, float* out, size_t n, double thr) {
    int code = 0; for (int s = 0; s < ns; ++s) if (!(acc[2 * s] <= thr * acc[2 * s + 1])) { code = s + 1; break; }
    if (code) for (size_t i = (size_t)blockIdx.x * blockDim.x + threadIdx.x; i < n; i += (size_t)gridDim.x * blockDim.x) out[i] = (float)code;
}
#endif
extern "C" void kernel_launch(void* const* d_in, const int* in_sizes, int n_in, void* d_out, int out_size, void* d_ws, size_t ws_size, hipStream_t stream) {
    using namespace mk;
    static int grid = 0;
    if (grid == 0) {
        if (n_in != 33 || out_size != M * D || ws_size < WS_END) { fprintf(stderr, "kernel_launch: unexpected problem (n_in %d, out %d, ws %zu < %zu); nothing launched\n", n_in, out_size, ws_size, (size_t)WS_END); grid = -1; return; }
        int dev = 0, cus = 0, per_cu = 0;
        if (hipGetDevice(&dev) != hipSuccess || hipDeviceGetAttribute(&cus, hipDeviceAttributeMultiprocessorCount, dev) != hipSuccess) { grid = -1; return; }
        if (hipFuncSetAttribute((const void*)mega, hipFuncAttributeMaxDynamicSharedMemorySize, LDS_BYTES) != hipSuccess) { fprintf(stderr, "kernel_launch: hipFuncSetAttribute failed\n"); grid = -1; return; }
        if (hipOccupancyMaxActiveBlocksPerMultiprocessor(&per_cu, (const void*)mega, NTHREADS, LDS_BYTES) != hipSuccess || per_cu < 1) fprintf(stderr, "kernel_launch: occupancy query reports %d workgroups per CU\n", per_cu);
        (void)hipGetLastError();
        grid = cus;
    }
    if (grid < 0) return;
    (void)hipMemsetAsync((char*)d_ws + WS_CTL, 0, CTL_BYTES, stream);
    Args a{};
    for (int i = 0; i < 33; ++i) a.in[i] = (const float*)d_in[i];
    a.out = (float*)d_out; a.ws = (unsigned char*)d_ws;
#if !MK_DEBUG
    a.s_lo = 0; a.s_hi = 16; a.flags = 3; a.bar_region = 0;
    hipLaunchKernelGGL(mega, dim3(grid), dim3(NTHREADS), LDS_BYTES, stream, a);
#else
    const size_t NV_OFF = (WS_END + 4095) & ~(size_t)4095;
    if (ws_size < NV_OFF + nv::bufs_bytes()) { fprintf(stderr, "debug build: workspace too small\n"); return; }
    const nv::Bufs nb = nv::carve((unsigned char*)d_ws + NV_OFF);
    double* acc = (double*)((char*)d_ws + WS_CTL + 512 * 1024);
    a.s_lo = 0; a.s_hi = 0; a.flags = 1; a.bar_region = 0;
    hipLaunchKernelGGL(mega, dim3(grid), dim3(NTHREADS), LDS_BYTES, stream, a);
    for (int s = MK_DEBUG_LO; s < MK_DEBUG_HI; ++s) {
        hipLaunchKernelGGL(k_bf16_to_f32, dim3(2048), dim3(256), 0, stream, (const unsigned short*)((char*)d_ws + WS_XB), nb.X, (size_t)M * D);
        a.s_lo = s; a.s_hi = s + 1; a.flags = 0; a.bar_region = 1 + s;
        hipLaunchKernelGGL(mega, dim3(grid), dim3(NTHREADS), LDS_BYTES, stream, a);
        nv::sublayer(nb, d_in, s, stream);
        hipLaunchKernelGGL(k_cmp, dim3(2048), dim3(256), 0, stream, (const unsigned short*)((char*)d_ws + WS_XB), (const float*)nb.X, (size_t)M * D, acc + 2 * s);
        if (s == 2) {
            hipLaunchKernelGGL(k_cmp_attn, dim3(2048), dim3(256), 0, stream, (const unsigned short*)((char*)d_ws + WS_Q), (const float*)nb.T2, 0, acc + 2 * 20);
            hipLaunchKernelGGL(k_cmp_attn, dim3(2048), dim3(256), 0, stream, (const unsigned short*)((char*)d_ws + WS_KB), (const float*)nb.K, 1, acc + 2 * 21);
            hipLaunchKernelGGL(k_cmp_attn, dim3(2048), dim3(256), 0, stream, (const unsigned short*)((char*)d_ws + WS_VT), (const float*)nb.V, 2, acc + 2 * 22);
        }
    }
    a.s_lo = 0; a.s_hi = 0; a.flags = 2; a.bar_region = 17;
    hipLaunchKernelGGL(mega, dim3(grid), dim3(NTHREADS), LDS_BYTES, stream, a);
    hipLaunchKernelGGL(k_verdict, dim3(2048), dim3(256), 0, stream, (const double*)acc, 16, (float*)d_out, (size_t)M * D, 1e-4);
    hipLaunchKernelGGL(k_verdict2, dim3(2048), dim3(256), 0, stream, (const double*)acc, 20, 24, 5, (float*)d_out, (size_t)M * D, 1e-3);
#endif
}
```

```cpp
#include <hip/hip_runtime.h>
#include <cstdio>
#include <cstdint>
#define MK_LEADER_OVERLAP_INV 1
namespace pg8 {
#define PG8_LAS __attribute__((address_space(3)))
typedef unsigned short bf16_t;
typedef short bf16x8 __attribute__((ext_vector_type(8)));
typedef float f32x4 __attribute__((ext_vector_type(4)));
typedef float f32x2 __attribute__((ext_vector_type(2)));
typedef unsigned u32x4 __attribute__((ext_vector_type(4)));
typedef unsigned u32x2 __attribute__((ext_vector_type(2)));
#ifndef MK_WGM
#define MK_WGM 4
#endif
constexpr int BM = 256, BK = 64, HALF = 128, HTB = HALF * BK * 2  , STAGE_BYTES = 8 * HTB, NXCD = 8, WGM = MK_WGM;

__host__ __device__ __forceinline__ int lds_byte(int r, int c) { const int st = (r >> 4) * 2 + (c >> 5), rr = r & 15, cc = c & 31, ob = rr * 64 + cc * 2; return st * 1024 + (ob ^ (((ob >> 9) & 1) << 5)); }
__host__ __device__ __forceinline__ void stage_rc(int b, int& R, int& C) { const int st = b / 1024, sb = b % 1024, swz = sb ^ (((sb >> 9) & 1) << 5); R = (st >> 1) * 16 + swz / 64; C = (st & 1) * 32 + (swz % 64) / 2; }
__host__ __device__ __forceinline__ int perm32(int rho) { const int n = rho >> 4, i = rho & 15; return 8 * (i >> 2) + 4 * n + (i & 3); }

struct Unit { int pm, pn, xa, xb, id; };
struct Gemm { const bf16_t* A; const bf16_t* Bt; int lda, ldb, K, agrp; };

struct StaticOrder {
    int nM, nN, nwg, G, c;
    __host__ __device__ void init(int M, int N, int G_, int c_) { nM = M / BM; nN = N / BM; nwg = nM * nN; G = G_; c = c_; }
    __host__ __device__ bool next(int i, Unit& u) const {
        const long L = (long)i * G + c; if (L >= nwg) return false;
        int wgid = (int)L; { const int q = nwg / NXCD, r = nwg % NXCD, xcd = wgid % NXCD, off = wgid / NXCD; wgid = (xcd < r ? xcd * (q + 1) : r * (q + 1) + (xcd - r) * q) + off; }
        const int nig = WGM * nN, gid = wgid / nig, fm = gid * WGM, gsz = (nM - fm) < WGM ? (nM - fm) : WGM;
        u.pm = fm + ((wgid % nig) % gsz); u.pn = (wgid % nig) / gsz; u.xa = 0; u.xb = 0; u.id = 0; return true;
    }
};
struct ListOrder {
    int lo, hi, G, c, nN, rowmajor;
    __host__ __device__ bool next(int i, Unit& u) const {
        const int i0 = (lo > c) ? (lo - c + G - 1) / G : 0; const int L = (i0 + i) * G + c; if (L >= hi) return false; const int k = L - lo;
        if (rowmajor) { u.pm = k / nN; u.pn = k % nN; } else { u.pm = k % nN; u.pn = k / nN; } u.xa = 0; u.xb = 0; u.id = 0; return true;
    }
};

struct BatchBOrder : StaticOrder {
    int bstride;
    __host__ __device__ bool next(int i, Unit& u) const { const bool ok = StaticOrder::next(i, u); if (ok) u.xb = (u.pm >> 3) * bstride; return ok; }
};
struct PreOrder {
    int G, c, l0, nl, oWO, oV, oK, oWQ;
    __host__ __device__ bool next(int i, Unit& u) const {
        const int e = i * G + c; if (e >= nl * 256) return false;
        const int t = e & 7, b = (e >> 3) & 3, h = (e >> 5) & 3, kind = (e >> 7) & 1, l = l0 + (e >> 8), big = l * 2048 * 2048 + h * 512, small = (l * 1024 + b * 256) * 2048 + h * 512;
        if (kind == 0) { u.pm = t; u.pn = 0; u.xa = oWO + big; u.xb = oV + small; } else { u.pm = 0; u.pn = t; u.xa = oK + small; u.xb = oWQ + big; }
        u.id = (kind << 9) | (l << 7) | (h << 5) | (b << 3) | t; return true;
    }
};

typedef __bf16 bf16x2_t __attribute__((ext_vector_type(2)));
__device__ __forceinline__ unsigned cvt_pk_bf16(float lo, float hi) { const f32x2 v = {lo, hi}; const bf16x2_t b = __builtin_convertvector(v, bf16x2_t); return __builtin_bit_cast(unsigned, b); }

typedef _Float16 h16x2_t __attribute__((ext_vector_type(2)));
__device__ __forceinline__ unsigned cvt_pk_h16(float lo, float hi) { const f32x2 v = {lo, hi}; const h16x2_t b = __builtin_convertvector(v, h16x2_t); return __builtin_bit_cast(unsigned, b); }
__device__ __forceinline__ float h_lo(unsigned w) { return (float)__builtin_bit_cast(h16x2_t, w)[0]; }
__device__ __forceinline__ float h_hi(unsigned w) { return (float)__builtin_bit_cast(h16x2_t, w)[1]; }

#ifndef MK_SP2
#define MK_SP2 true
#endif
template <class Epi, class Sched, bool SP2 = MK_SP2>
__device__ __forceinline__ void gemm_phase(PG8_LAS unsigned char* lds, const Gemm g, const Sched& S, const Epi& E) {
    int tid = threadIdx.x; asm volatile("" : "+v"(tid));
    const int wid = __builtin_amdgcn_readfirstlane(tid >> 6), lane = tid & 63, wr = wid >> 2, wc = wid & 3, fr = lane & 15, fq = lane >> 4;
    const int K = g.K, nt = K / BK;
    unsigned voffA[2], voffB[2];
#pragma unroll
    for (int i = 0; i < 2; ++i) { int R, C; stage_rc(tid * 16 + i * 8192, R, C); const int Rb = Epi::PERM ? ((R & ~31) + perm32(R & 31)) : R;
        voffA[i] = (unsigned)(R * g.lda + C) * 2u; voffB[i] = (unsigned)(Rb * g.ldb + C) * 2u; }
    const size_t kstep = (size_t)(BK * 2);
    const size_t hstepA = (size_t)HALF * g.lda * 2, hstepB = (size_t)HALF * g.ldb * 2;
    const size_t tstepA = 2 * hstepA, tstepB = 2 * hstepB;
    const unsigned ldsw = (unsigned)wid * 1024u;
    const int aoff = lds_byte(wr * 64 + fr, fq * 8), boff = lds_byte(wc * 32 + fr, fq * 8);
#define PG8_SA(b, h) (((b) * 2 + (h)) * HTB)
#define PG8_SB(b, h) ((4 + (b) * 2 + (h)) * HTB)
#ifndef MK_STAGE_AUX
#define MK_STAGE_AUX 1
#endif
#define PG8_STAGE(bufoff, gbase, voff) do { _Pragma("unroll") for (int _i = 0; _i < 2; ++_i) \
        __builtin_amdgcn_global_load_lds((const unsigned*)((const char*)(gbase) + (voff)[_i]), (PG8_LAS unsigned*)(lds + (bufoff) + ldsw + _i * 8192), 16, 0, MK_STAGE_AUX); } while (0)
#define PG8_LDA(dst, b, h) do { _Pragma("unroll") for (int m = 0; m < 4; ++m) _Pragma("unroll") for (int k = 0; k < 2; ++k) dst[m][k] = *(const PG8_LAS bf16x8*)(lds + PG8_SA(b, h) + aoff + m * 2048 + k * 1024); } while (0)
#define PG8_LDB(dst, b, h) do { _Pragma("unroll") for (int n = 0; n < 2; ++n) _Pragma("unroll") for (int k = 0; k < 2; ++k) dst[n][k] = *(const PG8_LAS bf16x8*)(lds + PG8_SB(b, h) + boff + n * 2048 + k * 1024); } while (0)
#ifndef MK_NOPRIO
#define PG8_PRIO(x) __builtin_amdgcn_s_setprio(x)
#else
#define PG8_PRIO(x) do { } while (0)
#endif
#if !defined(MK_MMA_PLAIN)
#define PG8_MM1(ai, bj, At, Bt, m, n, k) acc[ai][bj][m][n] = __builtin_amdgcn_mfma_f32_16x16x32_bf16(Bt[n][k], At[m][k], acc[ai][bj][m][n], 0, 0, 0); __builtin_amdgcn_sched_barrier(0)
#define PG8_MMA(ai, bj, At, Bt) do { PG8_PRIO(1); _Pragma("unroll") for (int k = 0; k < 2; ++k) { PG8_MM1(ai, bj, At, Bt, 0, 0, k); PG8_MM1(ai, bj, At, Bt, 0, 1, k); PG8_MM1(ai, bj, At, Bt, 1, 1, k); PG8_MM1(ai, bj, At, Bt, 1, 0, k); \
        PG8_MM1(ai, bj, At, Bt, 2, 0, k); PG8_MM1(ai, bj, At, Bt, 2, 1, k); PG8_MM1(ai, bj, At, Bt, 3, 1, k); PG8_MM1(ai, bj, At, Bt, 3, 0, k); } PG8_PRIO(0); } while (0)
#else
#define PG8_MMA(ai, bj, At, Bt) do { PG8_PRIO(1); _Pragma("unroll") for (int m = 0; m < 4; ++m) _Pragma("unroll") for (int n = 0; n < 2; ++n) _Pragma("unroll") for (int k = 0; k < 2; ++k) \
        acc[ai][bj][m][n] = __builtin_amdgcn_mfma_f32_16x16x32_bf16(Bt[n][k], At[m][k], acc[ai][bj][m][n], 0, 0, 0); PG8_PRIO(0); } while (0)
#endif
#if !defined(MK_MMA_PLAIN)
#define PG8_MMAR(ai, bj, At, Bt) do { PG8_PRIO(1); _Pragma("unroll") for (int k = 1; k >= 0; --k) { PG8_MM1(ai, bj, At, Bt, 3, 0, k); PG8_MM1(ai, bj, At, Bt, 3, 1, k); PG8_MM1(ai, bj, At, Bt, 2, 1, k); PG8_MM1(ai, bj, At, Bt, 2, 0, k); \
        PG8_MM1(ai, bj, At, Bt, 1, 0, k); PG8_MM1(ai, bj, At, Bt, 1, 1, k); PG8_MM1(ai, bj, At, Bt, 0, 1, k); PG8_MM1(ai, bj, At, Bt, 0, 0, k); } PG8_PRIO(0); } while (0)
#define PG8_MMAX(ai) do { PG8_MMA(ai, 0, At, B0); PG8_MMAR(ai, 1, At, B1); } while (0)
#else
#define PG8_MMAX(ai) do { PG8_MMA(ai, 0, At, B0); PG8_MMA(ai, 1, At, B1); } while (0)
#endif
#define PG8_WAIT_V(n) asm volatile("s_waitcnt vmcnt(" #n ")" ::: "memory")
#define PG8_WAIT_L(n) asm volatile("s_waitcnt lgkmcnt(" #n ")" ::: "memory")
#define PG8_BAR __builtin_amdgcn_s_barrier()
#define PG8_SCHED __builtin_amdgcn_sched_barrier(0)
    Unit cur, nxt; int ui = 0;
    if (!S.next(0, cur)) return;
    f32x4 acc[2][2][4][2];
#pragma unroll
    for (int a = 0; a < 2; ++a)
#pragma unroll
        for (int b = 0; b < 2; ++b)
#pragma unroll
            for (int m = 0; m < 4; ++m)
#pragma unroll
                for (int n = 0; n < 2; ++n) acc[a][b][m][n] = (f32x4){0.f, 0.f, 0.f, 0.f};
    bf16x8 At[4][2], B0[2][2], B1[2][2];
    const char* cA = (const char*)g.A + (size_t)cur.pm * tstepA + (size_t)(cur.pn >> 1) * (size_t)g.agrp * 2 + (size_t)cur.xa * 2; const char* cB = (const char*)g.Bt + (size_t)cur.pn * tstepB + (size_t)cur.xb * 2;
    if constexpr (Epi::RSTD_LDS) E.begin(cur, tid);
    if constexpr (SP2) {
    PG8_STAGE(PG8_SB(0, 0), cB, voffB); PG8_STAGE(PG8_SB(0, 1), cB + hstepB, voffB); PG8_STAGE(PG8_SA(0, 0), cA, voffA); PG8_STAGE(PG8_SA(0, 1), cA + hstepA, voffA);
    if (wr == 1) PG8_BAR;
    PG8_WAIT_V(2); PG8_BAR;
    PG8_STAGE(PG8_SB(1, 0), cB + kstep, voffB); PG8_STAGE(PG8_SA(1, 0), cA + kstep, voffA); PG8_STAGE(PG8_SB(1, 1), cB + hstepB + kstep, voffB);
    PG8_WAIT_V(6); PG8_BAR;
    } else {
    PG8_STAGE(PG8_SB(0, 0), cB, voffB); PG8_STAGE(PG8_SA(0, 0), cA, voffA); PG8_STAGE(PG8_SB(0, 1), cB + hstepB, voffB); PG8_STAGE(PG8_SA(0, 1), cA + hstepA, voffA);
    if (wr == 1) PG8_BAR;
    PG8_WAIT_V(4); PG8_BAR;
    PG8_STAGE(PG8_SB(1, 0), cB + kstep, voffB); PG8_STAGE(PG8_SA(1, 0), cA + kstep, voffA); PG8_STAGE(PG8_SB(1, 1), cB + hstepB + kstep, voffB);
    PG8_WAIT_V(6); PG8_BAR;
    }
    for (;;) {
        const bool has_next = S.next(ui + 1, nxt);
        const char* nA = has_next ? (const char*)g.A + (size_t)nxt.pm * tstepA + (size_t)(nxt.pn >> 1) * (size_t)g.agrp * 2 + (size_t)nxt.xa * 2 : cA; const char* nB = has_next ? (const char*)g.Bt + (size_t)nxt.pn * tstepB + (size_t)nxt.xb * 2 : cB;
        for (int t = 0; t < nt; t += 2) {
            const bool last = (t == nt - 2);
            if constexpr (Epi::RSTD_LDS) { if (last) E.late(tid); }
            const char* a1 = cA + (size_t)(t + 1) * kstep;
            const char* a2 = last ? nA : cA + (size_t)(t + 2) * kstep; const char* b2 = last ? nB : cB + (size_t)(t + 2) * kstep;
            const char* a3 = a2 + kstep; const char* b3 = b2 + kstep;
            if constexpr (SP2) {
            PG8_LDB(B0, 0, 0); PG8_LDB(B1, 0, 1); PG8_SCHED; PG8_LDA(At, 0, 0); PG8_STAGE(PG8_SA(1, 1), a1 + hstepA, voffA);
            PG8_WAIT_V(8); PG8_WAIT_L(0); PG8_BAR; PG8_MMAX(0); PG8_BAR; PG8_SCHED;
            PG8_LDA(At, 0, 1); PG8_STAGE(PG8_SB(0, 0), b2, voffB); PG8_STAGE(PG8_SB(0, 1), b2 + hstepB, voffB); PG8_STAGE(PG8_SA(0, 0), a2, voffA);
            PG8_WAIT_V(8); PG8_WAIT_L(0); PG8_BAR; PG8_MMAX(1); PG8_BAR; PG8_SCHED;
            PG8_LDB(B0, 1, 0); PG8_LDB(B1, 1, 1); PG8_SCHED; PG8_LDA(At, 1, 0); PG8_STAGE(PG8_SA(0, 1), a2 + hstepA, voffA);
            PG8_WAIT_V(8); PG8_WAIT_L(0); PG8_BAR; PG8_MMAX(0); PG8_BAR; PG8_SCHED;
            PG8_LDA(At, 1, 1); PG8_STAGE(PG8_SB(1, 0), b3, voffB); PG8_STAGE(PG8_SB(1, 1), b3 + hstepB, voffB); PG8_STAGE(PG8_SA(1, 0), a3, voffA);
            PG8_WAIT_V(8); PG8_WAIT_L(0); PG8_BAR; PG8_MMAX(1); PG8_BAR; PG8_SCHED;
            } else {
            PG8_LDB(B0, 0, 0); PG8_SCHED; PG8_LDA(At, 0, 0); PG8_STAGE(PG8_SA(1, 1), a1 + hstepA, voffA);
            PG8_WAIT_L(8); PG8_BAR; PG8_WAIT_L(0); PG8_MMA(0, 0, At, B0); PG8_BAR; PG8_SCHED;
            PG8_LDB(B1, 0, 1); PG8_STAGE(PG8_SB(0, 0), b2, voffB);
            PG8_BAR; PG8_WAIT_L(0); PG8_MMA(0, 1, At, B1); PG8_BAR;
            PG8_LDA(At, 0, 1); PG8_STAGE(PG8_SA(0, 0), a2, voffA);
            PG8_BAR; PG8_WAIT_L(0); PG8_MMA(1, 0, At, B0); PG8_BAR; PG8_SCHED;
            PG8_STAGE(PG8_SB(0, 1), b2 + hstepB, voffB);
            PG8_WAIT_V(6); PG8_BAR; PG8_MMA(1, 1, At, B1); PG8_BAR;
            PG8_LDB(B0, 1, 0); PG8_SCHED; PG8_LDA(At, 1, 0); PG8_STAGE(PG8_SA(0, 1), a2 + hstepA, voffA);
            PG8_WAIT_L(8); PG8_BAR; PG8_WAIT_L(0); PG8_MMA(0, 0, At, B0); PG8_BAR; PG8_SCHED;
            PG8_LDB(B1, 1, 1); PG8_STAGE(PG8_SB(1, 0), b3, voffB);
            PG8_BAR; PG8_WAIT_L(0); PG8_MMA(0, 1, At, B1); PG8_BAR;
            PG8_LDA(At, 1, 1); PG8_STAGE(PG8_SA(1, 0), a3, voffA);
            PG8_BAR; PG8_WAIT_L(0); PG8_MMA(1, 0, At, B0); PG8_BAR; PG8_SCHED;
            PG8_STAGE(PG8_SB(1, 1), b3 + hstepB, voffB);
            PG8_WAIT_V(6); PG8_BAR; PG8_MMA(1, 1, At, B1); PG8_BAR;
            }
        }
        if (wr == 0) PG8_BAR;
        E(acc, cur, wr, wc, fr, fq);
#if defined(MK_EPI_TWICE)
        if (Epi::TWICE_OK) { asm volatile("" ::: "memory"); E(acc, cur, wr, wc, fr, fq); }
#endif
        if (!has_next) break;
#pragma unroll
        for (int a = 0; a < 2; ++a)
#pragma unroll
            for (int b = 0; b < 2; ++b)
#pragma unroll
                for (int m = 0; m < 4; ++m)
#pragma unroll
                    for (int n = 0; n < 2; ++n) acc[a][b][m][n] = (f32x4){0.f, 0.f, 0.f, 0.f};
        cur = nxt; cA = nA; cB = nB; ++ui;
        if constexpr (Epi::RSTD_LDS) E.begin(cur, tid);
        if (wr == 1) PG8_BAR;
    }
    PG8_WAIT_V(0);
    PG8_BAR;
#undef PG8_SA
#undef PG8_SB
#undef PG8_STAGE
#undef PG8_LDA
#undef PG8_LDB
#undef PG8_MMA
#undef PG8_MM1
#undef PG8_MMAR
#undef PG8_MMAX
#undef PG8_WAIT_V
#undef PG8_WAIT_L
#undef PG8_BAR
#undef PG8_SCHED
}
}
#ifndef MK_RESID_BF16
#define MK_RESID_BF16 1
#endif
namespace pg8 {
constexpr float RMS_EPS = 1e-6f;
constexpr int DM = 2048;
constexpr int LDS_RED_OFF = 131072 + 1024, LDS_RSL_OFF = 131072 + 5120, LDS_RAW_OFF = 131072 + 6144;
struct RstdLds {
    const float* ssq; PG8_LAS unsigned char* lds;
    __device__ __forceinline__ void begin(const Unit& u, int tid) const {
        const int w = __builtin_amdgcn_readfirstlane(tid >> 6), lane = tid & 63;
        __builtin_amdgcn_global_load_lds((const unsigned*)(ssq + ((size_t)(u.pm * BM + 32 * w)) * 8 + 4 * lane), (PG8_LAS unsigned*)(lds + LDS_RAW_OFF + w * 1024), 16, 0, 0);
    }
    __device__ __forceinline__ void late(int tid) const {
        const f32x4 v = *(const PG8_LAS f32x4*)(lds + LDS_RAW_OFF + tid * 16);
        float s = (v[0] + v[1]) + (v[2] + v[3]); s += __shfl_xor(s, 1);
        if ((tid & 1) == 0) ((PG8_LAS float*)(lds + LDS_RSL_OFF))[tid >> 1] = __builtin_amdgcn_rsqf(s * (1.0f / DM) + RMS_EPS);
    }
    __device__ __forceinline__ void rows8(int wr, int fr, float (&r)[2][4]) const {
        const PG8_LAS float* rsl = (const PG8_LAS float*)(lds + LDS_RSL_OFF);
#pragma unroll
        for (int ai = 0; ai < 2; ++ai)
#pragma unroll
            for (int m = 0; m < 4; ++m) r[ai][m] = rsl[ai * HALF + wr * 64 + m * 16 + fr];
    }
};
__device__ __forceinline__ float fast_sigmoid(float x) { return __builtin_amdgcn_rcpf(1.0f + __builtin_amdgcn_exp2f(-1.4426950408889634f * x)); }
__device__ __forceinline__ float fast_silu(float x) { return x * fast_sigmoid(x); }
__device__ __forceinline__ float fast_gelu_tanh(float x) { return x * fast_sigmoid(1.5957691216057308f * (x + 0.044715f * x * x * x)); }

struct EpiSwiglu {
    static constexpr bool PERM = true, TWICE_OK = true, RSTD_LDS = true;
    bf16_t* H; int ldh; RstdLds R;
    __device__ __forceinline__ void begin(const Unit& u, int tid) const { R.begin(u, tid); }
    __device__ __forceinline__ void late(int tid) const { R.late(tid); }
    __device__ __forceinline__ void operator()(const f32x4 (&acc)[2][2][4][2], const Unit& u, int wr, int wc, int fr, int fq) const {
        float rs[2][4]; R.rows8(wr, fr, rs);
        const int row0 = u.pm * BM + wr * 64 + fr, col0 = u.pn * HALF + wc * 32 + 8 * fq;
#pragma unroll
        for (int ai = 0; ai < 2; ++ai)
#pragma unroll
            for (int m = 0; m < 4; ++m) { const float r = rs[ai][m]; float v[8];
#pragma unroll
                for (int n = 0; n < 2; ++n)
#pragma unroll
                    for (int i = 0; i < 4; ++i) v[4 * n + i] = fast_silu(acc[ai][0][m][n][i] * r) * (acc[ai][1][m][n][i] * r);
                u32x4 w; w.x = cvt_pk_bf16(v[0], v[1]); w.y = cvt_pk_bf16(v[2], v[3]); w.z = cvt_pk_bf16(v[4], v[5]); w.w = cvt_pk_bf16(v[6], v[7]);
#if defined(MK_HID_NT)
                __builtin_nontemporal_store(w, (u32x4*)(H + (size_t)(row0 + ai * HALF + m * 16) * ldh + col0)); }
#else
                *(u32x4*)(H + (size_t)(row0 + ai * HALF + m * 16) * ldh + col0) = w; }
#endif
    }
};
template <bool BIAS, bool SCALE> struct EpiResid {
    static constexpr bool PERM = true, TWICE_OK = false, RSTD_LDS = false;
    bf16_t* XH; bf16_t* XB; float* ssq; const float* bias; const float* cscale; float alpha; PG8_LAS float* red;
    __device__ __forceinline__ void operator()(const f32x4 (&acc)[2][2][4][2], const Unit& u, int wr, int wc, int fr, int fq) const {
        const int row0 = u.pm * BM + wr * 64 + fr, col0 = u.pn * BM + wc * 32 + 8 * fq;
        f32x4 bv[2][2], mv[2][2];
#pragma unroll
        for (int bj = 0; bj < 2; ++bj)
#pragma unroll
            for (int n = 0; n < 2; ++n) { bv[bj][n] = BIAS ? *(const f32x4*)(bias + col0 + bj * HALF + 4 * n) : (f32x4){0.f, 0.f, 0.f, 0.f};
                                          mv[bj][n] = SCALE ? *(const f32x4*)(cscale + col0 + bj * HALF + 4 * n) * alpha : (f32x4){alpha, alpha, alpha, alpha}; }
#if !defined(MK_RESID_NOPRE)
        constexpr bool L16 = !BIAS && !SCALE;
#else
        constexpr bool L16 = false;
#endif
#ifndef MK_RESID_NPRE
#define MK_RESID_NPRE 2
#endif
        constexpr int NPRE = L16 ? MK_RESID_NPRE : 0;
        u32x4 xo2[2][4][2];
        if constexpr (L16) {
#pragma unroll
            for (int ai = 0; ai < 2; ++ai)
#pragma unroll
                for (int m = 0; m < (ai ? NPRE : 4); ++m)
#pragma unroll
                    for (int bj = 0; bj < 2; ++bj) xo2[ai][m][bj] = *(const u32x4*)((MK_RESID_BF16 ? XB : XH) + (size_t)(row0 + ai * HALF + m * 16) * DM + col0 + bj * HALF);
        }
#pragma unroll
        for (int ai = 0; ai < 2; ++ai) { u32x4 xo[4][2];
#pragma unroll
            for (int m = 0; m < 4; ++m)
#pragma unroll
                for (int bj = 0; bj < 2; ++bj) { if (L16 && (ai == 0 || m < NPRE)) xo[m][bj] = xo2[ai][m][bj]; else xo[m][bj] = *(const u32x4*)((MK_RESID_BF16 ? XB : XH) + (size_t)(row0 + ai * HALF + m * 16) * DM + col0 + bj * HALF); }
#pragma unroll
            for (int m = 0; m < 4; ++m) { const int row = row0 + ai * HALF + m * 16; const size_t off = (size_t)row * DM + col0; float ss = 0.f;
#pragma unroll
                for (int bj = 0; bj < 2; ++bj) { const u32x4 q = xo[m][bj];
                    const f32x4 x0 = MK_RESID_BF16 ? (f32x4){__uint_as_float(q.x << 16), __uint_as_float(q.x & 0xffff0000u), __uint_as_float(q.y << 16), __uint_as_float(q.y & 0xffff0000u)} : (f32x4){h_lo(q.x), h_hi(q.x), h_lo(q.y), h_hi(q.y)};
                    const f32x4 x1 = MK_RESID_BF16 ? (f32x4){__uint_as_float(q.z << 16), __uint_as_float(q.z & 0xffff0000u), __uint_as_float(q.w << 16), __uint_as_float(q.w & 0xffff0000u)} : (f32x4){h_lo(q.z), h_hi(q.z), h_lo(q.w), h_hi(q.w)};
                    f32x4 a0 = acc[ai][bj][m][0], a1 = acc[ai][bj][m][1]; if (BIAS) { a0 = a0 + bv[bj][0]; a1 = a1 + bv[bj][1]; }
                    const f32x4 v0 = x0 + a0 * mv[bj][0], v1 = x1 + a1 * mv[bj][1];
                    u32x4 w; w.x = cvt_pk_bf16(v0[0], v0[1]); w.y = cvt_pk_bf16(v0[2], v0[3]); w.z = cvt_pk_bf16(v1[0], v1[1]); w.w = cvt_pk_bf16(v1[2], v1[3]);
                    *(u32x4*)(XB + off + bj * HALF) = w;
                    if (MK_RESID_BF16) {
                        const float r0 = __uint_as_float(w.x << 16), r1 = __uint_as_float(w.x & 0xffff0000u), r2 = __uint_as_float(w.y << 16), r3 = __uint_as_float(w.y & 0xffff0000u);
                        const float r4 = __uint_as_float(w.z << 16), r5 = __uint_as_float(w.z & 0xffff0000u), r6 = __uint_as_float(w.w << 16), r7 = __uint_as_float(w.w & 0xffff0000u);
                        ss += ((r0 * r0 + r1 * r1) + (r2 * r2 + r3 * r3)) + ((r4 * r4 + r5 * r5) + (r6 * r6 + r7 * r7));
                    } else {
                        u32x4 wh; wh.x = cvt_pk_h16(v0[0], v0[1]); wh.y = cvt_pk_h16(v0[2], v0[3]); wh.z = cvt_pk_h16(v1[0], v1[1]); wh.w = cvt_pk_h16(v1[2], v1[3]);
                        *(u32x4*)(XH + off + bj * HALF) = wh;
                        ss += ((v0[0] * v0[0] + v0[1] * v0[1]) + (v0[2] * v0[2] + v0[3] * v0[3])) + ((v1[0] * v1[0] + v1[1] * v1[1]) + (v1[2] * v1[2] + v1[3] * v1[3])); } }
                ss += __shfl_xor(ss, 16); ss += __shfl_xor(ss, 32);
                if (fq == 0) red[(ai * HALF + wr * 64 + m * 16 + fr) * 4 + wc] = ss; }
            asm volatile("" ::: "memory"); }
        asm volatile("s_waitcnt lgkmcnt(0)" ::: "memory"); __builtin_amdgcn_s_barrier(); asm volatile("" ::: "memory");
        { const int t = threadIdx.x; if (t < BM) { const f32x4 r4 = *(const PG8_LAS f32x4*)(red + 4 * t); ssq[((size_t)(u.pm * BM + t)) * 8 + u.pn] = (r4[0] + r4[1]) + (r4[2] + r4[3]); } }
        asm volatile("s_waitcnt lgkmcnt(0)" ::: "memory"); __builtin_amdgcn_s_barrier(); asm volatile("" ::: "memory");
    }
};
struct EpiResidFinal {
    static constexpr bool PERM = true, TWICE_OK = false, RSTD_LDS = false;
    const bf16_t* XB; float* ssq; float alpha; PG8_LAS float* red; PG8_LAS float* rsl; float* out; const float* gfin; unsigned* cnt; unsigned* tmo;
    __device__ __forceinline__ void operator()(const f32x4 (&acc_)[2][2][4][2], const Unit& u, int wr, int wc, int fr_, int fq) const {
        f32x4 (&acc)[2][2][4][2] = const_cast<f32x4 (&)[2][2][4][2]>(acc_);
        int fr = fr_; asm volatile("" : "+v"(fr));
        const int rb = wr * 64 + fr, row0 = u.pm * BM + rb, col0 = u.pn * BM + wc * 32 + 8 * fq;
#pragma unroll
        for (int ai = 0; ai < 2; ++ai) { u32x4 xo[4][2];
#pragma unroll
            for (int m = 0; m < 4; ++m)
#pragma unroll
                for (int bj = 0; bj < 2; ++bj) xo[m][bj] = *(const u32x4*)(XB + (size_t)(row0 + ai * HALF + m * 16) * DM + col0 + bj * HALF);
#pragma unroll
            for (int m = 0; m < 4; ++m) { float ss = 0.f;
#pragma unroll
                for (int bj = 0; bj < 2; ++bj) { const u32x4 q = xo[m][bj];
                    const f32x4 x0 = (f32x4){__uint_as_float(q.x << 16), __uint_as_float(q.x & 0xffff0000u), __uint_as_float(q.y << 16), __uint_as_float(q.y & 0xffff0000u)};
                    const f32x4 x1 = (f32x4){__uint_as_float(q.z << 16), __uint_as_float(q.z & 0xffff0000u), __uint_as_float(q.w << 16), __uint_as_float(q.w & 0xffff0000u)};
                    const f32x4 v0 = x0 + acc[ai][bj][m][0] * alpha, v1 = x1 + acc[ai][bj][m][1] * alpha; acc[ai][bj][m][0] = v0; acc[ai][bj][m][1] = v1;
                    ss += ((v0[0] * v0[0] + v0[1] * v0[1]) + (v0[2] * v0[2] + v0[3] * v0[3])) + ((v1[0] * v1[0] + v1[1] * v1[1]) + (v1[2] * v1[2] + v1[3] * v1[3])); }
                ss += __shfl_xor(ss, 16); ss += __shfl_xor(ss, 32);
                if (fq == 0) red[(ai * HALF + m * 16 + rb) * 4 + wc] = ss; }
            asm volatile("" ::: "memory"); }
        asm volatile("s_waitcnt lgkmcnt(0)" ::: "memory"); __builtin_amdgcn_s_barrier(); asm volatile("" ::: "memory");
        const int t = threadIdx.x;
        if (t < BM) { const f32x4 r4 = *(const PG8_LAS f32x4*)(red + 4 * t); ssq[((size_t)(u.pm * BM + t)) * 8 + u.pn] = (r4[0] + r4[1]) + (r4[2] + r4[3]); }
        asm volatile("s_waitcnt vmcnt(0) lgkmcnt(0)" ::: "memory"); __builtin_amdgcn_s_barrier(); asm volatile("" ::: "memory");
        if (t == 0) { unsigned* cw = cnt + 64 * u.pm;
            __builtin_amdgcn_fence(__ATOMIC_RELEASE, "agent"); asm volatile("s_waitcnt vmcnt(0)" ::: "memory");
            (void)__hip_atomic_fetch_add(cw, 1u, __ATOMIC_RELAXED, __HIP_MEMORY_SCOPE_AGENT);
            unsigned sp = 0;
            while (__hip_atomic_load(cw, __ATOMIC_RELAXED, __HIP_MEMORY_SCOPE_AGENT) < 8u) { __builtin_amdgcn_s_sleep(1);
                if ((++sp & 255u) == 0u) { if (__hip_atomic_load(tmo, __ATOMIC_RELAXED, __HIP_MEMORY_SCOPE_AGENT)) break; if (sp > (1u << 18)) { atomicAdd(tmo, 1u); break; } } }
            __builtin_amdgcn_fence(__ATOMIC_ACQUIRE, "agent"); asm volatile("s_waitcnt vmcnt(0)" ::: "memory"); }
        asm volatile("" ::: "memory"); __builtin_amdgcn_s_barrier(); asm volatile("" ::: "memory");
        if (t < BM) { const f32x4* sp4 = (const f32x4*)(ssq + ((size_t)(u.pm * BM + t)) * 8); const f32x4 a = sp4[0], b = sp4[1];
            rsl[t] = __builtin_amdgcn_rsqf((((a[0] + a[1]) + (a[2] + a[3])) + ((b[0] + b[1]) + (b[2] + b[3]))) * (1.0f / DM) + RMS_EPS); }
        asm volatile("s_waitcnt vmcnt(0) lgkmcnt(0)" ::: "memory"); __builtin_amdgcn_s_barrier(); asm volatile("" ::: "memory");
        f32x4 gv[2][2];
#pragma unroll
        for (int bj = 0; bj < 2; ++bj)
#pragma unroll
            for (int n = 0; n < 2; ++n) gv[bj][n] = *(const f32x4*)(gfin + col0 + bj * HALF + 4 * n);
#pragma unroll
        for (int ai = 0; ai < 2; ++ai)
#pragma unroll
            for (int m = 0; m < 4; ++m) { const float r = rsl[ai * HALF + m * 16 + rb]; float* op = out + (size_t)(row0 + ai * HALF + m * 16) * DM + col0;
#pragma unroll
                for (int bj = 0; bj < 2; ++bj)
#pragma unroll
                    for (int n = 0; n < 2; ++n) *(f32x4*)(op + bj * HALF + 4 * n) = acc[ai][bj][m][n] * r * gv[bj][n]; }
    }
};
struct EpiWin {
    static constexpr bool PERM = true, TWICE_OK = false, RSTD_LDS = true;
    bf16_t *U, *V, *HB; float* lnp; RstdLds R; const float* bias;
    __device__ __forceinline__ void begin(const Unit& u, int tid) const { R.begin(u, tid); }
    __device__ __forceinline__ void late(int tid) const { R.late(tid); }
    __device__ __forceinline__ void operator()(const f32x4 (&acc)[2][2][4][2], const Unit& u, int wr, int wc, int fr, int fq) const {
        float rs[2][4]; R.rows8(wr, fr, rs);
        const int row0 = u.pm * BM + wr * 64 + fr;
        if (u.pn < 8) {
            const bool isv = u.pn >= 4; bf16_t* dst = isv ? V : U;
            const int colt = (u.pn & 3) * BM + wc * 32 + 8 * fq, bcol = u.pn * BM + wc * 32 + 8 * fq;
            f32x4 bv[2][2];
#pragma unroll
            for (int bj = 0; bj < 2; ++bj)
#pragma unroll
                for (int n = 0; n < 2; ++n) bv[bj][n] = *(const f32x4*)(bias + bcol + bj * HALF + 4 * n);
#pragma unroll
            for (int ai = 0; ai < 2; ++ai)
#pragma unroll
                for (int m = 0; m < 4; ++m) { const int row = row0 + ai * HALF + m * 16; const float r = rs[ai][m]; float s1 = 0.f, s2 = 0.f;
#pragma unroll
                    for (int bj = 0; bj < 2; ++bj) { float v[8];
#pragma unroll
                        for (int n = 0; n < 2; ++n)
#pragma unroll
                            for (int i = 0; i < 4; ++i) { const float g = fast_gelu_tanh(acc[ai][bj][m][n][i] * r + bv[bj][n][i]); v[4 * n + i] = g; s1 += g; s2 += g * g; }
                        u32x4 w; w.x = cvt_pk_bf16(v[0], v[1]); w.y = cvt_pk_bf16(v[2], v[3]); w.z = cvt_pk_bf16(v[4], v[5]); w.w = cvt_pk_bf16(v[6], v[7]);
                        *(u32x4*)(dst + (size_t)row * 1024 + colt + bj * HALF) = w; }
                    if (isv) { s1 += __shfl_xor(s1, 16); s1 += __shfl_xor(s1, 32); s2 += __shfl_xor(s2, 16); s2 += __shfl_xor(s2, 32);
                        if (fq == 0) *(f32x2*)(lnp + ((size_t)row * 16 + (u.pn - 4) * 4 + wc) * 2) = (f32x2){s1, s2}; } }
        } else {
            const int j0 = (u.pn - 8) * HALF + wc * 32 + 8 * fq;
            f32x4 ba[2], bg[2];
#pragma unroll
            for (int n = 0; n < 2; ++n) { ba[n] = *(const f32x4*)(bias + 2048 + j0 + 4 * n); bg[n] = *(const f32x4*)(bias + 3072 + j0 + 4 * n); }
#pragma unroll
            for (int ai = 0; ai < 2; ++ai)
#pragma unroll
                for (int m = 0; m < 4; ++m) { const int row = row0 + ai * HALF + m * 16; const float r = rs[ai][m]; float v[8];
#pragma unroll
                    for (int n = 0; n < 2; ++n)
#pragma unroll
                        for (int i = 0; i < 4; ++i) v[4 * n + i] = (acc[ai][0][m][n][i] * r + ba[n][i]) * fast_sigmoid(acc[ai][1][m][n][i] * r + bg[n][i]);
                    u32x4 w; w.x = cvt_pk_bf16(v[0], v[1]); w.y = cvt_pk_bf16(v[2], v[3]); w.z = cvt_pk_bf16(v[4], v[5]); w.w = cvt_pk_bf16(v[6], v[7]);
                    *(u32x4*)(HB + (size_t)row * 1024 + j0) = w; }
        }
    }
};
struct EpiNone {
    static constexpr bool PERM = true, TWICE_OK = false, RSTD_LDS = false;
    __device__ __forceinline__ void operator()(const f32x4 (&acc)[2][2][4][2], const Unit&, int, int, int, int) const {
#pragma unroll
        for (int ai = 0; ai < 2; ++ai)
#pragma unroll
            for (int bj = 0; bj < 2; ++bj)
#pragma unroll
                for (int m = 0; m < 4; ++m) asm volatile("" :: "v"(acc[ai][bj][m][0]), "v"(acc[ai][bj][m][1]));
    }
};
struct EpiQ {
    static constexpr bool PERM = true, TWICE_OK = false, RSTD_LDS = true;
    bf16_t* Q; RstdLds R; float qscale;
    __device__ __forceinline__ void begin(const Unit& u, int tid) const { R.begin(u, tid); }
    __device__ __forceinline__ void late(int tid) const { R.late(tid); }
    __device__ __forceinline__ void operator()(const f32x4 (&acc)[2][2][4][2], const Unit& u, int wr, int wc, int fr, int fq) const {
        float rs[2][4]; R.rows8(wr, fr, rs);
        const int row0 = u.pm * BM + wr * 64 + fr, col0 = u.pn * BM + wc * 32 + 8 * fq;
#pragma unroll
        for (int ai = 0; ai < 2; ++ai)
#pragma unroll
            for (int m = 0; m < 4; ++m) { const float r = rs[ai][m] * qscale; bf16_t* rowp = Q + (size_t)(row0 + ai * HALF + m * 16) * DM + col0;
#pragma unroll
                for (int bj = 0; bj < 2; ++bj) { const f32x4 v0 = acc[ai][bj][m][0] * r, v1 = acc[ai][bj][m][1] * r;
                    u32x4 w; w.x = cvt_pk_bf16(v0[0], v0[1]); w.y = cvt_pk_bf16(v0[2], v0[3]); w.z = cvt_pk_bf16(v1[0], v1[1]); w.w = cvt_pk_bf16(v1[2], v1[3]);
                    *(u32x4*)(rowp + bj * HALF) = w; } }
    }
};
struct EpiKV {
    static constexpr bool PERM = true, TWICE_OK = false, RSTD_LDS = false;
    bf16_t* KB; bf16_t* VB; const float* rstd_mem;
    __device__ __forceinline__ void operator()(const f32x4 (&acc)[2][2][4][2], const Unit& u, int wr, int wc, int fr, int fq) const {
        const int row0 = u.pm * BM + wr * 64 + fr, l = (u.pn >> 3) & 3, col0 = (u.pn & 7) * BM + wc * 32 + 8 * fq; bf16_t* dst = (u.pn < 32) ? KB : VB;
#pragma unroll
        for (int ai = 0; ai < 2; ++ai)
#pragma unroll
            for (int m = 0; m < 4; ++m) { const int row = row0 + ai * HALF + m * 16; const float r = rstd_mem[row]; bf16_t* rowp = dst + ((size_t)l * 1024 + row) * DM + col0;
#pragma unroll
                for (int bj = 0; bj < 2; ++bj) { const f32x4 v0 = acc[ai][bj][m][0] * r, v1 = acc[ai][bj][m][1] * r;
                    u32x4 w; w.x = cvt_pk_bf16(v0[0], v0[1]); w.y = cvt_pk_bf16(v0[2], v0[3]); w.z = cvt_pk_bf16(v1[0], v1[1]); w.w = cvt_pk_bf16(v1[2], v1[3]);
                    *(u32x4*)(rowp + bj * HALF) = w; } }
    }
};
struct EpiPre {
    static constexpr bool PERM = true, TWICE_OK = false, RSTD_LDS = false;
    bf16_t* VWt; bf16_t* KWg;
    __device__ __forceinline__ void operator()(const f32x4 (&acc)[2][2][4][2], const Unit& u, int wr, int wc, int fr, int fq) const {
        const int e = u.id, t = e & 7, b = (e >> 3) & 3, h = (e >> 5) & 3, l = (e >> 7) & 3; const bool kw = e >= 512; const int ldc = kw ? 2048 : 1024;
        bf16_t* base = kw ? KWg + ((size_t)(l * 4 + b) * 1024 + h * 256 + wr * 64 + fr) * 2048 + t * BM + wc * 32 + 8 * fq
                          : VWt + ((size_t)(l * 4 + b) * 2048 + t * BM + wr * 64 + fr) * 1024 + h * 256 + wc * 32 + 8 * fq;
#pragma unroll
        for (int ai = 0; ai < 2; ++ai)
#pragma unroll
            for (int m = 0; m < 4; ++m) { bf16_t* rowp = base + (size_t)(ai * HALF + m * 16) * ldc;
#pragma unroll
                for (int bj = 0; bj < 2; ++bj) { const f32x4 v0 = acc[ai][bj][m][0], v1 = acc[ai][bj][m][1];
                    u32x4 w; w.x = cvt_pk_bf16(v0[0], v0[1]); w.y = cvt_pk_bf16(v0[2], v0[3]); w.z = cvt_pk_bf16(v1[0], v1[1]); w.w = cvt_pk_bf16(v1[2], v1[3]);
                    *(u32x4*)(rowp + bj * HALF) = w; } }
    }
};
struct EpiSoftmax {
    static constexpr bool PERM = true, TWICE_OK = false, RSTD_LDS = true;
    bf16_t* P; RstdLds R; float qscale; PG8_LAS float* red; PG8_LAS float* red2;
    __device__ __forceinline__ void begin(const Unit& u, int tid) const { R.begin(u, tid); }
    __device__ __forceinline__ void late(int tid) const { R.late(tid); }
    __device__ __forceinline__ void operator()(const f32x4 (&acc_)[2][2][4][2], const Unit& u, int wr, int wc, int fr_, int fq) const {
        f32x4 (&acc)[2][2][4][2] = const_cast<f32x4 (&)[2][2][4][2]>(acc_);
        int fr = fr_; asm volatile("" : "+v"(fr));
        const int rb = wr * 64 + fr;
        const PG8_LAS float* rsl = (const PG8_LAS float*)(R.lds + LDS_RSL_OFF) + rb;
        PG8_LAS float* r1 = red + 4 * rb; PG8_LAS float* r2 = red2 + 4 * rb;
#pragma unroll
        for (int ai = 0; ai < 2; ++ai)
#pragma unroll
            for (int m = 0; m < 4; ++m) { float mx = acc[ai][0][m][0][0];
#pragma unroll
                for (int bj = 0; bj < 2; ++bj)
#pragma unroll
                    for (int n = 0; n < 2; ++n)
#pragma unroll
                        for (int i = 0; i < 4; ++i) mx = fmaxf(mx, acc[ai][bj][m][n][i]);
                mx = fmaxf(mx, __shfl_xor(mx, 16)); mx = fmaxf(mx, __shfl_xor(mx, 32));
                if (fq == 0) r1[(ai * HALF + m * 16) * 4 + wc] = mx * (rsl[ai * HALF + m * 16] * qscale); }
        asm volatile("s_waitcnt lgkmcnt(0)" ::: "memory"); __builtin_amdgcn_s_barrier(); asm volatile("" ::: "memory");
#pragma unroll
        for (int ai = 0; ai < 2; ++ai)
#pragma unroll
            for (int m = 0; m < 4; ++m) { const f32x4 m4 = *(const PG8_LAS f32x4*)(r1 + (ai * HALF + m * 16) * 4);
                const float mx = fmaxf(fmaxf(m4[0], m4[1]), fmaxf(m4[2], m4[3])), r = rsl[ai * HALF + m * 16] * qscale; float sum = 0.f;
#pragma unroll
                for (int bj = 0; bj < 2; ++bj)
#pragma unroll
                    for (int n = 0; n < 2; ++n)
#pragma unroll
                        for (int i = 0; i < 4; ++i) { const float pz = __builtin_amdgcn_exp2f(acc[ai][bj][m][n][i] * r - mx); acc[ai][bj][m][n][i] = pz; sum += pz; }
                sum += __shfl_xor(sum, 16); sum += __shfl_xor(sum, 32);
                if (fq == 0) r2[(ai * HALF + m * 16) * 4 + wc] = sum; }
        asm volatile("s_waitcnt lgkmcnt(0)" ::: "memory"); __builtin_amdgcn_s_barrier(); asm volatile("" ::: "memory");
        bf16_t* base = P + (size_t)(u.pm * BM + rb) * 1024 + u.pn * BM + wc * 32 + 8 * fq;
#pragma unroll
        for (int ai = 0; ai < 2; ++ai)
#pragma unroll
            for (int m = 0; m < 4; ++m) { const f32x4 s4 = *(const PG8_LAS f32x4*)(r2 + (ai * HALF + m * 16) * 4);
                const float inv = __builtin_amdgcn_rcpf((s4[0] + s4[1]) + (s4[2] + s4[3])); bf16_t* rowp = base + (size_t)(ai * HALF + m * 16) * 1024;
#pragma unroll
                for (int bj = 0; bj < 2; ++bj) { const f32x4 v0 = acc[ai][bj][m][0] * inv, v1 = acc[ai][bj][m][1] * inv;
                    u32x4 w; w.x = cvt_pk_bf16(v0[0], v0[1]); w.y = cvt_pk_bf16(v0[2], v0[3]); w.z = cvt_pk_bf16(v1[0], v1[1]); w.w = cvt_pk_bf16(v1[2], v1[3]);
                    *(u32x4*)(rowp + bj * HALF) = w; } }
    }
};
}
namespace mk {
using pg8::bf16_t; using pg8::bf16x8; using pg8::f32x4; using pg8::f32x2; using pg8::u32x4; using pg8::u32x2;
#define LAS __attribute__((address_space(3)))
typedef unsigned short bf16;
constexpr int D = 2048, NB = 4, S = 2048, M = NB * S, F = 5632, NM = 256, MM = NB * NM, NL = 4, NWAVES = 8, NTHREADS = 512;
constexpr float EPS = 1e-6f;
constexpr float QSCALE = 0.044194173824159216f * 1.4426950408889634f;

constexpr size_t MiB = 1u << 20;
constexpr size_t WS_CTL = 0, CTL_BYTES = 1 * MiB;
constexpr size_t SZ_WGU = (size_t)2 * F * D * 2, SZ_WDN = (size_t)D * F * 2, SZ_SQ = (size_t)D * D * 2;
constexpr size_t WS_WGU = 1 * MiB;
constexpr size_t WS_WDN = WS_WGU + 8 * SZ_WGU;
constexpr size_t WS_WQ = WS_WDN + 8 * SZ_WDN;
constexpr size_t WS_WO = WS_WQ + 4 * SZ_SQ;
constexpr size_t WS_WK = WS_WO + 4 * SZ_SQ;
constexpr size_t WS_WV = WS_WK + 4 * SZ_SQ;
constexpr size_t WS_WIN = WS_WV + 4 * SZ_SQ;
constexpr size_t WS_WOUT = WS_WIN + 2 * 2 * SZ_SQ;
constexpr size_t WS_WPOOL = WS_WOUT + 2 * SZ_SQ;
constexpr size_t WS_WSG = WS_WPOOL + 2 * (size_t)2048 * 512 * 2;
constexpr size_t WS_X = WS_WSG + 2 * (size_t)8 * 128 * 128 * 2;
constexpr size_t WS_XB = WS_X + (size_t)M * D * 4;
constexpr size_t WS_SSQ = WS_XB + (size_t)M * D * 2;
constexpr size_t WS_LNP = WS_SSQ + (size_t)M * 32 * 4;
constexpr size_t WS_MEMB = WS_LNP + (size_t)M * 32 * 4;
constexpr size_t WS_RMEM = WS_MEMB + (size_t)MM * D * 2;
constexpr size_t WS_KB = WS_RMEM + 4096;
constexpr size_t WS_VT = WS_KB + (size_t)NL * MM * D * 2;
constexpr size_t WS_HID = WS_VT + (size_t)NL * MM * D * 2;
constexpr size_t WS_U = WS_HID, WS_V = WS_U + (size_t)M * 1024 * 2, WS_HB = WS_V + (size_t)M * 1024 * 2, WS_YC = WS_HB + (size_t)M * 1024 * 2;
constexpr size_t WS_DD = WS_HID;
constexpr size_t WS_Q = WS_HID, WS_O = WS_Q + (size_t)M * D * 2;
constexpr size_t WS_P = WS_O;
constexpr size_t WS_VW = (WS_HID + (size_t)M * F * 2 + 4095) & ~(size_t)4095;
constexpr size_t WS_KW = WS_VW + (size_t)NL * NB * D * 1024 * 2;
constexpr size_t WS_END = WS_KW + (size_t)NL * NB * 1024 * D * 2;
static_assert(WS_YC + (size_t)M * D * 2 <= WS_HID + (size_t)M * F * 2 && WS_O + (size_t)M * D * 2 <= WS_HID + (size_t)M * F * 2, "overlays fit in HID");

constexpr int RING_BYTES = 131072, LDSCTL_OFF = RING_BYTES, MISC_OFF = LDSCTL_OFF + 320, LDS_RED2_OFF = 147456, LDS_BYTES = 151552;

typedef unsigned v4u __attribute__((ext_vector_type(4)));
#define LDS_WAIT() asm volatile("s_waitcnt lgkmcnt(0)" ::: "memory")
#define VM_WAIT() asm volatile("s_waitcnt vmcnt(0)" ::: "memory")
__device__ __forceinline__ unsigned f2bf(float f) { unsigned u = __builtin_bit_cast(unsigned, f); return (u + 0x7fffu + ((u >> 16) & 1u)) >> 16; }
__device__ __forceinline__ unsigned pk2(float lo, float hi) { return f2bf(lo) | (f2bf(hi) << 16); }
__device__ __forceinline__ float bflo(unsigned w) { return __builtin_bit_cast(float, w << 16); }
__device__ __forceinline__ float bfhi(unsigned w) { return __builtin_bit_cast(float, w & 0xffff0000u); }
__device__ __forceinline__ float wave_sum(float v) {
#pragma unroll
    for (int o = 1; o < 64; o <<= 1) v += __shfl_xor(v, o);
    return v;
}
typedef __attribute__((address_space(1))) unsigned gu32;
#define RLX_AGENT __ATOMIC_RELAXED, __HIP_MEMORY_SCOPE_AGENT
#define XB_TMO      128
#define XB_XCNT(j)  (256  + 64 * (j))
#define XB_XSUB(j)  (1280 + 64 * (j))
#define XB_XGEN(j)  (2304 + 64 * (j))
#define XB_TOP      3328
#define XB_TOPGEN   3392
#define XCD_BAR_WORDS 3456
#define XB_SPIN_CAP (1u << 18)

__device__ __forceinline__ unsigned xb_ld(unsigned* p)              { return __hip_atomic_load(p, __ATOMIC_RELAXED, __HIP_MEMORY_SCOPE_AGENT); }
__device__ __forceinline__ unsigned xb_add(unsigned* p, unsigned v) { return __hip_atomic_fetch_add(p, v, __ATOMIC_RELAXED, __HIP_MEMORY_SCOPE_AGENT); }
__device__ __forceinline__ unsigned xb_xcc_id() { return (unsigned)__builtin_amdgcn_s_getreg((3 << 11) | 20) & 0xFu; }
#define XB_SPIN(cond, bar) do { unsigned _sp = 0; while (cond) { __builtin_amdgcn_s_sleep(1); \
    if ((++_sp & 255u) == 0u) { if (xb_ld(&(bar)[XB_TMO])) break; if (_sp > XB_SPIN_CAP) { atomicAdd(&(bar)[XB_TMO], 1u); break; } } } } while (0)

struct XcdBarrier {
    unsigned* bar; unsigned x;
    volatile LAS unsigned* st;
};

__device__ __forceinline__ XcdBarrier xcd_barrier_post(unsigned* bar, volatile LAS unsigned* st) {
    XcdBarrier b; b.bar = bar; b.x = xb_xcc_id(); b.st = st;
    if (threadIdx.x == 0) (void)xb_add(&bar[XB_XCNT(b.x)], 1u);
    return b;
}
__device__ __forceinline__ void xcd_barrier_complete(unsigned* bar, unsigned x, unsigned& nloc, unsigned& nx) {
    const unsigned G = gridDim.x * gridDim.y * gridDim.z;
    unsigned sum, cnt, mine, sp = 0u;
    for (;;) {
        sum = 0u; cnt = 0u; mine = 0u;
#pragma unroll
        for (unsigned j = 0; j < 16; ++j) { const unsigned c = xb_ld(&bar[XB_XCNT(j)]); sum += c; cnt += (c > 0u) ? 1u : 0u; }
        if (sum == G) break;
        __builtin_amdgcn_s_sleep(1);
        if ((++sp & 255u) == 0u) { if (xb_ld(&bar[XB_TMO])) break; if (sp > XB_SPIN_CAP) { atomicAdd(&bar[XB_TMO], 1u); break; } }
    }
    mine = xb_ld(&bar[XB_XCNT(x)]);
    nloc = mine > 0u ? mine : 1u; nx = cnt > 0u ? cnt : 1u;
}

__device__ __forceinline__ void xcd_barrier(const XcdBarrier& b) {
    asm volatile("s_waitcnt vmcnt(0)" ::: "memory");
    __syncthreads();
    if (threadIdx.x == 0) {
        unsigned* bar = b.bar;
        __builtin_amdgcn_s_waitcnt(0);
        unsigned nloc = b.st[0], nx = b.st[1];
        if (nloc == 0u) { xcd_barrier_complete(bar, b.x, nloc, nx); b.st[0] = nloc; b.st[1] = nx; }
        const unsigned old = xb_add(&bar[XB_XSUB(b.x)], 1u);
        const unsigned gen = old / nloc;
        if (old + 1u == (gen + 1u) * nloc) {
#if defined(MK_LEADER_OVERLAP_INV)
            asm volatile("s_waitcnt vmcnt(0) lgkmcnt(0)\n\tbuffer_wbl2 sc1\n\tbuffer_inv sc1\n\ts_waitcnt vmcnt(0)" ::: "memory");
#else
            __builtin_amdgcn_fence(__ATOMIC_RELEASE, "agent");
            asm volatile("s_waitcnt vmcnt(0)" ::: "memory");
#endif
#if defined(MK_LEADER_EARLY_INV)
            __builtin_amdgcn_fence(__ATOMIC_ACQUIRE, "agent");
            asm volatile("s_waitcnt vmcnt(0)" ::: "memory");
#endif
            const unsigned og = xb_add(&bar[XB_TOP], 1u);
            if (og + 1u == (gen + 1u) * nx) xb_add(&bar[XB_TOPGEN], 1u);
            else XB_SPIN(xb_ld(&bar[XB_TOPGEN]) == gen, bar);
#if !defined(MK_LEADER_EARLY_INV) && !defined(MK_LEADER_OVERLAP_INV)
            __builtin_amdgcn_fence(__ATOMIC_ACQUIRE, "agent");
            asm volatile("s_waitcnt vmcnt(0)" ::: "memory");
#endif
            xb_add(&bar[XB_XGEN(b.x)], 1u);
        } else {
            __builtin_amdgcn_fence(__ATOMIC_ACQUIRE, "agent");
            asm volatile("s_waitcnt vmcnt(0)" ::: "memory");
            XB_SPIN(xb_ld(&bar[XB_XGEN(b.x)]) == gen, bar);
        }
        __builtin_amdgcn_fence(__ATOMIC_ACQUIRE, "workgroup");
    }
    __syncthreads();
}

struct Ctx { LAS unsigned char* lds; int tid, lane, wave, vcu, G; unsigned char* ws; const float* const* in; };
#define WSP(T, off) ((T*)(c.ws + (off)))
__device__ __forceinline__ int deal_item(int vcu, int G, int N, int k) {
    if (G == 256 && (N & 255) == 0) return (k < (N >> 8)) ? (vcu >> 5) * (N >> 3) + (vcu & 31) + 32 * k : -1;
    const int it = vcu + k * G; return it < N ? it : -1;
}
#define SBAR() do { asm volatile("" ::: "memory"); __builtin_amdgcn_s_barrier(); asm volatile("" ::: "memory"); } while (0)

struct Job { const float* W; const float* gain; bf16* WT; int ldw, c0, K, rmul, radd, kb, nb; };
__device__ __forceinline__ void job_load(const Job& j, float (&v)[32], int lane) {
    const float* src = j.W + (size_t)(64 * j.kb + (lane >> 5)) * j.ldw + j.c0 + 32 * j.nb + (lane & 31);
#pragma unroll
    for (int i = 0; i < 32; ++i) v[i] = __builtin_nontemporal_load(src + (size_t)(2 * i) * j.ldw);
}
__device__ __forceinline__ void job_finish(const Job& j, float (&v)[32], LAS float* scr, int lane) {
    const int k0 = 64 * j.kb, n0 = 32 * j.nb;
    if (j.gain) { const float* gp = j.gain + k0 + (lane >> 5);
#pragma unroll
        for (int i = 0; i < 32; ++i) v[i] *= gp[2 * i]; }
#pragma unroll
    for (int i = 0; i < 32; ++i) scr[(2 * i + (lane >> 5)) * 33 + (lane & 31)] = v[i];
    LDS_WAIT(); asm volatile("" ::: "memory");
    const int cc = lane & 7;
#pragma unroll
    for (int q = 0; q < 4; ++q) { const int n = (lane >> 3) + 8 * q; const LAS float* sp = scr + (8 * cc) * 33 + n;
        v4u o; o.x = pk2(sp[0 * 33], sp[1 * 33]); o.y = pk2(sp[2 * 33], sp[3 * 33]); o.z = pk2(sp[4 * 33], sp[5 * 33]); o.w = pk2(sp[6 * 33], sp[7 * 33]);
        const int nn = n0 + n, drow = (nn >> 7) * j.rmul + (nn & 127) + j.radd;
        __builtin_nontemporal_store(o, (v4u*)(j.WT + (size_t)drow * j.K + k0 + 8 * cc)); }
    LDS_WAIT(); asm volatile("" ::: "memory");
}
constexpr int IT_GU = (D / 64) * (F / 32), IT_SQ = (D / 64) * (D / 32), IT_POOL = (512 / 64) * (512 / 32);
static_assert((F / 64) * (D / 32) == IT_GU, "down-projection item count equals gate/up item count");
constexpr int L_COMMON = 6 * IT_GU, L_EVEN = L_COMMON + 3 * IT_SQ, L_ODD = L_COMMON + 4 * IT_POOL, KV_ITEMS = NL * 3 * IT_SQ;
__host__ __device__ constexpr int layer_items(int l) { return (l & 1) ? L_ODD : L_EVEN; }
__host__ __device__ constexpr int mixer_items(int l) { return (l & 1) ? 4 * IT_POOL : 3 * IT_SQ; }
__device__ __forceinline__ Job decode_job(const Ctx& c, int l, int r) {
    Job j; j.c0 = 0; j.rmul = 128; j.radd = 0; j.gain = nullptr; int nblk;
    if (l < 0) { const int ll = r / (3 * IT_SQ); r -= ll * 3 * IT_SQ; const int t = r / IT_SQ; r -= t * IT_SQ;
        j.W = c.in[25 + t] + (size_t)ll * D * D; j.ldw = D; j.K = D; nblk = D / 32;
        if (t < 2) { j.gain = c.in[23] + ll * D; j.WT = WSP(bf16, t ? WS_WV : WS_WK); j.radd = ll * D; } else j.WT = WSP(bf16, WS_WO + (size_t)ll * SZ_SQ); }
    else { int f = -1;
        if (r < 3 * IT_GU) f = 0; else { r -= 3 * IT_GU; const int mi = mixer_items(l);
            if (r < mi) {
                if ((l & 1) == 0) { const int e = l >> 1;
                    if (r < 2 * IT_SQ) { j.W = c.in[7] + (size_t)e * D * 4096; j.ldw = 4096; j.K = D; j.gain = c.in[6] + l * D; j.WT = WSP(bf16, WS_WIN + (size_t)e * 2 * SZ_SQ);
                        if (r < IT_SQ) { nblk = 64; }
                        else if (r < IT_SQ + IT_SQ / 2) { r -= IT_SQ; j.c0 = 2048; nblk = 32; j.rmul = 256; j.radd = 2048; }
                        else { r -= IT_SQ + IT_SQ / 2; j.c0 = 3072; nblk = 32; j.rmul = 256; j.radd = 2048 + 128; }
                    } else { r -= 2 * IT_SQ; j.W = c.in[17] + (size_t)e * 2048 * D; j.ldw = D; j.K = 2048; j.WT = WSP(bf16, WS_WOUT + (size_t)e * SZ_SQ); nblk = D / 32; }
                } else { const int o = l >> 1, g = r / IT_POOL; r -= g * IT_POOL; j.W = c.in[19] + (size_t)(o * 4 + g) * 512 * 512; j.ldw = 512; j.K = 512; j.WT = WSP(bf16, WS_WPOOL + (size_t)o * 2048 * 512 * 2); j.radd = g * 512; nblk = 16; }
            } else { r -= mi; f = 1; } }
        if (f >= 0) { const int t = r / IT_GU, base = f ? 28 : 2; r -= t * IT_GU;
            if (t < 2) { j.W = c.in[base + 1 + t] + (size_t)l * D * F; j.ldw = F; j.K = D; j.gain = c.in[base] + l * D; j.WT = WSP(bf16, WS_WGU + (size_t)(l * 2 + f) * SZ_WGU); j.rmul = 256; j.radd = t * 128; nblk = F / 32; }
            else { j.W = c.in[base + 3] + (size_t)l * F * D; j.ldw = D; j.K = F; j.WT = WSP(bf16, WS_WDN + (size_t)(l * 2 + f) * SZ_WDN); nblk = D / 32; } }
    }
    j.kb = r / nblk; j.nb = r - j.kb * nblk; return j;
}
template <int NI> __device__ __forceinline__ void convert_range(const Ctx& c, int l, int lo, int hi, int rank, int nranks) {
    LAS float* scr = (LAS float*)(c.lds + c.wave * 16384);
    const int step = nranks * NWAVES, lane = c.lane;
    for (int it = lo + rank * NWAVES + c.wave; it < hi; it += NI * step) {
        Job j[NI]; float v[NI][32];
#pragma unroll
        for (int q = 0; q < NI; ++q) if (it + q * step < hi) { j[q] = decode_job(c, l, it + q * step); job_load(j[q], v[q], lane); }
#pragma unroll
        for (int q = 0; q < NI; ++q) if (it + q * step < hi) job_finish(j[q], v[q], scr, lane);
    }
}
#ifndef MK_CONV_Q1
#define MK_CONV_Q1 26
#define MK_CONV_Q2 52
#endif
constexpr int NSCORE = 128;
constexpr int NGEMM_UP = 235;
__host__ __device__ constexpr int conv_cut(int l, int pct) { return (int)((long)layer_items(l) * pct / 100); }

__device__ __forceinline__ void p0_prologue(const Ctx& c) {
    const int gw = c.vcu * NWAVES + c.wave, NGW = c.G * NWAVES, lane = c.lane;
    convert_range<2>(c, -1, 0, KV_ITEMS, c.vcu, c.G);
    convert_range<2>(c, 0, 0, layer_items(0), c.vcu, c.G);
    for (int l = 1; l < NL; ++l) convert_range<2>(c, l, conv_cut(l, MK_CONV_Q2), layer_items(l), c.vcu, c.G);
    { const float* x = c.in[0]; bf16* XH = WSP(bf16, WS_X); bf16* XB = WSP(bf16, WS_XB); float* ssq = WSP(float, WS_SSQ);
      for (int m = gw; m < M; m += NGW) { const f32x4* xr = (const f32x4*)(x + (size_t)m * D) + lane; u32x2* xh = (u32x2*)(XH + (size_t)m * D) + lane; u32x2* xb = (u32x2*)(XB + (size_t)m * D) + lane; float s = 0.f;
#pragma unroll
          for (int j = 0; j < 8; ++j) { const f32x4 v = xr[64 * j]; u32x2 w; w.x = pk2(v[0], v[1]); w.y = pk2(v[2], v[3]); xb[64 * j] = w;
              if (MK_RESID_BF16) { const float r0 = bflo(w.x), r1 = bfhi(w.x), r2 = bflo(w.y), r3 = bfhi(w.y); s += (r0 * r0 + r1 * r1) + (r2 * r2 + r3 * r3); }
              else { u32x2 wh; wh.x = pg8::cvt_pk_h16(v[0], v[1]); wh.y = pg8::cvt_pk_h16(v[2], v[3]); xh[64 * j] = wh; s += (v[0] * v[0] + v[1] * v[1]) + (v[2] * v[2] + v[3] * v[3]); } }
          s = wave_sum(s);
          if (lane < 8) ssq[(size_t)m * 8 + lane] = lane == 0 ? s : 0.f; } }
    { const float* x = c.in[1]; bf16* XB = WSP(bf16, WS_MEMB); float* rm = WSP(float, WS_RMEM);
      for (int m = gw; m < MM; m += NGW) { const f32x4* xr = (const f32x4*)(x + (size_t)m * D) + lane; f32x4 v[8]; float s = 0.f;
#pragma unroll
          for (int j = 0; j < 8; ++j) { v[j] = xr[64 * j]; s += (v[j][0] * v[j][0] + v[j][1] * v[j][1]) + (v[j][2] * v[j][2] + v[j][3] * v[j][3]); }
          s = wave_sum(s);
          u32x2* xb = (u32x2*)(XB + (size_t)m * D) + lane;
#pragma unroll
          for (int j = 0; j < 8; ++j) { u32x2 w; w.x = pk2(v[j][0], v[j][1]); w.y = pk2(v[j][2], v[j][3]); xb[64 * j] = w; }
          if (lane == 0) rm[m] = __builtin_amdgcn_rsqf(s * (1.0f / D) + EPS); } }
    { const float* wq = c.in[24]; const float* gq = c.in[22]; bf16* o = WSP(bf16, WS_WQ);
      for (int m = gw; m < NL * D; m += NGW) { const f32x4* xr = (const f32x4*)(wq + (size_t)m * D) + lane; u32x2* xb = (u32x2*)(o + (size_t)m * D) + lane; const float g = gq[m];
#pragma unroll
          for (int j = 0; j < 8; ++j) { const f32x4 v = __builtin_nontemporal_load(xr + 64 * j) * g; u32x2 w; w.x = pk2(v[0], v[1]); w.y = pk2(v[2], v[3]); xb[64 * j] = w; } } }
    { const float* ws = c.in[9]; bf16* o = WSP(bf16, WS_WSG);
      for (int i = gw * 64 + lane; i < 2 * 8 * 128 * 128; i += NGW * 64) { const int q = i & 127, p = (i >> 7) & 127; o[i] = (bf16)f2bf(((q >> 6) <= (p >> 6)) ? ws[i] : 0.f); } }
}

template <int WIN> __device__ __forceinline__ void pool_rows(const bf16* X, int row0, int t0, int ch, f32x4 gv, const LAS float* rsl, bf16* DD) {
    f32x4 hv[31];
#pragma unroll
    for (int r = 16 - WIN; r < 31; ++r) { const float rr = rsl[r]; f32x4 xv = (f32x4){0.f, 0.f, 0.f, 0.f}; if (t0 - 15 + r >= 0) { const u32x2 q = *(const u32x2*)(X + (size_t)(row0 - 15 + r) * D + ch); xv = MK_RESID_BF16 ? (f32x4){bflo(q.x), bfhi(q.x), bflo(q.y), bfhi(q.y)} : (f32x4){pg8::h_lo(q.x), pg8::h_hi(q.x), pg8::h_lo(q.y), pg8::h_hi(q.y)}; } hv[r] = xv * rr * gv; }
#pragma unroll
    for (int t = 0; t < 16; ++t) { f32x4 s = hv[15 + t];
#pragma unroll
        for (int i = 1; i < WIN; ++i) s += hv[15 + t - i];
        const int n = (t0 + t + 1 < WIN) ? t0 + t + 1 : WIN; const float inv = 1.0f / (float)n;
        const f32x4 d = s * inv - hv[15 + t];
        u32x2 w; w.x = pk2(d[0], d[1]); w.y = pk2(d[2], d[3]); *(u32x2*)(DD + (size_t)(row0 + t) * D + ch) = w; }
}
__device__ __forceinline__ void pool_phase(const Ctx& c, const float* gain  ) {
    const bf16* X = WSP(bf16, MK_RESID_BF16 ? WS_XB : WS_X); const float* ssq = WSP(float, WS_SSQ); bf16* DD = WSP(bf16, WS_DD);
    LAS float* rsl = (LAS float*)c.lds;
    const int ch = 4 * c.tid; const f32x4 gv = *(const f32x4*)(gain + ch);
    for (int k0 = 0; deal_item(c.vcu, c.G, M / 16, k0) >= 0; k0 += 4) {
        { const int q = c.tid >> 6, t = c.tid & 63, it = deal_item(c.vcu, c.G, M / 16, k0 + (q & 3));
          if (q < 4 && it >= 0) { const int row0 = it * 16, t0 = row0 & (S - 1), r = t >> 1, part = t & 1; const bool valid = (r < 31) && (t0 - 15 + r >= 0); float s = 0.f;
              if (valid) { const f32x4 a = *(const f32x4*)(ssq + (size_t)(row0 - 15 + r) * 8 + part * 4); s = (a[0] + a[1]) + (a[2] + a[3]); }
              s += __shfl_xor(s, 1);
              if (part == 0 && r < 31) rsl[q * 32 + r] = valid ? __builtin_amdgcn_rsqf(s * (1.0f / D) + EPS) : 0.f; } }
        LDS_WAIT(); __syncthreads();
        for (int kk = 0, it; kk < 4 && (it = deal_item(c.vcu, c.G, M / 16, k0 + kk)) >= 0; ++kk) { const int row0 = it * 16, t0 = row0 & (S - 1); const LAS float* rs = rsl + kk * 32;
            switch (c.wave >> 1) { case 0: pool_rows<2>(X, row0, t0, ch, gv, rs, DD); break; case 1: pool_rows<4>(X, row0, t0, ch, gv, rs, DD); break;
                                   case 2: pool_rows<8>(X, row0, t0, ch, gv, rs, DD); break; default: pool_rows<16>(X, row0, t0, ch, gv, rs, DD); break; } }
        __syncthreads(); }
}

__device__ __forceinline__ void gate_item(const Ctx& c, int idx, int e, const bf16* U, const bf16* V, const float* lnp, const bf16* WSG, const float* bs, const float* lng, const float* lnb, bf16* YC) {
    LAS unsigned char* vnT = c.lds;
    LAS f32x2* st = (LAS f32x2*)(c.lds + 36864);
    const int h = idx & 7, row0 = (idx >> 3) * 128, lane = c.lane, fr = lane & 15, fq = lane >> 4, w = c.wave;
    if (c.tid < 128) { const f32x4* p = (const f32x4*)(lnp + (size_t)(row0 + c.tid) * 32); float s1 = 0.f, s2 = 0.f;
#pragma unroll
        for (int j = 0; j < 8; ++j) { const f32x4 a = p[j]; s1 += a[0] + a[2]; s2 += a[1] + a[3]; }
        const float mu = s1 * (1.0f / 1024.f), var = fmaxf(s2 * (1.0f / 1024.f) - mu * mu, 0.f);
        st[c.tid] = (f32x2){mu, __builtin_amdgcn_rsqf(var + EPS)}; }
    LDS_WAIT(); __syncthreads();
#pragma unroll
    for (int i = 0; i < 4; ++i) { const int j = c.tid + 512 * i, q = j >> 4, cc = (j & 15) * 8;
        const v4u raw = *(const v4u*)(V + (size_t)(row0 + q) * 1024 + h * 128 + cc); const f32x2 ms = st[q];
        const f32x4 g0 = *(const f32x4*)(lng + h * 128 + cc), g1 = *(const f32x4*)(lng + h * 128 + cc + 4), b0 = *(const f32x4*)(lnb + h * 128 + cc), b1 = *(const f32x4*)(lnb + h * 128 + cc + 4);
        const float v[8] = {bflo(raw.x), bfhi(raw.x), bflo(raw.y), bfhi(raw.y), bflo(raw.z), bfhi(raw.z), bflo(raw.w), bfhi(raw.w)};
        const float g[8] = {g0[0], g0[1], g0[2], g0[3], g1[0], g1[1], g1[2], g1[3]}, bb[8] = {b0[0], b0[1], b0[2], b0[3], b1[0], b1[1], b1[2], b1[3]};
#pragma unroll
        for (int k = 0; k < 8; ++k) *(LAS unsigned short*)(vnT + ((cc + k) * 136 + q) * 2) = (unsigned short)f2bf((v[k] - ms.x) * ms.y * g[k] + bb[k]); }
    LDS_WAIT(); __syncthreads();
    bf16x8 Af[4]; const bf16* wrow = WSG + ((size_t)(e * 8 + h) * 128 + 16 * w + fr) * 128 + 8 * fq;
#pragma unroll
    for (int ks = 0; ks < 4; ++ks) Af[ks] = *(const bf16x8*)(wrow + 32 * ks);
    const float bsv = bs[(e * 8 + h) * 128 + 16 * w + fr]; const size_t orow = (size_t)(row0 + 16 * w + fr);
#pragma unroll
    for (int cb = 0; cb < 8; ++cb) { f32x4 acc = (f32x4){0.f, 0.f, 0.f, 0.f};
#pragma unroll
        for (int ks = 0; ks < 4; ++ks) { const bf16x8 Bf = *(const LAS bf16x8*)(vnT + ((16 * cb + fr) * 136 + 32 * ks + 8 * fq) * 2); acc = __builtin_amdgcn_mfma_f32_16x16x32_bf16(Bf, Af[ks], acc, 0, 0, 0); }
        const u32x2 uu = *(const u32x2*)(U + orow * 1024 + h * 128 + 16 * cb + 4 * fq);
        u32x2 o; o.x = pk2(bflo(uu.x) * (acc[0] + bsv), bfhi(uu.x) * (acc[1] + bsv)); o.y = pk2(bflo(uu.y) * (acc[2] + bsv), bfhi(uu.y) * (acc[3] + bsv));
        *(u32x2*)(YC + orow * 2048 + h * 128 + 16 * cb + 4 * fq) = o; }
    __syncthreads();
}
__device__ __forceinline__ void mix_phase(const Ctx& c, int e) {
    const bf16* U = WSP(bf16, WS_U); const bf16* V = WSP(bf16, WS_V); const bf16* HB = WSP(bf16, WS_HB); bf16* YC = WSP(bf16, WS_YC); const float* lnp = WSP(float, WS_LNP);
#ifndef MK_MIXREP_G
#define MK_MIXREP_G 1
#define MK_MIXREP_C 1
#endif
    for (int rep = 0; rep < MK_MIXREP_G; ++rep)
    for (int k = 0, it; (it = deal_item(c.vcu, c.G, 512, k)) >= 0; ++k) gate_item(c, it, e, U, V, lnp, WSP(bf16, WS_WSG), c.in[10], c.in[11] + e * 1024, c.in[12] + e * 1024, YC);
    { const int ch = 2 * c.tid; const float* cw = c.in[13] + (size_t)e * 31 * 1024 + ch; LAS f32x2* red = (LAS f32x2*)(c.lds + 40960);
      f32x2 wv[31];
#pragma unroll
      for (int j = 0; j < 31; ++j) wv[j] = *(const f32x2*)(cw + j * 1024);
      const f32x2 cbv = *(const f32x2*)(c.in[14] + e * 1024 + ch), gv = *(const f32x2*)(c.in[15] + e * 1024 + ch), bv = *(const f32x2*)(c.in[16] + e * 1024 + ch);
      for (int rep = 0; rep < MK_MIXREP_C; ++rep)
      for (int k = 0, it; (it = deal_item(c.vcu, c.G, M / 16, k)) >= 0; ++k) { const int r0 = it * 16, t0 = r0 & (S - 1);
          unsigned hw[46];
#pragma unroll
          for (int i = 0; i < 46; ++i) { unsigned raw = 0u; if (t0 - 30 + i >= 0) raw = *(const unsigned*)(HB + (size_t)(r0 - 30 + i) * 1024 + ch); hw[i] = raw; }
          f32x2 o[16];
#pragma unroll
          for (int r = 0; r < 16; ++r) { o[r] = cbv;
#pragma unroll
              for (int j = 0; j < 31; ++j) o[r] += (f32x2){bflo(hw[r + j]), bfhi(hw[r + j])} * wv[j]; }
#pragma unroll
          for (int r = 0; r < 16; ++r) { const float s1 = wave_sum(o[r][0] + o[r][1]), s2 = wave_sum(o[r][0] * o[r][0] + o[r][1] * o[r][1]); if (c.lane == 0) red[c.wave * 16 + r] = (f32x2){s1, s2}; }
          LDS_WAIT(); __syncthreads();
#pragma unroll
          for (int r = 0; r < 16; ++r) { float s1 = 0.f, s2 = 0.f;
#pragma unroll
              for (int w = 0; w < 8; ++w) { const f32x2 p = red[w * 16 + r]; s1 += p[0]; s2 += p[1]; }
              const float mu = s1 * (1.0f / 1024.f), var = fmaxf(s2 * (1.0f / 1024.f) - mu * mu, 0.f), rs = __builtin_amdgcn_rsqf(var + EPS);
              const float y0 = (o[r][0] - mu) * rs * gv[0] + bv[0], y1 = (o[r][1] - mu) * rs * gv[1] + bv[1];
              *(unsigned*)(YC + (size_t)(r0 + r) * 2048 + 1024 + ch) = pk2(pg8::fast_silu(y0), pg8::fast_silu(y1)); }
          __syncthreads(); } }
}


__device__ __forceinline__ void final_phase(const Ctx& c, float* out) {
    const bf16* X = WSP(bf16, MK_RESID_BF16 ? WS_XB : WS_X); const float* ssq = WSP(float, WS_SSQ); const float* g = c.in[32];
    const int gw = c.vcu * NWAVES + c.wave, NGW = c.G * NWAVES, lane = c.lane;
    f32x4 gv[8];
#pragma unroll
    for (int j = 0; j < 8; ++j) gv[j] = ((const f32x4*)g)[lane + 64 * j];
    for (int k = 0, m; (m = deal_item(gw, NGW, M, k)) >= 0; ++k) { float s = 0.f; if (lane < 2) { const f32x4 a = ((const f32x4*)(ssq + (size_t)m * 8))[lane]; s = (a[0] + a[1]) + (a[2] + a[3]); }
        const float rs = __builtin_amdgcn_rsqf(wave_sum(s) * (1.0f / D) + EPS);
        const u32x2* xr = (const u32x2*)(X + (size_t)m * D) + lane; f32x4* o = (f32x4*)(out + (size_t)m * D) + lane;
#pragma unroll
        for (int j = 0; j < 8; ++j) { const u32x2 q = xr[64 * j]; o[64 * j] = (MK_RESID_BF16 ? (f32x4){bflo(q.x), bfhi(q.x), bflo(q.y), bfhi(q.y)} : (f32x4){pg8::h_lo(q.x), pg8::h_hi(q.x), pg8::h_lo(q.y), pg8::h_hi(q.y)}) * rs * gv[j]; } }
}

struct Args { const float* in[33]; float* out; unsigned char* ws; int s_lo, s_hi, flags, bar_region; };
__global__ void __launch_bounds__(NTHREADS, 2) mega(Args a) {
    extern __shared__ __attribute__((aligned(16))) unsigned char lds_raw[];
    Ctx c; c.lds = (LAS unsigned char*)lds_raw; c.tid = threadIdx.x; c.lane = c.tid & 63; c.wave = __builtin_amdgcn_readfirstlane(c.tid >> 6);
    c.G = gridDim.x; { const int bx = blockIdx.x; c.vcu = (c.G % 8 == 0) ? (bx % 8) * (c.G / 8) + bx / 8 : bx; }
    c.ws = a.ws; c.in = a.in; const int vcu0 = c.vcu;
    volatile LAS unsigned* MISC = (volatile LAS unsigned*)(c.lds + MISC_OFF);
    for (int u = c.tid; u < (LDS_BYTES - LDSCTL_OFF) / 4; u += NTHREADS) ((LAS unsigned*)(c.lds + LDSCTL_OFF))[u] = 0u;
    __syncthreads();
    XcdBarrier bar = xcd_barrier_post((unsigned*)(c.ws + WS_CTL) + a.bar_region * XCD_BAR_WORDS, MISC + 8);
#if defined(MK_BAR_TWICE)
#define GRID_BAR() do { xcd_barrier(bar); xcd_barrier(bar); } while (0)
#else
#define GRID_BAR() xcd_barrier(bar)
#endif
#ifndef MK_REPEAT
#define MK_REPEAT -1
#endif
#define REPS(type) ((MK_REPEAT == (type)) ? 2 : 1)
    const int bx = blockIdx.x;
    PG8_LAS float* lds_red = (PG8_LAS float*)(c.lds + pg8::LDS_RED_OFF);
    bf16* XB = WSP(bf16, WS_XB); float* ssq = WSP(float, WS_SSQ);

#define RLOOP(type) for (int rp = 0; rp < REPS(type); ++rp)
#ifndef MK_FUSE_FINAL
#define MK_FUSE_FINAL 1
#endif
    bool fused_final = false;
    if (a.flags & 1) {
        RLOOP(0) { p0_prologue(c); GRID_BAR(); }
        RLOOP(1) { pg8::Gemm g{WSP(bf16, WS_MEMB), WSP(bf16, WS_WK), D, D, D, 0}; pg8::ListOrder so{0, 256, c.G, bx, 4, 0}; pg8::EpiKV E{WSP(bf16, WS_KB), WSP(bf16, WS_VT), WSP(float, WS_RMEM)};
          pg8::gemm_phase(c.lds, g, so, E); GRID_BAR(); }
        { pg8::Gemm g{(const bf16*)c.ws, (const bf16*)c.ws, D, D, 512, 0}; pg8::PreOrder so{c.G, bx, 0, (c.G > NSCORE) ? 1 : NL, (int)(WS_WO / 2), (int)(WS_VT / 2), (int)(WS_KB / 2), (int)(WS_WQ / 2)}; pg8::EpiPre E{WSP(bf16, WS_VW), WSP(bf16, WS_KW)};
          pg8::gemm_phase(c.lds, g, so, E);
        }
    }
    for (int it = 0; it <= NL; ++it) {
        const int l = it - 1;
        { int t = threadIdx.x, vc = vcu0, gg = gridDim.x; size_t z = 0; asm volatile("" : "+v"(t), "+s"(z), "+s"(vc), "+s"(gg));
          c.tid = t; c.lane = t & 63; c.wave = __builtin_amdgcn_readfirstlane(t >> 6); c.ws = a.ws + z; c.vcu = vc; c.G = gg;
          XB = WSP(bf16, WS_XB); ssq = WSP(float, WS_SSQ); }
        if (it > 0 && 4 * l + 1 >= a.s_lo && 4 * l + 1 < a.s_hi) {
            if ((l & 1) == 0) { const int e = l >> 1;
                RLOOP(4) { pg8::Gemm g{XB, WSP(bf16, WS_WIN + (size_t)e * 2 * SZ_SQ), D, D, D, 0}; pg8::StaticOrder so; so.init(M, 4096, c.G, bx);
                  pg8::EpiWin E{WSP(bf16, WS_U), WSP(bf16, WS_V), WSP(bf16, WS_HB), WSP(float, WS_LNP), pg8::RstdLds{ssq, c.lds}, c.in[8] + e * 4096};
                  pg8::gemm_phase(c.lds, g, so, E); GRID_BAR(); }
                RLOOP(5) { mix_phase(c, e); GRID_BAR(); }
                RLOOP(6) { pg8::Gemm g{WSP(bf16, WS_YC), WSP(bf16, WS_WOUT + (size_t)e * SZ_SQ), D, D, D, 0}; pg8::StaticOrder so; so.init(M, D, c.G, bx);
                  pg8::EpiResid<true, false> E{WSP(bf16, WS_X), XB, ssq, c.in[18] + e * D, nullptr, rp ? 0.0f : 1.0f, lds_red};
                  pg8::gemm_phase(c.lds, g, so, E); GRID_BAR(); }
            } else { const int o = l >> 1;
                RLOOP(7) { pool_phase(c, c.in[6] + l * D); GRID_BAR(); }
                RLOOP(8) { pg8::Gemm g{WSP(bf16, WS_DD), WSP(bf16, WS_WPOOL + (size_t)o * 2048 * 512 * 2), D, 512, 512, 512}; pg8::StaticOrder so; so.init(M, D, c.G, bx);
                  pg8::EpiResid<true, true> E{WSP(bf16, WS_X), XB, ssq, c.in[20] + o * D, c.in[21] + o * D, rp ? 0.0f : 1.0f, lds_red};
                  pg8::gemm_phase(c.lds, g, so, E); GRID_BAR(); }
            }
        }
        if (it > 0 && 4 * l + 2 >= a.s_lo && 4 * l + 2 < a.s_hi) {
            RLOOP(9) { pg8::Gemm g{XB, WSP(bf16, WS_KW + (size_t)l * NB * 1024 * D * 2), D, D, D, 0}; pg8::BatchBOrder so; so.init(M, 1024, c.G, bx); so.bstride = 1024 * D;
              pg8::EpiSoftmax E{WSP(bf16, WS_P), pg8::RstdLds{ssq, c.lds}, QSCALE, lds_red, (PG8_LAS float*)(c.lds + LDS_RED2_OFF)};
              pg8::gemm_phase(c.lds, g, so, E);
              if (c.G > NSCORE && bx >= NSCORE && l + 1 < NL && rp == 0) {
                  pg8::Gemm g2{(const bf16*)c.ws, (const bf16*)c.ws, D, D, 512, 0}; pg8::PreOrder so2{c.G - NSCORE, bx - NSCORE, l + 1, 1, (int)(WS_WO / 2), (int)(WS_VT / 2), (int)(WS_KB / 2), (int)(WS_WQ / 2)}; pg8::EpiPre E2{WSP(bf16, WS_VW), WSP(bf16, WS_KW)};
                  pg8::gemm_phase(c.lds, g2, so2, E2); }
              GRID_BAR(); }
            RLOOP(11) { pg8::Gemm g{WSP(bf16, WS_P), WSP(bf16, WS_VW + (size_t)l * NB * D * 1024 * 2), 1024, 1024, 1024, 0}; pg8::BatchBOrder so; so.init(M, D, c.G, bx); so.bstride = D * 1024;
              pg8::EpiResid<false, false> E{WSP(bf16, WS_X), XB, ssq, nullptr, nullptr, rp ? 0.0f : 1.0f, lds_red};
              pg8::gemm_phase(c.lds, g, so, E); GRID_BAR(); }
        }
        for (int j = 0; j < 2; ++j) {
            const int s = (j == 0) ? 4 * l + 3 : 4 * it, ll = (j == 0) ? l : it;
            if ((j == 0 && it == 0) || (j == 1 && it == NL) || s < a.s_lo || s >= a.s_hi) continue;
            RLOOP(2) { const int ngemm = (c.G > NGEMM_UP) ? NGEMM_UP : c.G;
              if (bx < ngemm) { pg8::Gemm g{XB, WSP(bf16, WS_WGU + (size_t)(ll * 2 + (1 - j)) * SZ_WGU), D, D, D, 0}; pg8::StaticOrder so; so.init(M, 2 * F, ngemm, bx);
                pg8::EpiSwiglu E{WSP(bf16, WS_HID), F, pg8::RstdLds{ssq, c.lds}};
                pg8::gemm_phase(c.lds, g, so, E); }
              if (ll + 1 < NL && rp == 0) { const int nl = ll + 1, nsp = c.G - ngemm, lo = (j == 1) ? 0 : conv_cut(nl, MK_CONV_Q1), hi = (j == 1) ? conv_cut(nl, MK_CONV_Q1) : conv_cut(nl, MK_CONV_Q2);
                  if (nsp > 0) { if (bx >= ngemm) convert_range<2>(c, nl, lo, hi, bx - ngemm, nsp); }
                  else convert_range<2>(c, nl, lo, hi, c.vcu, c.G); }
              GRID_BAR(); }
#if defined(MK_PROBE_CHEAP)
            { pg8::Gemm g{XB, WSP(bf16, WS_WGU + (size_t)(ll * 2 + (1 - j)) * SZ_WGU), D, D, D, 0}; pg8::StaticOrder so; so.init(M, 2 * F, c.G, bx);
              pg8::EpiQ E{WSP(bf16, WS_END + 4096), pg8::RstdLds{ssq, c.lds}, 1.0f};
              pg8::gemm_phase(c.lds, g, so, E); GRID_BAR(); }
#endif
#if defined(MK_PROBE_SHORT)
            { pg8::Gemm g{XB, WSP(bf16, WS_WGU + (size_t)(ll * 2 + (1 - j)) * SZ_WGU), D, D, 256, 0}; pg8::StaticOrder so; so.init(M, D, c.G, bx);
              pg8::EpiNone E{};
              pg8::gemm_phase(c.lds, g, so, E); GRID_BAR(); }
#endif
#if defined(MK_PROBE_HOTB)
            { struct HotB : pg8::StaticOrder { __device__ bool next(int i, pg8::Unit& u) const { const bool ok = pg8::StaticOrder::next(i, u); u.pn = 0; return ok; } };
              pg8::Gemm g{XB, WSP(bf16, WS_WGU + (size_t)(ll * 2 + (1 - j)) * SZ_WGU), D, D, D, 0}; HotB so; so.init(M, 2 * F, c.G, bx);
              pg8::EpiNone E{};
              pg8::gemm_phase(c.lds, g, so, E); GRID_BAR(); }
#endif
#if defined(MK_PROBE_HOTAB)
            { struct HotAB : pg8::StaticOrder { __device__ bool next(int i, pg8::Unit& u) const { const bool ok = pg8::StaticOrder::next(i, u); u.pn = 0; u.pm = 0; return ok; } };
              pg8::Gemm g{XB, WSP(bf16, WS_WGU + (size_t)(ll * 2 + (1 - j)) * SZ_WGU), D, D, D, 0}; HotAB so; so.init(M, 2 * F, c.G, bx);
              pg8::EpiNone E{};
              pg8::gemm_phase(c.lds, g, so, E); GRID_BAR(); }
#endif
#if defined(MK_PROBE_COLDB)
            { pg8::Gemm g{XB, (const bf16*)c.in[j ? 3 : 29] + (size_t)ll * D * F * 2, D, D, D, 0}; pg8::StaticOrder so; so.init(M, 2 * F, c.G, bx);
              pg8::EpiNone E{};
              pg8::gemm_phase(c.lds, g, so, E); GRID_BAR(); }
#endif
#if defined(MK_PROBE_ZERO)
            { const bf16* zz = WSP(bf16, WS_CTL + 512 * 1024);
              pg8::Gemm g{zz, zz, 0, 0, D, 0}; pg8::StaticOrder so; so.init(M, 2 * F, c.G, bx);
              pg8::EpiNone E{};
              pg8::gemm_phase(c.lds, g, so, E); GRID_BAR(); }
#endif
#if defined(MK_PROBE_NONE)
            { pg8::Gemm g{XB, WSP(bf16, WS_WGU + (size_t)(ll * 2 + (1 - j)) * SZ_WGU), D, D, D, 0}; pg8::StaticOrder so; so.init(M, 2 * F, c.G, bx);
              pg8::EpiNone E{};
              pg8::gemm_phase(c.lds, g, so, E); GRID_BAR(); }
#endif
            RLOOP(3) { pg8::Gemm g{WSP(bf16, WS_HID), WSP(bf16, WS_WDN + (size_t)(ll * 2 + (1 - j)) * SZ_WDN), F, F, F, 0}; pg8::StaticOrder so; so.init(M, D, c.G, bx);
              if (MK_FUSE_FINAL && s == 4 * NL - 1 && (a.flags & 2) && c.G >= (M / 256) * (D / 256) && rp == REPS(3) - 1) {
                  pg8::EpiResidFinal E{XB, ssq, 0.5f, lds_red, (PG8_LAS float*)(c.lds + pg8::LDS_RSL_OFF), a.out, c.in[32], (unsigned*)(c.ws + WS_CTL + 768 * 1024), (unsigned*)(c.ws + WS_CTL) + a.bar_region * XCD_BAR_WORDS + XB_TMO};
                  pg8::gemm_phase(c.lds, g, so, E); fused_final = true; }
              else { pg8::EpiResid<false, false> E{WSP(bf16, WS_X), XB, ssq, nullptr, nullptr, rp ? 0.0f : 0.5f, lds_red};
                  pg8::gemm_phase(c.lds, g, so, E); GRID_BAR(); } }
        }
    }
    if ((a.flags & 2) && !fused_final) final_phase(c, a.out);
}
}
#ifndef MK_DEBUG
#define MK_DEBUG 0
#endif
#if MK_DEBUG
__global__ void k_bf16_to_f32(const unsigned short* a, float* o, size_t n) {
    for (size_t i = (size_t)blockIdx.x * blockDim.x + threadIdx.x; i < n; i += (size_t)gridDim.x * blockDim.x) o[i] = __uint_as_float(((unsigned)a[i]) << 16);
}
__global__ void k_cmp(const unsigned short* a, const float* ref, size_t n, double* acc) {
    double d = 0.0, r = 0.0;
    for (size_t i = (size_t)blockIdx.x * blockDim.x + threadIdx.x; i < n; i += (size_t)gridDim.x * blockDim.x) { const double x = __uint_as_float(((unsigned)a[i]) << 16), y = ref[i]; d += (x - y) * (x - y); r += y * y; }
    for (int o = 32; o >= 1; o >>= 1) { d += __shfl_xor(d, o); r += __shfl_xor(r, o); }
    if ((threadIdx.x & 63) == 0) { atomicAdd(acc, d); atomicAdd(acc + 1, r); }
}
__global__ void k_cmp_attn(const unsigned short* mine, const float* ref, int which, double* acc) {
    double d = 0.0, r = 0.0; const size_t n = (which == 1 || which == 2) ? (size_t)mk::MM * mk::D : (size_t)mk::M * mk::D;
    for (size_t i = (size_t)blockIdx.x * blockDim.x + threadIdx.x; i < n; i += (size_t)gridDim.x * blockDim.x) {
        const size_t row = i / mk::D, col = i % mk::D; size_t mi = i; double sc = 1.0;
        if (which == 0) sc = 1.0 / (double)mk::QSCALE;
        double y = ref[i];
        if (which == 4) { const size_t b = row / mk::S; y = 0.0; for (int k = 0; k < 256; ++k) y += ref[(b * 256 + k) * mk::D + col]; y *= (1.0 / 256.0); }
        const double x = (double)__uint_as_float(((unsigned)mine[mi]) << 16) * sc; d += (x - y) * (x - y); r += y * y; }
    for (int o = 32; o >= 1; o >>= 1) { d += __shfl_xor(d, o); r += __shfl_xor(r, o); }
    if ((threadIdx.x & 63) == 0) { atomicAdd(acc, d); atomicAdd(acc + 1, r); }
}
__global__ void k_frac(const unsigned short* mine, const float* ref, int mode, int wsel, double* acc) {
    double m = 0.0, t = 0.0; const size_t n = (size_t)mk::M * mk::D;
    for (size_t i = (size_t)blockIdx.x * blockDim.x + threadIdx.x; i < n; i += (size_t)gridDim.x * blockDim.x) { const size_t row = i / mk::D, col = i % mk::D;
        if (wsel >= 0 && (int)((row % 128) / 16) != wsel) continue;
        double y = (mode == 3) ? ref[((row / mk::S) * 256) * mk::D + col] : ref[(mode == 1) ? 0 : i]; if (mode == 1) { const size_t b = row / mk::S; y = 0.0; for (int k = 0; k < 256; ++k) y += ref[(b * 256 + k) * mk::D + col]; y *= (1.0 / 256.0); }
        double x = (double)__uint_as_float(((unsigned)mine[i]) << 16); if (mode == 2) x *= 1.0 / (double)mk::QSCALE; t += 1.0; if (fabs(x - y) <= 0.02 * fabs(y) + 1e-3) m += 1.0; }
    for (int o = 32; o >= 1; o >>= 1) { m += __shfl_xor(m, o); t += __shfl_xor(t, o); }
    if ((threadIdx.x & 63) == 0) { atomicAdd(acc, m); atomicAdd(acc + 1, t); }
}
__global__ void k_verdict3(const double* acc, float* out, size_t n) {
    const float c1 = 2.0f + floorf((float)(10.0 * acc[0] / acc[1])), c2 = 2.0f + floorf((float)(10.0 * acc[2] / acc[3]));
    for (size_t i = (size_t)blockIdx.x * blockDim.x + threadIdx.x; i < n; i += (size_t)gridDim.x * blockDim.x) out[i] = (i < n / 2) ? c1 : c2;
}
__global__ void k_verdict2(const double* acc, int lo, int hi, int code0, float* out, size_t n, double thr) {
    int code = 0; for (int s = lo; s < hi; ++s) if (!(acc[2 * s] <= thr * acc[2 * s + 1])) { code = code0 + (s - lo); break; }
    if (code) for (size_t i = (size_t)blockIdx.x * blockDim.x + threadIdx.x; i < n; i += (size_t)gridDim.x * blockDim.x) out[i] = (float)code;
}
__global__ void k_verdict(const double* acc, int ns, float* out, size_t n, double thr) {
    int code = 0; for (int s = 0; s < ns; ++s) if (!(acc[2 * s] <= thr * acc[2 * s + 1])) { code = s + 1; break; }
    if (code) for (size_t i = (size_t)blockIdx.x * blockDim.x + threadIdx.x; i < n; i += (size_t)gridDim.x * blockDim.x) out[i] = (float)code;
}
#endif
extern "C" void kernel_launch(void* const* d_in, const int* in_sizes, int n_in, void* d_out, int out_size, void* d_ws, size_t ws_size, hipStream_t stream) {
    using namespace mk;
    static int grid = 0;
    if (grid == 0) {
        if (n_in != 33 || out_size != M * D || ws_size < WS_END) { fprintf(stderr, "kernel_launch: unexpected problem (n_in %d, out %d, ws %zu < %zu); nothing launched\n", n_in, out_size, ws_size, (size_t)WS_END); grid = -1; return; }
        int dev = 0, cus = 0, per_cu = 0;
        if (hipGetDevice(&dev) != hipSuccess || hipDeviceGetAttribute(&cus, hipDeviceAttributeMultiprocessorCount, dev) != hipSuccess) { grid = -1; return; }
        if (hipFuncSetAttribute((const void*)mega, hipFuncAttributeMaxDynamicSharedMemorySize, LDS_BYTES) != hipSuccess) { fprintf(stderr, "kernel_launch: hipFuncSetAttribute failed\n"); grid = -1; return; }
        if (hipOccupancyMaxActiveBlocksPerMultiprocessor(&per_cu, (const void*)mega, NTHREADS, LDS_BYTES) != hipSuccess || per_cu < 1) fprintf(stderr, "kernel_launch: occupancy query reports %d workgroups per CU\n", per_cu);
        (void)hipGetLastError();
        grid = cus;
    }
    if (grid < 0) return;
    (void)hipMemsetAsync((char*)d_ws + WS_CTL, 0, CTL_BYTES, stream);
    Args a{};
    for (int i = 0; i < 33; ++i) a.in[i] = (const float*)d_in[i];
    a.out = (float*)d_out; a.ws = (unsigned char*)d_ws;
#if !MK_DEBUG
    a.s_lo = 0; a.s_hi = 16; a.flags = 3; a.bar_region = 0;
    hipLaunchKernelGGL(mega, dim3(grid), dim3(NTHREADS), LDS_BYTES, stream, a);
#else
    const size_t NV_OFF = (WS_END + 4095) & ~(size_t)4095;
    if (ws_size < NV_OFF + nv::bufs_bytes()) { fprintf(stderr, "debug build: workspace too small\n"); return; }
    const nv::Bufs nb = nv::carve((unsigned char*)d_ws + NV_OFF);
    double* acc = (double*)((char*)d_ws + WS_CTL + 512 * 1024);
    a.s_lo = 0; a.s_hi = 0; a.flags = 1; a.bar_region = 0;
    hipLaunchKernelGGL(mega, dim3(grid), dim3(NTHREADS), LDS_BYTES, stream, a);
    for (int s = MK_DEBUG_LO; s < MK_DEBUG_HI; ++s) {
        hipLaunchKernelGGL(k_bf16_to_f32, dim3(2048), dim3(256), 0, stream, (const unsigned short*)((char*)d_ws + WS_XB), nb.X, (size_t)M * D);
        a.s_lo = s; a.s_hi = s + 1; a.flags = 0; a.bar_region = 1 + s;
        hipLaunchKernelGGL(mega, dim3(grid), dim3(NTHREADS), LDS_BYTES, stream, a);
        nv::sublayer(nb, d_in, s, stream);
        hipLaunchKernelGGL(k_cmp, dim3(2048), dim3(256), 0, stream, (const unsigned short*)((char*)d_ws + WS_XB), (const float*)nb.X, (size_t)M * D, acc + 2 * s);
        if (s == 2) {
            hipLaunchKernelGGL(k_cmp_attn, dim3(2048), dim3(256), 0, stream, (const unsigned short*)((char*)d_ws + WS_Q), (const float*)nb.T2, 0, acc + 2 * 20);
            hipLaunchKernelGGL(k_cmp_attn, dim3(2048), dim3(256), 0, stream, (const unsigned short*)((char*)d_ws + WS_KB), (const float*)nb.K, 1, acc + 2 * 21);
            hipLaunchKernelGGL(k_cmp_attn, dim3(2048), dim3(256), 0, stream, (const unsigned short*)((char*)d_ws + WS_VT), (const float*)nb.V, 2, acc + 2 * 22);
        }
    }
    a.s_lo = 0; a.s_hi = 0; a.flags = 2; a.bar_region = 17;
    hipLaunchKernelGGL(mega, dim3(grid), dim3(NTHREADS), LDS_BYTES, stream, a);
    hipLaunchKernelGGL(k_verdict, dim3(2048), dim3(256), 0, stream, (const double*)acc, 16, (float*)d_out, (size_t)M * D, 1e-4);
    hipLaunchKernelGGL(k_verdict2, dim3(2048), dim3(256), 0, stream, (const double*)acc, 20, 24, 5, (float*)d_out, (size_t)M * D, 1e-3);
#endif
}
```
